# Optimizing an MI355X kernel written in HIP

```python
import math
import jax, jax.numpy as jnp
from jax import lax
import numpy as np

D_MODEL = 1024
BATCH = 16
SEQ = 256
DEPTH = 2
DEC_BATCH = 8
DEC_SEQ = 1024
PAST_LEN = 512

GRID_W = 64
HEAD_DIM = 64
N_Q_HEADS = 8
N_KV_HEADS = 2
GQA_GROUP = N_Q_HEADS // N_KV_HEADS
ATTN_W = N_Q_HEADS * HEAD_DIM
KV_W = N_KV_HEADS * HEAD_DIM
ROPE_AXIS_PAIRS = HEAD_DIM // 4
ROPE_THETA = 10000.0
Q_BLOCK = 128
SSM_W = D_MODEL // 2
SSM_GROUP = 16
N_SSM_GROUPS = SSM_W // SSM_GROUP
STATE_P = 64
DT_MIN = 1e-3
DT_MAX = 1e-1
FOURIER_W = D_MODEL // 2
FOURIER_GROUPS = 4
FOURIER_GW = FOURIER_W // FOURIER_GROUPS
N_BRANCH = 3
D_IN = ATTN_W + 2 * KV_W + SSM_W + FOURIER_W + N_BRANCH * D_MODEL
SPLITS = [ATTN_W, ATTN_W + KV_W, ATTN_W + 2 * KV_W, ATTN_W + 2 * KV_W + SSM_W,
          ATTN_W + 2 * KV_W + SSM_W + FOURIER_W]
D_FF = ((8 * D_MODEL // 3 + 127) // 128) * 128
CONV_W = 3
EPS = 1e-6
ALPHA = (2 * DEPTH) ** 0.25
BETA = (8 * DEPTH) ** -0.25

kernel_name = "hybrid_diffusion_prefix_trunk_step"


def _layer_norm(x, g, b):
    xf = x.astype(jnp.float32)
    mu = jnp.mean(xf, axis=-1, keepdims=True)
    xc = xf - mu
    var = jnp.mean(xc * xc, axis=-1, keepdims=True)
    y = xc * lax.rsqrt(var + EPS) * g.astype(jnp.float32) + b.astype(jnp.float32)
    return y.astype(x.dtype)


def _rms_norm(x, g):
    xf = x.astype(jnp.float32)
    y = xf * lax.rsqrt(jnp.mean(xf * xf, axis=-1, keepdims=True) + EPS) * g.astype(jnp.float32)
    return y.astype(x.dtype)


def _axial_rope_tables(n_tokens):
    rows = n_tokens // GRID_W
    row = jnp.repeat(jnp.arange(rows, dtype=jnp.float32), GRID_W)
    col = jnp.tile(jnp.arange(GRID_W, dtype=jnp.float32), rows)
    freqs = ROPE_THETA ** (-jnp.arange(ROPE_AXIS_PAIRS, dtype=jnp.float32) / ROPE_AXIS_PAIRS)
    ang = jnp.concatenate([row[:, None] * freqs, col[:, None] * freqs], axis=-1)
    return jnp.cos(ang), jnp.sin(ang)


def _apply_rope(x, cos, sin):
    b, l, h, _ = x.shape
    xr = x.astype(jnp.float32).reshape(b, l, h, HEAD_DIM // 2, 2)
    x0, x1 = xr[..., 0], xr[..., 1]
    c = cos[None, :, None, :]
    s = sin[None, :, None, :]
    out = jnp.stack([x0 * c - x1 * s, x0 * s + x1 * c], axis=-1)
    return out.reshape(b, l, h, HEAD_DIM).astype(x.dtype)


def _block_attention(q, k, v):
    bsz, lq = q.shape[:2]
    n_blocks = lq // Q_BLOCK
    qb = q.reshape(bsz, n_blocks, Q_BLOCK, N_KV_HEADS, GQA_GROUP, HEAD_DIM).transpose(1, 0, 2, 3, 4, 5)
    scale = HEAD_DIM ** -0.5

    def one_block(q_blk):
        s = jnp.einsum("bqhgd,bkhd->bhgqk", q_blk, k).astype(jnp.float32) * scale
        p = jax.nn.softmax(s, axis=-1).astype(v.dtype)
        return jnp.einsum("bhgqk,bkhd->bqhgd", p, v)

    o = lax.map(one_block, qb)
    return o.transpose(1, 0, 2, 3, 4, 5).reshape(bsz, lq, ATTN_W)


def _zoh(a_re, a_im, log_dt, b_re, b_im):
    a_re = a_re.astype(jnp.float32)
    a_im = a_im.astype(jnp.float32)
    b_re = b_re.astype(jnp.float32)
    b_im = b_im.astype(jnp.float32)
    dt = jnp.exp(log_dt.astype(jnp.float32))[:, None]
    mag = jnp.exp(a_re * dt)
    ang = a_im * dt
    lb_re = mag * jnp.cos(ang)
    lb_im = mag * jnp.sin(ang)
    den = a_re * a_re + a_im * a_im
    n_re = lb_re - 1.0
    n_im = lb_im
    f_re = (n_re * a_re + n_im * a_im) / den
    f_im = (n_im * a_re - n_re * a_im) / den
    bb_re = f_re[..., None] * b_re - f_im[..., None] * b_im
    bb_im = f_re[..., None] * b_im + f_im[..., None] * b_re
    return lb_re, lb_im, bb_re, bb_im


def _complex_linear_combine(e1, e2):
    a1r, a1i, b1r, b1i = e1
    a2r, a2i, b2r, b2i = e2
    return (a2r * a1r - a2i * a1i, a2r * a1i + a2i * a1r,
            a2r * b1r - a2i * b1i + b2r, a2r * b1i + a2i * b1r + b2i)


def _s5_bidirectional(u, a_re, a_im, log_dt, b_re, b_im, c_re, c_im, d, h0):
    bsz, L = u.shape[:2]
    uf = u.astype(jnp.float32)
    ug = uf.reshape(bsz, L, N_SSM_GROUPS, SSM_GROUP)
    h0 = h0.astype(jnp.float32)
    y = d.astype(jnp.float32) * uf
    finals = []
    for di in range(2):
        lb_re, lb_im, bb_re, bb_im = _zoh(a_re[di], a_im[di], log_dt[di], b_re[di], b_im[di])
        bu_re = jnp.einsum("blgn,gpn->blgp", ug, bb_re)
        bu_im = jnp.einsum("blgn,gpn->blgp", ug, bb_im)
        if di == 1:
            bu_re = jnp.flip(bu_re, axis=1)
            bu_im = jnp.flip(bu_im, axis=1)
        hr, hi = h0[:, di, ..., 0], h0[:, di, ..., 1]
        bu_re = bu_re.at[:, 0].add(lb_re * hr - lb_im * hi)
        bu_im = bu_im.at[:, 0].add(lb_re * hi + lb_im * hr)
        a_r = jnp.broadcast_to(lb_re, bu_re.shape)
        a_i = jnp.broadcast_to(lb_im, bu_im.shape)
        _, _, s_re, s_im = lax.associative_scan(_complex_linear_combine, (a_r, a_i, bu_re, bu_im), axis=1)
        finals.append(jnp.stack([s_re[:, -1], s_im[:, -1]], axis=-1))
        if di == 1:
            s_re = jnp.flip(s_re, axis=1)
            s_im = jnp.flip(s_im, axis=1)
        yd = (jnp.einsum("blgp,gnp->blgn", s_re, c_re[di].astype(jnp.float32))
              - jnp.einsum("blgp,gnp->blgn", s_im, c_im[di].astype(jnp.float32)))
        y = y + yd.reshape(bsz, L, SSM_W)
    state = jnp.stack(finals, axis=1)
    return y.astype(u.dtype), state


def _fourier_mix(f):
    bsz, L = f.shape[:2]
    fg = f.astype(jnp.float32).reshape(bsz, L, FOURIER_GROUPS, FOURIER_GW)
    out = jnp.fft.fft2(fg, axes=(1, 3), norm="ortho").real
    return out.reshape(bsz, L, FOURIER_W).astype(f.dtype)


def _dwconv3(h, w, b):
    hp = jnp.pad(h, ((0, 0), (1, 1), (0, 0)))
    return hp[:, :-2] * w[0] + hp[:, 1:-1] * w[1] + hp[:, 2:] * w[2] + b


def _trunk_layer(x, mod, p, rope, ctx_k, ctx_v, h0):
    bsz, L = x.shape[:2]
    sh1, sc1, g1, sh2, sc2, g2 = jnp.split(mod[:, None, :], 6, axis=-1)
    u = x * (1.0 + sc1) + sh1
    z = u @ p["w_in"]
    q, k, v, s_in, f_in, gates = jnp.split(z, SPLITS, axis=-1)
    q = _rms_norm(q.reshape(bsz, L, N_Q_HEADS, HEAD_DIM), p["q_norm_g"])
    k = _rms_norm(k.reshape(bsz, L, N_KV_HEADS, HEAD_DIM), p["k_norm_g"])
    v = v.reshape(bsz, L, N_KV_HEADS, HEAD_DIM)
    if rope is None:
        keys, vals = k, v
    else:
        cos, sin = rope
        q = _apply_rope(q, cos, sin)
        k = _apply_rope(k, cos, sin)
        keys = jnp.concatenate([k, ctx_k.astype(k.dtype)], axis=1)
        vals = jnp.concatenate([v, ctx_v.astype(v.dtype)], axis=1)
    attn = _block_attention(q, keys, vals)
    ssm_y, ssm_state = _s5_bidirectional(s_in, p["ssm_a_re"], p["ssm_a_im"], p["ssm_log_dt"],
                                         p["ssm_b_re"], p["ssm_b_im"], p["ssm_c_re"], p["ssm_c_im"],
                                         p["ssm_d"], h0)
    ssm_y = jax.nn.gelu(ssm_y)
    ssm_y = ssm_y * jax.nn.sigmoid(ssm_y @ p["w_glu"] + p["b_glu"])
    four = _fourier_mix(f_in)
    g_a, g_s, g_f = jnp.split(jax.nn.sigmoid(gates), N_BRANCH, axis=-1)
    merged = (g_a * (attn @ p["w_br_attn"]) + g_s * (ssm_y @ p["w_br_ssm"])
              + g_f * (four @ p["w_br_four"]))
    mix_out = merged @ p["w_out"]
    x = _layer_norm(ALPHA * x + g1 * mix_out, p["ln1_g"], p["ln1_b"])
    u2 = x * (1.0 + sc2) + sh2
    h = _dwconv3(u2 @ p["w_up"], p["conv_w"], p["conv_b"])
    ha, hb = jnp.split(h, 2, axis=-1)
    ffn_out = (jax.nn.silu(ha) * hb) @ p["w_down"]
    x = _layer_norm(ALPHA * x + g2 * ffn_out, p["ln2_g"], p["ln2_b"])
    return x, k, v, ssm_state


def setup_inputs(seed: int = 0) -> dict:
    key = jax.random.key(seed)
    ks = jax.random.split(key, 40)
    f32 = jnp.float32
    nrm = lambda k_, shape, s: jax.random.normal(k_, shape, f32) * s
    G, P, N = N_SSM_GROUPS, STATE_P, SSM_GROUP
    n_idx = jnp.arange(P, dtype=f32)
    inp = {}
    inp["x_prompt"] = nrm(ks[0], (BATCH, SEQ, D_MODEL), 1.0)
    inp["x_sample"] = nrm(ks[1], (DEC_BATCH, DEC_SEQ, D_MODEL), 1.0)
    inp["c"] = nrm(ks[2], (DEC_BATCH, D_MODEL), 1.0)
    inp["cache_k"] = nrm(ks[3], (DEC_BATCH, DEPTH, PAST_LEN, N_KV_HEADS, HEAD_DIM), 1.0)
    inp["cache_v"] = nrm(ks[4], (DEC_BATCH, DEPTH, PAST_LEN, N_KV_HEADS, HEAD_DIM), 1.0)
    inp["state_ssm"] = nrm(ks[5], (DEC_BATCH, DEPTH, 2, G, P, 2), 0.3)
    inp["c_ctx"] = nrm(ks[6], (D_MODEL,), 1.0)
    inp["w_ada"] = nrm(ks[7], (DEPTH, D_MODEL, 6 * D_MODEL), 0.5 * D_MODEL ** -0.5)
    inp["b_ada"] = nrm(ks[8], (DEPTH, 6 * D_MODEL), 0.01)
    inp["w_in"] = nrm(ks[9], (DEPTH, D_MODEL, D_IN), D_MODEL ** -0.5)
    inp["q_norm_g"] = 1.0 + nrm(ks[10], (DEPTH, HEAD_DIM), 0.01)
    inp["k_norm_g"] = 1.0 + nrm(ks[11], (DEPTH, HEAD_DIM), 0.01)
    inp["ssm_a_re"] = -0.5 + nrm(ks[12], (DEPTH, 2, G, P), 0.01)
    inp["ssm_a_im"] = math.pi * n_idx + nrm(ks[13], (DEPTH, 2, G, P), 0.01)
    inp["ssm_log_dt"] = jax.random.uniform(ks[14], (DEPTH, 2, G), f32, math.log(DT_MIN), math.log(DT_MAX))
    inp["ssm_b_re"] = nrm(ks[15], (DEPTH, 2, G, P, N), (2 * N) ** -0.5)
    inp["ssm_b_im"] = nrm(ks[16], (DEPTH, 2, G, P, N), (2 * N) ** -0.5)
    inp["ssm_c_re"] = nrm(ks[17], (DEPTH, 2, G, N, P), (2 * P) ** -0.5)
    inp["ssm_c_im"] = nrm(ks[18], (DEPTH, 2, G, N, P), (2 * P) ** -0.5)
    inp["ssm_d"] = nrm(ks[19], (DEPTH, SSM_W), 1.0)
    inp["w_glu"] = nrm(ks[20], (DEPTH, SSM_W, SSM_W), SSM_W ** -0.5)
    inp["b_glu"] = nrm(ks[21], (DEPTH, SSM_W), 0.01)
    inp["w_br_attn"] = nrm(ks[22], (DEPTH, ATTN_W, D_MODEL), ATTN_W ** -0.5)
    inp["w_br_ssm"] = nrm(ks[23], (DEPTH, SSM_W, D_MODEL), SSM_W ** -0.5)
    inp["w_br_four"] = nrm(ks[24], (DEPTH, FOURIER_W, D_MODEL), FOURIER_W ** -0.5)
    inp["w_out"] = nrm(ks[25], (DEPTH, D_MODEL, D_MODEL), BETA * D_MODEL ** -0.5)
    inp["ln1_g"] = 1.0 + nrm(ks[26], (DEPTH, D_MODEL), 0.01)
    inp["ln1_b"] = nrm(ks[27], (DEPTH, D_MODEL), 0.01)
    inp["w_up"] = nrm(ks[28], (DEPTH, D_MODEL, 2 * D_FF), D_MODEL ** -0.5)
    inp["conv_w"] = nrm(ks[29], (DEPTH, CONV_W, 2 * D_FF), CONV_W ** -0.5)
    inp["conv_b"] = nrm(ks[30], (DEPTH, 2 * D_FF), 0.01)
    inp["w_down"] = nrm(ks[31], (DEPTH, D_FF, D_MODEL), BETA * D_FF ** -0.5)
    inp["ln2_g"] = 1.0 + nrm(ks[32], (DEPTH, D_MODEL), 0.01)
    inp["ln2_b"] = nrm(ks[33], (DEPTH, D_MODEL), 0.01)
    return inp


def reference(x_prompt, x_sample, c, cache_k, cache_v, state_ssm, c_ctx,
              w_ada, b_ada, w_in, q_norm_g, k_norm_g,
              ssm_a_re, ssm_a_im, ssm_log_dt, ssm_b_re, ssm_b_im, ssm_c_re, ssm_c_im, ssm_d,
              w_glu, b_glu, w_br_attn, w_br_ssm, w_br_four, w_out, ln1_g, ln1_b,
              w_up, conv_w, conv_b, w_down, ln2_g, ln2_b):
    stacked = dict(w_in=w_in, q_norm_g=q_norm_g, k_norm_g=k_norm_g,
                   ssm_a_re=ssm_a_re, ssm_a_im=ssm_a_im, ssm_log_dt=ssm_log_dt,
                   ssm_b_re=ssm_b_re, ssm_b_im=ssm_b_im, ssm_c_re=ssm_c_re, ssm_c_im=ssm_c_im,
                   ssm_d=ssm_d, w_glu=w_glu, b_glu=b_glu, w_br_attn=w_br_attn, w_br_ssm=w_br_ssm,
                   w_br_four=w_br_four, w_out=w_out, ln1_g=ln1_g, ln1_b=ln1_b,
                   w_up=w_up, conv_w=conv_w, conv_b=conv_b, w_down=w_down, ln2_g=ln2_g, ln2_b=ln2_b)

    h = x_prompt
    h0_ctx = jnp.zeros((x_prompt.shape[0], 2, N_SSM_GROUPS, STATE_P, 2), jnp.float32)
    ks_out, vs_out, ss_out = [], [], []
    for l in range(DEPTH):
        p = {name: arr[l] for name, arr in stacked.items()}
        mod_ctx = jax.nn.silu(c_ctx)[None, :] @ w_ada[l] + b_ada[l]
        h, k_l, v_l, s_l = _trunk_layer(h, mod_ctx, p, None, None, None, h0_ctx)
        ks_out.append(k_l)
        vs_out.append(v_l)
        ss_out.append(s_l)
    new_cache_k = jnp.stack(ks_out, axis=1)
    new_cache_v = jnp.stack(vs_out, axis=1)
    new_state_ssm = jnp.stack(ss_out, axis=1)

    rope = _axial_rope_tables(x_sample.shape[1])
    zx = x_sample
    for l in range(DEPTH):
        p = {name: arr[l] for name, arr in stacked.items()}
        mod = jax.nn.silu(c) @ w_ada[l] + b_ada[l]
        zx, _, _, _ = _trunk_layer(zx, mod, p, rope, cache_k[:, l], cache_v[:, l], state_ssm[:, l])

    return (h, zx, new_cache_k, new_cache_v, new_state_ssm)
```

```cpp
#include <hip/hip_runtime.h>
#include <hip/hip_cooperative_groups.h>
#include <cstdio>
#include <cstdint>
namespace cg = cooperative_groups;

typedef unsigned short bf16_t;
using bf16x8 = __attribute__((ext_vector_type(8))) short;
using f32x4 = __attribute__((ext_vector_type(4))) float;

#define DEVI __device__ __forceinline__

constexpr int M = 12288;
constexpr int MCTX = 4096;
constexpr float ALPHA = 1.41421356237f;
constexpr float LN_EPS = 1e-6f;

constexpr size_t WL_IN = 0;
constexpr size_t WL_GLU = WL_IN + (size_t)4864 * 1024;
constexpr size_t WL_BR = WL_GLU + (size_t)512 * 512;
constexpr size_t WL_OUT = WL_BR + (size_t)3 * 1024 * 512;
constexpr size_t WL_UP = WL_OUT + (size_t)1024 * 1024;
constexpr size_t WL_DN = WL_UP + (size_t)5632 * 1024;
constexpr size_t WL_TOT = WL_DN + (size_t)1024 * 2816;
constexpr size_t OFF_W = 0;
constexpr size_t SSM_EL = 196608;
constexpr size_t OFF_SSM = OFF_W + 2 * WL_TOT * 2;
constexpr size_t OFF_LAM16 = OFF_SSM + 64 * SSM_EL * 2;
constexpr size_t OFF_T1024 = OFF_LAM16 + 2 * 2 * 32 * 64 * 8;
constexpr size_t OFF_T256 = OFF_T1024 + (size_t)1024 * 2048 * 2;
constexpr size_t OFF_DFT128 = OFF_T256 + (size_t)256 * 512 * 2;
constexpr size_t OFF_ROPE = OFF_DFT128 + (size_t)256 * 128 * 2;
constexpr size_t OFF_MOD = OFF_ROPE + (size_t)1024 * 32 * 8;
constexpr size_t OFF_U = OFF_MOD + (size_t)2 * 9 * 6144 * 4;
constexpr size_t OFF_R = OFF_U + (size_t)M * 1024 * 2;
constexpr size_t OFF_Z = OFF_R;
constexpr size_t OFF_ATT = OFF_R;
constexpr size_t OFF_SSMG = OFF_R + (size_t)M * 512 * 2;
constexpr size_t OFF_FOUR = OFF_R + (size_t)2 * M * 512 * 2;
constexpr size_t OFF_QN = OFF_Z + (size_t)M * 1792 * 2;
constexpr size_t OFF_KD = OFF_QN + (size_t)M * 512 * 2;
constexpr size_t OFF_VTD = OFF_KD + (size_t)16 * 1536 * 64 * 2;
constexpr size_t OFF_KC = OFF_VTD + (size_t)16 * 1536 * 64 * 2;
constexpr size_t OFF_VTC = OFF_KC + (size_t)32 * 256 * 64 * 2;
constexpr size_t OFF_SSMP = OFF_VTC + (size_t)32 * 256 * 64 * 2;
constexpr size_t OFF_GT = OFF_SSMP + (size_t)M * 512 * 2;
constexpr size_t OFF_HG = OFF_R;
constexpr size_t OFF_EDGE = OFF_HG + (size_t)M * 2816 * 2;

constexpr size_t OUT_CK = (size_t)M * 1024;
constexpr size_t OUT_CV = OUT_CK + (size_t)16 * 2 * 256 * 128;
constexpr size_t OUT_ST = OUT_CV + (size_t)16 * 2 * 256 * 128;

struct Params {
  const float* in[34];
  float* out;
  unsigned char* ws;
};

DEVI int opaque_tid() {
  int t = threadIdx.x;
  asm volatile("" : "+v"(t));
  return t;
}
DEVI unsigned short f2bf(float f) {
  unsigned u = __float_as_uint(f);
  u += 0x7fffu + ((u >> 16) & 1u);
  return (unsigned short)(u >> 16);
}
DEVI float bf2f(unsigned short h) { return __uint_as_float(((unsigned)h) << 16); }
DEVI unsigned pack2(float a, float b) { return (unsigned)f2bf(a) | ((unsigned)f2bf(b) << 16); }
DEVI float sigmoidf_(float x) { return 1.0f / (1.0f + __expf(-x)); }
DEVI float gelu_tanh(float x) {
  float y = 0.7978845608028654f * (x + 0.044715f * x * x * x);
  float t = 1.0f - 2.0f / (1.0f + __expf(2.0f * y));
  return 0.5f * x * (1.0f + t);
}
DEVI int modrow(int m) { return m < MCTX ? 0 : 1 + ((m - MCTX) >> 10); }

DEVI void gemm_core(const bf16_t* P, int ldp, const bf16_t* Q, int ldq, int K, f32x4 (&acc)[4][4],
                    unsigned char* smem) {
  const int tid = opaque_tid(), lane = tid & 63, wave = tid >> 6, wp = wave >> 1, wq = wave & 1;
  const int fr = lane & 15, fq = lane >> 4;
  const int srow = tid >> 3, sch = tid & 7;
  const bf16_t* gp = P + (size_t)srow * ldp + sch * 8;
  const bf16_t* gq = Q + (size_t)srow * ldq + sch * 8;
  const int woff = srow * 128 + ((sch ^ ((srow >> 1) & 7)) << 4);
  const int swz = fr >> 1;
  const int poff = (wp * 64 + fr) * 128;
  const int qoff = 16384 + (wq * 64 + fr) * 128;
  uint4 rp[4], rq[4];
  const int nk = K >> 6;
#pragma unroll
  for (int it = 0; it < 4; ++it) {
    rp[it] = *(const uint4*)(gp + (size_t)(32 * it) * ldp);
    rq[it] = *(const uint4*)(gq + (size_t)(32 * it) * ldq);
  }
#pragma unroll
  for (int it = 0; it < 4; ++it) {
    *(uint4*)(smem + woff + it * 4096) = rp[it];
    *(uint4*)(smem + 16384 + woff + it * 4096) = rq[it];
  }
  __syncthreads();
#pragma unroll 1
  for (int kt = 0; kt < nk; ++kt) {
    const int cur = (kt & 1) * 32768;
    {
      const int kn = (kt + 1 < nk) ? kt + 1 : kt;
      const bf16_t* gp2 = gp + (size_t)kn * 64;
      const bf16_t* gq2 = gq + (size_t)kn * 64;
#pragma unroll
      for (int it = 0; it < 4; ++it) {
        rp[it] = *(const uint4*)(gp2 + (size_t)(32 * it) * ldp);
        rq[it] = *(const uint4*)(gq2 + (size_t)(32 * it) * ldq);
      }
    }
#pragma unroll
    for (int ks = 0; ks < 2; ++ks) {
      const int co = ((ks * 4 + fq) ^ swz) << 4;
      bf16x8 a[4], b[4];
#pragma unroll
      for (int i = 0; i < 4; ++i) a[i] = *(const bf16x8*)(smem + cur + poff + i * 2048 + co);
#pragma unroll
      for (int j = 0; j < 4; ++j) b[j] = *(const bf16x8*)(smem + cur + qoff + j * 2048 + co);
#pragma unroll
      for (int i = 0; i < 4; ++i)
#pragma unroll
        for (int j = 0; j < 4; ++j)
          acc[i][j] = __builtin_amdgcn_mfma_f32_16x16x32_bf16(a[i], b[j], acc[i][j], 0, 0, 0);
    }
    {
      const int nxt = 32768 - cur;
#pragma unroll
      for (int it = 0; it < 4; ++it) {
        *(uint4*)(smem + nxt + woff + it * 4096) = rp[it];
        *(uint4*)(smem + nxt + 16384 + woff + it * 4096) = rq[it];
      }
    }
    __syncthreads();
  }
}

DEVI void zero_acc(f32x4 (&acc)[4][4]) {
#pragma unroll
  for (int i = 0; i < 4; ++i)
#pragma unroll
    for (int j = 0; j < 4; ++j) acc[i][j] = f32x4{0.f, 0.f, 0.f, 0.f};
}

DEVI void transpose_tile(const float* W, int K, int N, bf16_t* WT, int kt, int nt, int mode, unsigned char* smem) {
  float* t = (float*)smem;
  const int tid = opaque_tid();
  {
    const int r = tid >> 4, c4 = tid & 15;
#pragma unroll
    for (int it = 0; it < 4; ++it) {
      float4 v = *(const float4*)(W + (size_t)(kt * 64 + r + 16 * it) * N + nt * 64 + c4 * 4);
      float* d = t + (r + 16 * it) * 65 + c4 * 4;
      d[0] = v.x; d[1] = v.y; d[2] = v.z; d[3] = v.w;
    }
  }
  __syncthreads();
  {
    const int n = tid >> 2, kq = tid & 3;
    unsigned w[8];
#pragma unroll
    for (int e = 0; e < 8; ++e) w[e] = pack2(t[(kq * 16 + 2 * e) * 65 + n], t[(kq * 16 + 2 * e + 1) * 65 + n]);
    int c = nt * 64 + n, row = c;
    if (mode == 1) {
      int half = c >= 2816 ? 1 : 0;
      int cc = c - half * 2816;
      row = (cc >> 6) * 128 + half * 64 + (cc & 63);
    }
    uint4* dst = (uint4*)(WT + (size_t)row * K + kt * 64 + kq * 16);
    dst[0] = uint4{w[0], w[1], w[2], w[3]};
    dst[1] = uint4{w[4], w[5], w[6], w[7]};
  }
  __syncthreads();
}

DEVI void weights_item(const Params& p, int idx, unsigned char* smem) {
  const int l = idx / 4032;
  int t = idx - l * 4032;
  bf16_t* wl = (bf16_t*)(p.ws + OFF_W) + (size_t)l * WL_TOT;
  if (t < 1216) { transpose_tile(p.in[9] + (size_t)l * 1024 * 4864, 1024, 4864, wl + WL_IN, t / 76, t % 76, 0, smem); return; }
  t -= 1216;
  if (t < 64) { transpose_tile(p.in[20] + (size_t)l * 512 * 512, 512, 512, wl + WL_GLU, t / 8, t % 8, 0, smem); return; }
  t -= 64;
  if (t < 384) {
    const int br = t / 128; t -= br * 128;
    transpose_tile(p.in[22 + br] + (size_t)l * 512 * 1024, 512, 1024, wl + WL_BR + (size_t)br * 1024 * 512, t / 16, t % 16, 0, smem);
    return;
  }
  t -= 384;
  if (t < 256) { transpose_tile(p.in[25] + (size_t)l * 1024 * 1024, 1024, 1024, wl + WL_OUT, t / 16, t % 16, 0, smem); return; }
  t -= 256;
  if (t < 1408) { transpose_tile(p.in[28] + (size_t)l * 1024 * 5632, 1024, 5632, wl + WL_UP, t / 88, t % 88, 1, smem); return; }
  t -= 1408;
  transpose_tile(p.in[31] + (size_t)l * 2816 * 1024, 2816, 1024, wl + WL_DN, t / 16, t % 16, 0, smem);
}

DEVI void mod_item(const Params& p, int idx, unsigned char* smem) {
  const int l = idx / 96, nt = idx % 96;
  float* sc = (float*)smem;
  float* red = (float*)(smem + 36864);
  const int tid = opaque_tid();
  for (int e = tid; e < 9 * 1024; e += 256) {
    const int r = e >> 10, k = e & 1023;
    const float v = (r == 0) ? p.in[6][k] : p.in[2][(r - 1) * 1024 + k];
    sc[e] = v * sigmoidf_(v);
  }
  __syncthreads();
  const int kq = tid >> 6, col = tid & 63;
  const float* w = p.in[7] + (size_t)l * 1024 * 6144 + (size_t)(kq * 256) * 6144 + nt * 64 + col;
  float acc[9];
#pragma unroll
  for (int r = 0; r < 9; ++r) acc[r] = 0.f;
  for (int k0 = 0; k0 < 256; k0 += 8) {
    float wv[8];
#pragma unroll
    for (int e = 0; e < 8; ++e) wv[e] = w[(size_t)(k0 + e) * 6144];
#pragma unroll
    for (int e = 0; e < 8; ++e)
#pragma unroll
      for (int r = 0; r < 9; ++r) acc[r] += sc[r * 1024 + kq * 256 + k0 + e] * wv[e];
  }
#pragma unroll
  for (int r = 0; r < 9; ++r) red[(kq * 9 + r) * 64 + col] = acc[r];
  __syncthreads();
  float* mod = (float*)(p.ws + OFF_MOD) + (size_t)l * 9 * 6144;
  for (int e = tid; e < 9 * 64; e += 256) {
    const int r = e >> 6, c = e & 63;
    float s = red[(0 * 9 + r) * 64 + c] + red[(1 * 9 + r) * 64 + c] + red[(2 * 9 + r) * 64 + c] + red[(3 * 9 + r) * 64 + c];
    mod[r * 6144 + nt * 64 + c] = s + p.in[8][l * 6144 + nt * 64 + c];
  }
  __syncthreads();
}

DEVI void ssm_pre_item(const Params& p, int idx, unsigned char* smem) {
  const int l = idx >> 5, g = idx & 31;
  const int tid = opaque_tid();
  float2* Lpow = (float2*)smem;
  float2* Bbar = (float2*)(smem + 17408);
  float* Kc = (float*)(smem + 17408 + 16384);
  const float* a_re = p.in[12]; const float* a_im = p.in[13]; const float* log_dt = p.in[14];
  const float* b_re = p.in[15]; const float* b_im = p.in[16]; const float* c_re = p.in[17]; const float* c_im = p.in[18];
  for (int e = tid; e < 2 * 17 * 64; e += 256) {
    const int dir = e / (17 * 64), tau = (e >> 6) % 17, pp = e & 63;
    const int ai = ((l * 2 + dir) * 32 + g) * 64 + pp;
    const float dt = expf(log_dt[(l * 2 + dir) * 32 + g]);
    const float mag = expf(a_re[ai] * dt * (float)tau);
    const float ang = a_im[ai] * dt * (float)tau;
    float s, c; sincosf(ang, &s, &c);
    Lpow[e] = float2{mag * c, mag * s};
    if (tau == 16) ((float2*)(p.ws + OFF_LAM16))[ai] = float2{mag * c, mag * s};
  }
  for (int e = tid; e < 2 * 64 * 16; e += 256) {
    const int dir = e >> 10, pp = (e >> 4) & 63, n = e & 15;
    const int ai = ((l * 2 + dir) * 32 + g) * 64 + pp;
    const float dt = expf(log_dt[(l * 2 + dir) * 32 + g]);
    const float ar = a_re[ai], aim = a_im[ai];
    const float mag = expf(ar * dt);
    float s, c; sincosf(aim * dt, &s, &c);
    const float nr = mag * c - 1.0f, ni = mag * s;
    const float den = ar * ar + aim * aim;
    const float fr_ = (nr * ar + ni * aim) / den, fi_ = (ni * ar - nr * aim) / den;
    const float br = b_re[(size_t)ai * 16 + n], bi = b_im[(size_t)ai * 16 + n];
    Bbar[e] = float2{fr_ * br - fi_ * bi, fr_ * bi + fi_ * br};
  }
  __syncthreads();
  for (int dir = 0; dir < 2; ++dir) {
    const int tau = tid >> 4, n = tid & 15;
    float acc[16];
#pragma unroll
    for (int m = 0; m < 16; ++m) acc[m] = 0.f;
    const size_t cbase = ((size_t)((l * 2 + dir) * 32 + g) * 16 + n) * 64;
    for (int pp = 0; pp < 64; ++pp) {
      const float cr = c_re[cbase + pp], ci = c_im[cbase + pp];
      const float2 lp = Lpow[(dir * 17 + tau) * 64 + pp];
      const float gr = cr * lp.x - ci * lp.y, gi = cr * lp.y + ci * lp.x;
#pragma unroll
      for (int m = 0; m < 16; ++m) {
        const float2 bb = Bbar[(dir * 64 + pp) * 16 + m];
        acc[m] += gr * bb.x - gi * bb.y;
      }
    }
    const int delta = dir == 0 ? 15 - tau : 15 + tau;
#pragma unroll
    for (int m = 0; m < 16; ++m) {
      if (dir == 1 && tau == 0) Kc[(delta * 16 + n) * 16 + m] += acc[m];
      else Kc[(delta * 16 + n) * 16 + m] = acc[m];
    }
    __syncthreads();
  }
  bf16_t* AC = (bf16_t*)(p.ws + OFF_SSM) + (size_t)idx * SSM_EL;
  bf16_t* W1 = AC + 256 * 512;
  for (int v = tid; v < 256 * 64; v += 256) {
    const int row = v >> 6, kc = v & 63;
    const int t = row >> 4, n = row & 15;
    float val[8];
    if (kc < 32) {
      const int s = kc >> 1, m0 = (kc & 1) * 8;
      const int delta = s - t + 15;
#pragma unroll
      for (int e = 0; e < 8; ++e) val[e] = Kc[(delta * 16 + n) * 16 + m0 + e];
    } else {
      const int dir = kc >= 48 ? 1 : 0;
      const int p0 = ((kc - 32) & 15) * 4;
      const int tau = dir == 0 ? t + 1 : 16 - t;
      const size_t cbase = ((size_t)((l * 2 + dir) * 32 + g) * 16 + n) * 64;
#pragma unroll
      for (int e = 0; e < 4; ++e) {
        const float cr = c_re[cbase + p0 + e], ci = c_im[cbase + p0 + e];
        const float2 lp = Lpow[(dir * 17 + tau) * 64 + p0 + e];
        val[2 * e] = cr * lp.x - ci * lp.y;
        val[2 * e + 1] = -(cr * lp.y + ci * lp.x);
      }
    }
    *(uint4*)(AC + (size_t)row * 512 + kc * 8) =
        uint4{pack2(val[0], val[1]), pack2(val[2], val[3]), pack2(val[4], val[5]), pack2(val[6], val[7])};
  }
  for (int v = tid; v < 256 * 32; v += 256) {
    const int row = v >> 5, kc = v & 31;
    const int dir = row >> 7, pp = (row >> 1) & 63, ri = row & 1;
    const int s = kc >> 1, m0 = (kc & 1) * 8;
    const float2 lp = Lpow[(dir * 17 + (dir == 0 ? 15 - s : s)) * 64 + pp];
    float val[8];
#pragma unroll
    for (int e = 0; e < 8; ++e) {
      const float2 bb = Bbar[(dir * 64 + pp) * 16 + m0 + e];
      val[e] = ri == 0 ? (lp.x * bb.x - lp.y * bb.y) : (lp.x * bb.y + lp.y * bb.x);
    }
    *(uint4*)(W1 + (size_t)row * 256 + kc * 8) =
        uint4{pack2(val[0], val[1]), pack2(val[2], val[3]), pack2(val[4], val[5]), pack2(val[6], val[7])};
  }
  __syncthreads();
}

DEVI void table_item(const Params& p, int idx) {
  const int tid = opaque_tid();
  if (idx < 512) {
    bf16_t* T = (bf16_t*)(p.ws + OFF_T1024);
    for (int e = tid; e < 4096; e += 256) {
      const int g = idx * 4096 + e, k = g >> 11, kk = g & 2047;
      const int ph = (k * (kk & 1023)) & 1023;
      float s, c; sincospif((float)ph * (2.0f / 1024.0f), &s, &c);
      T[g] = f2bf(kk < 1024 ? c : -s);
    }
    return;
  }
  idx -= 512;
  if (idx < 32) {
    bf16_t* T = (bf16_t*)(p.ws + OFF_T256);
    for (int e = tid; e < 4096; e += 256) {
      const int g = idx * 4096 + e, k = g >> 9, kk = g & 511;
      const int ph = (k * (kk & 255)) & 255;
      float s, c; sincospif((float)ph * (2.0f / 256.0f), &s, &c);
      T[g] = f2bf(kk < 256 ? c : -s);
    }
    return;
  }
  idx -= 32;
  if (idx < 8) {
    bf16_t* T = (bf16_t*)(p.ws + OFF_DFT128);
    for (int e = tid; e < 4096; e += 256) {
      const int g = idx * 4096 + e, n1 = g >> 7, c_ = g & 127;
      const int ph = (c_ * (n1 & 127)) & 127;
      float s, c; sincospif((float)ph * (2.0f / 128.0f), &s, &c);
      T[g] = f2bf(n1 < 128 ? c : s);
    }
    return;
  }
  idx -= 8;
  {
    float2* T = (float2*)(p.ws + OFF_ROPE);
    for (int e = tid; e < 4096; e += 256) {
      const int g = idx * 4096 + e, t = g >> 5, i = g & 31;
      const float pos = (i < 16) ? (float)(t >> 6) : (float)(t & 63);
      const float fr_ = powf(10000.0f, -(float)(i & 15) / 16.0f);
      float s, c; sincosf(pos * fr_, &s, &c);
      T[g] = float2{c, s};
    }
  }
}

DEVI const float* xin_row(const Params& p, int m) {
  return m < MCTX ? p.in[0] + (size_t)m * 1024 : p.in[1] + (size_t)(m - MCTX) * 1024;
}

DEVI void modulate0_row(const Params& p, int m) {
  const int lane = opaque_tid() & 63;
  const float* x = xin_row(p, m);
  const float* mod = (const float*)(p.ws + OFF_MOD) + (size_t)modrow(m) * 6144;
  bf16_t* u = (bf16_t*)(p.ws + OFF_U) + (size_t)m * 1024;
#pragma unroll
  for (int k = 0; k < 4; ++k) {
    const int c = lane * 4 + 256 * k;
    const float4 v = *(const float4*)(x + c);
    const float4 sh = *(const float4*)(mod + c);
    const float4 sc = *(const float4*)(mod + 1024 + c);
    uint2 o;
    o.x = pack2(v.x * (1.f + sc.x) + sh.x, v.y * (1.f + sc.y) + sh.y);
    o.y = pack2(v.z * (1.f + sc.z) + sh.z, v.w * (1.f + sc.w) + sh.w);
    *(uint2*)(u + c) = o;
  }
}

DEVI void ln_row(const Params& p, int m, const float* g, const float* b, const float* modl, int sh_off, int sc_off, bool write_u) {
  const int lane = opaque_tid() & 63;
  float* x = p.out + (size_t)m * 1024;
  float4 v[4];
  float s = 0.f;
#pragma unroll
  for (int k = 0; k < 4; ++k) {
    v[k] = *(const float4*)(x + lane * 4 + 256 * k);
    s += v[k].x + v[k].y + v[k].z + v[k].w;
  }
#pragma unroll
  for (int o = 32; o >= 1; o >>= 1) s += __shfl_xor(s, o);
  const float mu = s * (1.0f / 1024.0f);
  float q = 0.f;
#pragma unroll
  for (int k = 0; k < 4; ++k) {
    v[k].x -= mu; v[k].y -= mu; v[k].z -= mu; v[k].w -= mu;
    q += v[k].x * v[k].x + v[k].y * v[k].y + v[k].z * v[k].z + v[k].w * v[k].w;
  }
#pragma unroll
  for (int o = 32; o >= 1; o >>= 1) q += __shfl_xor(q, o);
  const float rs = rsqrtf(q * (1.0f / 1024.0f) + LN_EPS);
  const float* mod = modl + (size_t)modrow(m) * 6144;
  bf16_t* u = (bf16_t*)(p.ws + OFF_U) + (size_t)m * 1024;
#pragma unroll
  for (int k = 0; k < 4; ++k) {
    const int c = lane * 4 + 256 * k;
    const float4 gg = *(const float4*)(g + c);
    const float4 bb = *(const float4*)(b + c);
    float4 y;
    y.x = v[k].x * rs * gg.x + bb.x; y.y = v[k].y * rs * gg.y + bb.y;
    y.z = v[k].z * rs * gg.z + bb.z; y.w = v[k].w * rs * gg.w + bb.w;
    *(float4*)(x + c) = y;
    if (write_u) {
      const float4 sh = *(const float4*)(mod + sh_off + c);
      const float4 sc = *(const float4*)(mod + sc_off + c);
      uint2 o;
      o.x = pack2(y.x * (1.f + sc.x) + sh.x, y.y * (1.f + sc.y) + sh.y);
      o.y = pack2(y.z * (1.f + sc.z) + sh.z, y.w * (1.f + sc.w) + sh.w);
      *(uint2*)(u + c) = o;
    }
  }
}

DEVI void prep_token(const Params& p, int l, int tok) {
  const int lane = opaque_tid() & 63;
  bf16_t* Kd = (bf16_t*)(p.ws + OFF_KD); bf16_t* VTd = (bf16_t*)(p.ws + OFF_VTD);
  bf16_t* Kc = (bf16_t*)(p.ws + OFF_KC); bf16_t* VTc = (bf16_t*)(p.ws + OFF_VTC);
  if (tok >= M) {
    const int b = (tok - M) >> 9, j = (tok - M) & 511;
    if (lane < 32) {
      const int li = lane & 15, hk = li >> 3, d0 = (li & 7) * 8;
      const float* src = (lane < 16 ? p.in[3] : p.in[4]) + ((size_t)((b * 2 + l) * 512 + j)) * 128 + li * 8;
      const float4 v0 = *(const float4*)src, v1 = *(const float4*)(src + 4);
      const float vv[8] = {v0.x, v0.y, v0.z, v0.w, v1.x, v1.y, v1.z, v1.w};
      if (lane < 16) {
        *(uint4*)(Kd + ((size_t)(b * 2 + hk) * 1536 + 1024 + j) * 64 + d0) =
            uint4{pack2(vv[0], vv[1]), pack2(vv[2], vv[3]), pack2(vv[4], vv[5]), pack2(vv[6], vv[7])};
      } else {
#pragma unroll
        for (int e = 0; e < 8; ++e) VTd[((size_t)(b * 2 + hk) * 64 + d0 + e) * 1536 + 1024 + j] = f2bf(vv[e]);
      }
    }
    return;
  }
  const int m = tok;
  const bool dec = m >= MCTX;
  const int b = dec ? (m - MCTX) >> 10 : m >> 8;
  const int t = dec ? (m - MCTX) & 1023 : m & 255;
  const bf16_t* z = (const bf16_t*)(p.ws + OFF_Z) + (size_t)m * 1792;
  const float2* rope = (const float2*)(p.ws + OFF_ROPE) + (size_t)t * 32;
  {
    const uint4 raw = *(const uint4*)(z + lane * 8);
    float x[8];
    x[0] = bf2f(raw.x & 0xffff); x[1] = bf2f(raw.x >> 16); x[2] = bf2f(raw.y & 0xffff); x[3] = bf2f(raw.y >> 16);
    x[4] = bf2f(raw.z & 0xffff); x[5] = bf2f(raw.z >> 16); x[6] = bf2f(raw.w & 0xffff); x[7] = bf2f(raw.w >> 16);
    float ss = 0.f;
#pragma unroll
    for (int e = 0; e < 8; ++e) ss += x[e] * x[e];
    ss += __shfl_xor(ss, 1); ss += __shfl_xor(ss, 2); ss += __shfl_xor(ss, 4);
    const float rn = rsqrtf(ss * (1.0f / 64.0f) + LN_EPS);
    const int d0 = (lane & 7) * 8;
    const float* gq = p.in[10] + l * 64 + d0;
#pragma unroll
    for (int e = 0; e < 8; ++e) x[e] = x[e] * rn * gq[e];
    if (dec) {
#pragma unroll
      for (int e = 0; e < 4; ++e) {
        const float2 cs = rope[(d0 >> 1) + e];
        const float x0 = x[2 * e], x1 = x[2 * e + 1];
        x[2 * e] = x0 * cs.x - x1 * cs.y;
        x[2 * e + 1] = x0 * cs.y + x1 * cs.x;
      }
    }
    const float qs = 0.125f * 1.4426950408889634f;
    *(uint4*)((bf16_t*)(p.ws + OFF_QN) + (size_t)m * 512 + lane * 8) =
        uint4{pack2(x[0] * qs, x[1] * qs), pack2(x[2] * qs, x[3] * qs), pack2(x[4] * qs, x[5] * qs), pack2(x[6] * qs, x[7] * qs)};
  }
  {
    const int li = lane & 15, hk = li >> 3, d0 = (li & 7) * 8;
    const uint4 raw = *(const uint4*)(z + 512 + li * 8);
    float x[8];
    x[0] = bf2f(raw.x & 0xffff); x[1] = bf2f(raw.x >> 16); x[2] = bf2f(raw.y & 0xffff); x[3] = bf2f(raw.y >> 16);
    x[4] = bf2f(raw.z & 0xffff); x[5] = bf2f(raw.z >> 16); x[6] = bf2f(raw.w & 0xffff); x[7] = bf2f(raw.w >> 16);
    float ss = 0.f;
#pragma unroll
    for (int e = 0; e < 8; ++e) ss += x[e] * x[e];
    ss += __shfl_xor(ss, 1); ss += __shfl_xor(ss, 2); ss += __shfl_xor(ss, 4);
    const float rn = rsqrtf(ss * (1.0f / 64.0f) + LN_EPS);
    const float* gk = p.in[11] + l * 64 + d0;
#pragma unroll
    for (int e = 0; e < 8; ++e) x[e] = x[e] * rn * gk[e];
    if (lane < 16) {
      if (!dec) {
        float* ck = p.out + OUT_CK + ((size_t)((b * 2 + l) * 256 + t)) * 128 + li * 8;
        *(float4*)ck = float4{x[0], x[1], x[2], x[3]};
        *(float4*)(ck + 4) = float4{x[4], x[5], x[6], x[7]};
        *(uint4*)(Kc + ((size_t)(b * 2 + hk) * 256 + t) * 64 + d0) =
            uint4{pack2(x[0], x[1]), pack2(x[2], x[3]), pack2(x[4], x[5]), pack2(x[6], x[7])};
      } else {
#pragma unroll
        for (int e = 0; e < 4; ++e) {
          const float2 cs = rope[(d0 >> 1) + e];
          const float x0 = x[2 * e], x1 = x[2 * e + 1];
          x[2 * e] = x0 * cs.x - x1 * cs.y;
          x[2 * e + 1] = x0 * cs.y + x1 * cs.x;
        }
        *(uint4*)(Kd + ((size_t)(b * 2 + hk) * 1536 + t) * 64 + d0) =
            uint4{pack2(x[0], x[1]), pack2(x[2], x[3]), pack2(x[4], x[5]), pack2(x[6], x[7])};
      }
    }
  }
  if (lane >= 16 && lane < 32) {
    const int li = lane - 16, hk = li >> 3, d0 = (li & 7) * 8;
    const uint4 raw = *(const uint4*)(z + 640 + li * 8);
    float x[8];
    x[0] = bf2f(raw.x & 0xffff); x[1] = bf2f(raw.x >> 16); x[2] = bf2f(raw.y & 0xffff); x[3] = bf2f(raw.y >> 16);
    x[4] = bf2f(raw.z & 0xffff); x[5] = bf2f(raw.z >> 16); x[6] = bf2f(raw.w & 0xffff); x[7] = bf2f(raw.w >> 16);
    if (!dec) {
      float* cv = p.out + OUT_CV + ((size_t)((b * 2 + l) * 256 + t)) * 128 + li * 8;
      *(float4*)cv = float4{x[0], x[1], x[2], x[3]};
      *(float4*)(cv + 4) = float4{x[4], x[5], x[6], x[7]};
#pragma unroll
      for (int e = 0; e < 8; ++e) VTc[((size_t)(b * 2 + hk) * 64 + d0 + e) * 256 + t] = f2bf(x[e]);
    } else {
#pragma unroll
      for (int e = 0; e < 8; ++e) VTd[((size_t)(b * 2 + hk) * 64 + d0 + e) * 1536 + t] = f2bf(x[e]);
    }
  }
}

DEVI void attn_item(const Params& p, int a, unsigned char* smem) {
  const int tid = opaque_tid(), lane = tid & 63, wave = tid >> 6, fr = lane & 15, fq = lane >> 4;
  int h, Lk, m0;
  const bf16_t *Kb, *Vb;
  if (a < 512) {
    const int b = a >> 6; h = (a >> 3) & 7; const int qb = a & 7; Lk = 1536; m0 = MCTX + b * 1024 + qb * 128;
    const int bh = b * 2 + (h >> 2);
    Kb = (const bf16_t*)(p.ws + OFF_KD) + (size_t)bh * 1536 * 64;
    Vb = (const bf16_t*)(p.ws + OFF_VTD) + (size_t)bh * 64 * 1536;
  } else {
    a -= 512;
    const int b = a >> 4; h = (a >> 1) & 7; const int qb = a & 1; Lk = 256; m0 = b * 256 + qb * 128;
    const int bh = b * 2 + (h >> 2);
    Kb = (const bf16_t*)(p.ws + OFF_KC) + (size_t)bh * 256 * 64;
    Vb = (const bf16_t*)(p.ws + OFF_VTC) + (size_t)bh * 64 * 256;
  }
  const bf16_t* Qn = (const bf16_t*)(p.ws + OFF_QN);
  bf16x8 qf[2][2];
#pragma unroll
  for (int jq = 0; jq < 2; ++jq)
#pragma unroll
    for (int ks = 0; ks < 2; ++ks)
      qf[jq][ks] = *(const bf16x8*)(Qn + (size_t)(m0 + wave * 32 + jq * 16 + fr) * 512 + h * 64 + ks * 32 + fq * 8);
  f32x4 o[4][2];
#pragma unroll
  for (int di = 0; di < 4; ++di)
#pragma unroll
    for (int jq = 0; jq < 2; ++jq) o[di][jq] = f32x4{0.f, 0.f, 0.f, 0.f};
  float mrow[2] = {-1e30f, -1e30f}, lrow[2] = {0.f, 0.f};
  const int nt = Lk >> 6;
  const int srow = tid >> 3, sch = tid & 7;
  const int woff = srow * 128 + ((sch ^ ((srow >> 1) & 7)) << 4);
  const int swz = fr >> 1;
  uint4 rk[2], rv[2];
#pragma unroll
  for (int it = 0; it < 2; ++it) {
    rk[it] = *(const uint4*)(Kb + (size_t)(srow + 32 * it) * 64 + sch * 8);
    rv[it] = *(const uint4*)(Vb + (size_t)(srow + 32 * it) * Lk + sch * 8);
  }
#pragma unroll
  for (int it = 0; it < 2; ++it) {
    *(uint4*)(smem + woff + it * 4096) = rk[it];
    *(uint4*)(smem + 8192 + woff + it * 4096) = rv[it];
  }
  __syncthreads();
#pragma unroll 1
  for (int kt = 0; kt < nt; ++kt) {
    const int cur = (kt & 1) * 16384;
    const bool more = (kt + 1) < nt;
    if (more) {
#pragma unroll
      for (int it = 0; it < 2; ++it) {
        rk[it] = *(const uint4*)(Kb + (size_t)((kt + 1) * 64 + srow + 32 * it) * 64 + sch * 8);
        rv[it] = *(const uint4*)(Vb + (size_t)(srow + 32 * it) * Lk + (kt + 1) * 64 + sch * 8);
      }
    }
    f32x4 s[4][2];
#pragma unroll
    for (int i = 0; i < 4; ++i)
#pragma unroll
      for (int jq = 0; jq < 2; ++jq) s[i][jq] = f32x4{0.f, 0.f, 0.f, 0.f};
#pragma unroll
    for (int ks = 0; ks < 2; ++ks) {
      const int co = ((ks * 4 + fq) ^ swz) << 4;
#pragma unroll
      for (int i = 0; i < 4; ++i) {
        const bf16x8 kf = *(const bf16x8*)(smem + cur + (i * 16 + fr) * 128 + co);
#pragma unroll
        for (int jq = 0; jq < 2; ++jq) s[i][jq] = __builtin_amdgcn_mfma_f32_16x16x32_bf16(kf, qf[jq][ks], s[i][jq], 0, 0, 0);
      }
    }
#pragma unroll
    for (int jq = 0; jq < 2; ++jq) {
      float mx = -1e30f;
#pragma unroll
      for (int i = 0; i < 4; ++i)
#pragma unroll
        for (int r = 0; r < 4; ++r) mx = fmaxf(mx, s[i][jq][r]);
      mx = fmaxf(mx, __shfl_xor(mx, 16));
      mx = fmaxf(mx, __shfl_xor(mx, 32));
      const float mnew = fmaxf(mrow[jq], mx);
      const float alpha = exp2f(mrow[jq] - mnew);
      mrow[jq] = mnew;
      float ls = 0.f;
#pragma unroll
      for (int i = 0; i < 4; ++i)
#pragma unroll
        for (int r = 0; r < 4; ++r) { const float e = exp2f(s[i][jq][r] - mnew); s[i][jq][r] = e; ls += e; }
      lrow[jq] = lrow[jq] * alpha + ls;
#pragma unroll
      for (int di = 0; di < 4; ++di)
#pragma unroll
        for (int r = 0; r < 4; ++r) o[di][jq][r] *= alpha;
    }
#pragma unroll
    for (int kk = 0; kk < 2; ++kk) {
      bf16x8 pf[2];
#pragma unroll
      for (int jq = 0; jq < 2; ++jq) {
        union { uint4 u; bf16x8 v; } cv;
        cv.u = uint4{pack2(s[2 * kk][jq][0], s[2 * kk][jq][1]), pack2(s[2 * kk][jq][2], s[2 * kk][jq][3]),
                     pack2(s[2 * kk + 1][jq][0], s[2 * kk + 1][jq][1]), pack2(s[2 * kk + 1][jq][2], s[2 * kk + 1][jq][3])};
        pf[jq] = cv.v;
      }
      const int c0 = ((4 * kk + (fq >> 1)) ^ swz) << 4;
      const int c1 = ((4 * kk + 2 + (fq >> 1)) ^ swz) << 4;
      const int wi = (fq & 1) * 8;
#pragma unroll
      for (int di = 0; di < 4; ++di) {
        const unsigned char* vrow = smem + cur + 8192 + (di * 16 + fr) * 128;
        union { uint2 u[2]; bf16x8 v; } cv;
        cv.u[0] = *(const uint2*)(vrow + c0 + wi);
        cv.u[1] = *(const uint2*)(vrow + c1 + wi);
#pragma unroll
        for (int jq = 0; jq < 2; ++jq) o[di][jq] = __builtin_amdgcn_mfma_f32_16x16x32_bf16(cv.v, pf[jq], o[di][jq], 0, 0, 0);
      }
    }
    if (more) {
      const int nxt = 16384 - cur;
#pragma unroll
      for (int it = 0; it < 2; ++it) {
        *(uint4*)(smem + nxt + woff + it * 4096) = rk[it];
        *(uint4*)(smem + nxt + 8192 + woff + it * 4096) = rv[it];
      }
    }
    __syncthreads();
  }
  bf16_t* att = (bf16_t*)(p.ws + OFF_ATT);
#pragma unroll
  for (int jq = 0; jq < 2; ++jq) {
    float lt = lrow[jq];
    lt += __shfl_xor(lt, 16);
    lt += __shfl_xor(lt, 32);
    const float inv = 1.0f / lt;
    bf16_t* dst = att + (size_t)(m0 + wave * 32 + jq * 16 + fr) * 512 + h * 64 + 4 * fq;
#pragma unroll
    for (int di = 0; di < 4; ++di)
      *(uint2*)(dst + di * 16) = uint2{pack2(o[di][jq][0] * inv, o[di][jq][1] * inv), pack2(o[di][jq][2] * inv, o[di][jq][3] * inv)};
  }
}

DEVI int ssm_col_row(int sub, int j) {
  return sub < 8 ? MCTX + sub * 1024 + j * 16 : ((sub - 8) * 4 + (j >> 4)) * 256 + (j & 15) * 16;
}

DEVI void ssm_item(const Params& p, int l, int idx, unsigned char* smem) {
  const int g = idx / 12, sub = idx % 12;
  const int tid = opaque_tid(), lane = tid & 63, wave = tid >> 6, fr = lane & 15, fq = lane >> 4;
  const bf16_t* AC = (const bf16_t*)(p.ws + OFF_SSM) + (size_t)(l * 32 + g) * SSM_EL;
  const bf16_t* W1 = AC + 256 * 512;
  const bf16_t* z = (const bf16_t*)(p.ws + OFF_Z);
  const int ucol = 768 + g * 16;
  size_t ubase[4];
#pragma unroll
  for (int jt = 0; jt < 4; ++jt) ubase[jt] = (size_t)ssm_col_row(sub, jt * 16 + fr) * 1792 + ucol;
  f32x4 acc[4][4];
  zero_acc(acc);
#pragma unroll 1
  for (int ks = 0; ks < 8; ++ks) {
    const int s = 2 * ks + (fq >> 1), m8 = (fq & 1) * 8;
    bf16x8 a[4], b[4];
#pragma unroll
    for (int i = 0; i < 4; ++i) a[i] = *(const bf16x8*)(W1 + (size_t)(wave * 64 + i * 16 + fr) * 256 + ks * 32 + fq * 8);
#pragma unroll
    for (int jt = 0; jt < 4; ++jt) b[jt] = *(const bf16x8*)(z + ubase[jt] + (size_t)s * 1792 + m8);
#pragma unroll
    for (int i = 0; i < 4; ++i)
#pragma unroll
      for (int jt = 0; jt < 4; ++jt) acc[i][jt] = __builtin_amdgcn_mfma_f32_16x16x32_bf16(a[i], b[jt], acc[i][jt], 0, 0, 0);
  }
#pragma unroll
  for (int i = 0; i < 4; ++i)
#pragma unroll
    for (int jt = 0; jt < 4; ++jt) {
      const int j = jt * 16 + fr;
      const int ch = (wave * 64 + i * 16 + 4 * fq) >> 2;
      *(f32x4*)(smem + j * 1024 + ((ch ^ (j & 15)) << 4)) = acc[i][jt];
    }
  __syncthreads();
  if (tid < 128) {
    const int dir = tid >> 6, pp = tid & 63;
    const float2 lam = ((const float2*)(p.ws + OFF_LAM16))[((l * 2 + dir) * 32 + g) * 64 + pp];
    const int nseq = sub < 8 ? 1 : 4, nch = sub < 8 ? 64 : 16;
    const int ch = (dir * 64 + pp) >> 1, wi = (pp & 1) * 8;
    for (int q = 0; q < nseq; ++q) {
      float hr = 0.f, hi = 0.f;
      if (sub < 8) {
        const float* h0 = p.in[5] + ((size_t)(((sub * 2 + l) * 2 + dir) * 32 + g) * 64 + pp) * 2;
        hr = h0[0]; hi = h0[1];
      }
      for (int c = 0; c < nch; ++c) {
        const int j = q * nch + (dir == 0 ? c : nch - 1 - c);
        float2* f = (float2*)(smem + j * 1024 + ((ch ^ (j & 15)) << 4) + wi);
        const float2 F = *f;
        *f = float2{hr, hi};
        const float nr = lam.x * hr - lam.y * hi + F.x;
        const float ni = lam.x * hi + lam.y * hr + F.y;
        hr = nr; hi = ni;
      }
      if (sub >= 8) {
        const int b = (sub - 8) * 4 + q;
        float* st = p.out + OUT_ST + ((size_t)(((b * 2 + l) * 2 + dir) * 32 + g) * 64 + pp) * 2;
        st[0] = hr; st[1] = hi;
      }
    }
  }
  __syncthreads();
  zero_acc(acc);
#pragma unroll 1
  for (int ks = 0; ks < 16; ++ks) {
    bf16x8 a[4], b[4];
#pragma unroll
    for (int i = 0; i < 4; ++i) a[i] = *(const bf16x8*)(AC + (size_t)(wave * 64 + i * 16 + fr) * 512 + ks * 32 + fq * 8);
    if (ks < 8) {
      const int s = 2 * ks + (fq >> 1), m8 = (fq & 1) * 8;
#pragma unroll
      for (int jt = 0; jt < 4; ++jt) b[jt] = *(const bf16x8*)(z + ubase[jt] + (size_t)s * 1792 + m8);
    } else {
      const int c0 = ((ks - 8) * 32 + fq * 8) >> 2;
#pragma unroll
      for (int jt = 0; jt < 4; ++jt) {
        const int j = jt * 16 + fr;
        const f32x4 v0 = *(const f32x4*)(smem + j * 1024 + ((c0 ^ (j & 15)) << 4));
        const f32x4 v1 = *(const f32x4*)(smem + j * 1024 + (((c0 + 1) ^ (j & 15)) << 4));
        union { uint4 u; bf16x8 v; } cv;
        cv.u = uint4{pack2(v0[0], v0[1]), pack2(v0[2], v0[3]), pack2(v1[0], v1[1]), pack2(v1[2], v1[3])};
        b[jt] = cv.v;
      }
    }
#pragma unroll
    for (int i = 0; i < 4; ++i)
#pragma unroll
      for (int jt = 0; jt < 4; ++jt) acc[i][jt] = __builtin_amdgcn_mfma_f32_16x16x32_bf16(a[i], b[jt], acc[i][jt], 0, 0, 0);
  }
  bf16_t* sp = (bf16_t*)(p.ws + OFF_SSMP);
  const float4 dv = *(const float4*)(p.in[19] + l * 512 + g * 16 + 4 * fq);
#pragma unroll
  for (int i = 0; i < 4; ++i) {
    const int t = wave * 4 + i;
#pragma unroll
    for (int jt = 0; jt < 4; ++jt) {
      const size_t row = (size_t)ssm_col_row(sub, jt * 16 + fr) + t;
      const uint2 uu = *(const uint2*)(z + row * 1792 + ucol + 4 * fq);
      const float y0 = gelu_tanh(acc[i][jt][0] + dv.x * bf2f(uu.x & 0xffff));
      const float y1 = gelu_tanh(acc[i][jt][1] + dv.y * bf2f(uu.x >> 16));
      const float y2 = gelu_tanh(acc[i][jt][2] + dv.z * bf2f(uu.y & 0xffff));
      const float y3 = gelu_tanh(acc[i][jt][3] + dv.w * bf2f(uu.y >> 16));
      *(uint2*)(sp + row * 512 + g * 16 + 4 * fq) = uint2{pack2(y0, y1), pack2(y2, y3)};
      asm volatile("" ::: "memory");
    }
  }
  __syncthreads();
}

#define TILE_IDS \
  const int tid = opaque_tid(), lane = tid & 63, wave = tid >> 6, wp = wave >> 1, wq = wave & 1, fr = lane & 15, fq = lane >> 4; \
  (void)tid; (void)wp; (void)wq; (void)fr; (void)fq;

DEVI void z_tile(const Params& p, int l, int t, unsigned char* smem) {
  TILE_IDS
  const int mt = t / 14, nt = t % 14;
  const bf16_t* P = (const bf16_t*)(p.ws + OFF_W) + (size_t)l * WL_TOT + WL_IN + (size_t)nt * 128 * 1024;
  const bf16_t* Q = (const bf16_t*)(p.ws + OFF_U) + (size_t)mt * 128 * 1024;
  f32x4 acc[4][4];
  zero_acc(acc);
  gemm_core(P, 1024, Q, 1024, 1024, acc, smem);
  bf16_t* z = (bf16_t*)(p.ws + OFF_Z);
#pragma unroll
  for (int i = 0; i < 4; ++i)
#pragma unroll
    for (int j = 0; j < 4; ++j) {
      const int n = nt * 128 + wp * 64 + i * 16 + 4 * fq, m = mt * 128 + wq * 64 + j * 16 + fr;
      *(uint2*)(z + (size_t)m * 1792 + n) = uint2{pack2(acc[i][j][0], acc[i][j][1]), pack2(acc[i][j][2], acc[i][j][3])};
    }
}

DEVI void four1_tile(const Params& p, int t, unsigned char* smem) {
  TILE_IDS
  const int mt = t >> 3, grp = (t >> 1) & 3, half = t & 1;
  const bf16_t* P = (const bf16_t*)(p.ws + OFF_Z) + (size_t)mt * 128 * 1792 + 1280 + grp * 128;
  const bf16_t* Q = (const bf16_t*)(p.ws + OFF_DFT128) + (size_t)half * 128 * 128;
  f32x4 acc[4][4];
  zero_acc(acc);
  gemm_core(P, 1792, Q, 128, 128, acc, smem);
  bf16_t* GT = (bf16_t*)(p.ws + OFF_GT);
  const int m0 = mt * 128;
  int L; bf16_t* gb; int lpos0;
  if (m0 < MCTX) { L = 256; gb = GT + (size_t)(m0 >> 8) * 512 * 512; lpos0 = m0 & 255; }
  else { L = 1024; gb = GT + (size_t)16 * 512 * 512 + (size_t)((m0 - MCTX) >> 10) * 512 * 2048; lpos0 = (m0 - MCTX) & 1023; }
#pragma unroll
  for (int i = 0; i < 4; ++i)
#pragma unroll
    for (int j = 0; j < 4; ++j) {
      const int lp = lpos0 + wp * 64 + i * 16 + 4 * fq;
      const int cp = wq * 64 + j * 16 + fr;
      *(uint2*)(gb + (size_t)(grp * 128 + cp) * (2 * L) + half * L + lp) =
          uint2{pack2(acc[i][j][0], acc[i][j][1]), pack2(acc[i][j][2], acc[i][j][3])};
    }
}

DEVI void four2_tile(const Params& p, int t, unsigned char* smem) {
  TILE_IDS
  const bf16_t* GT = (const bf16_t*)(p.ws + OFF_GT);
  const bf16_t *P, *Q; int K, mrow0, nt; float scale;
  if (t < 128) {
    const int b = t >> 3, pt = (t >> 2) & 1; nt = t & 3;
    P = GT + (size_t)b * 512 * 512 + (size_t)nt * 128 * 512;
    Q = (const bf16_t*)(p.ws + OFF_T256) + (size_t)pt * 128 * 512;
    K = 512; mrow0 = b * 256 + pt * 128; scale = 0.005524271728019903f;
  } else {
    t -= 128;
    const int b = t >> 5, pt = (t >> 2) & 7; nt = t & 3;
    P = GT + (size_t)16 * 512 * 512 + (size_t)b * 512 * 2048 + (size_t)nt * 128 * 2048;
    Q = (const bf16_t*)(p.ws + OFF_T1024) + (size_t)pt * 128 * 2048;
    K = 2048; mrow0 = MCTX + b * 1024 + pt * 128; scale = 0.0027621358640099515f;
  }
  f32x4 acc[4][4];
  zero_acc(acc);
  gemm_core(P, K, Q, K, K, acc, smem);
  bf16_t* fo = (bf16_t*)(p.ws + OFF_FOUR);
#pragma unroll
  for (int i = 0; i < 4; ++i)
#pragma unroll
    for (int j = 0; j < 4; ++j) {
      const int n = nt * 128 + wp * 64 + i * 16 + 4 * fq, m = mrow0 + wq * 64 + j * 16 + fr;
      *(uint2*)(fo + (size_t)m * 512 + n) =
          uint2{pack2(acc[i][j][0] * scale, acc[i][j][1] * scale), pack2(acc[i][j][2] * scale, acc[i][j][3] * scale)};
    }
}

DEVI void glu_tile(const Params& p, int l, int t, unsigned char* smem) {
  TILE_IDS
  const int mt = t >> 2, nt = t & 3;
  const bf16_t* P = (const bf16_t*)(p.ws + OFF_W) + (size_t)l * WL_TOT + WL_GLU + (size_t)nt * 128 * 512;
  const bf16_t* sp = (const bf16_t*)(p.ws + OFF_SSMP);
  const bf16_t* Q = sp + (size_t)mt * 128 * 512;
  f32x4 acc[4][4];
  zero_acc(acc);
  gemm_core(P, 512, Q, 512, 512, acc, smem);
  bf16_t* sg = (bf16_t*)(p.ws + OFF_SSMG);
#pragma unroll
  for (int i = 0; i < 4; ++i)
#pragma unroll
    for (int j = 0; j < 4; ++j) {
      const int n = nt * 128 + wp * 64 + i * 16 + 4 * fq, m = mt * 128 + wq * 64 + j * 16 + fr;
      const float4 bg = *(const float4*)(p.in[21] + l * 512 + n);
      const uint2 yy = *(const uint2*)(sp + (size_t)m * 512 + n);
      const float y0 = bf2f(yy.x & 0xffff), y1 = bf2f(yy.x >> 16), y2 = bf2f(yy.y & 0xffff), y3 = bf2f(yy.y >> 16);
      *(uint2*)(sg + (size_t)m * 512 + n) =
          uint2{pack2(y0 * sigmoidf_(acc[i][j][0] + bg.x), y1 * sigmoidf_(acc[i][j][1] + bg.y)),
                pack2(y2 * sigmoidf_(acc[i][j][2] + bg.z), y3 * sigmoidf_(acc[i][j][3] + bg.w))};
      asm volatile("" ::: "memory");
    }
}

DEVI void merged_tile(const Params& p, int l, int t, unsigned char* smem) {
  TILE_IDS
  const int mt = t >> 3, nt = t & 7;
  const bf16_t* wl = (const bf16_t*)(p.ws + OFF_W) + (size_t)l * WL_TOT;
  const bf16_t* u = (const bf16_t*)(p.ws + OFF_U) + (size_t)mt * 128 * 1024;
  bf16_t* mo = (bf16_t*)(p.ws + OFF_GT);
#pragma unroll 1
  for (int br = 0; br < 3; ++br) {
    uint2 sg[4][4];
    {
      f32x4 acc[4][4];
      zero_acc(acc);
      gemm_core(wl + WL_IN + (size_t)(1792 + br * 1024 + nt * 128) * 1024, 1024, u, 1024, 1024, acc, smem);
#pragma unroll
      for (int i = 0; i < 4; ++i)
#pragma unroll
        for (int j = 0; j < 4; ++j)
          sg[i][j] = uint2{pack2(sigmoidf_(acc[i][j][0]), sigmoidf_(acc[i][j][1])), pack2(sigmoidf_(acc[i][j][2]), sigmoidf_(acc[i][j][3]))};
    }
    {
      f32x4 acc[4][4];
      zero_acc(acc);
      const bf16_t* X = (const bf16_t*)(p.ws + OFF_ATT) + (size_t)br * M * 512 + (size_t)mt * 128 * 512;
      gemm_core(wl + WL_BR + (size_t)br * 1024 * 512 + (size_t)nt * 128 * 512, 512, X, 512, 512, acc, smem);
#pragma unroll
      for (int i = 0; i < 4; ++i)
#pragma unroll
        for (int j = 0; j < 4; ++j) {
          const int n = nt * 128 + wp * 64 + i * 16 + 4 * fq, m = mt * 128 + wq * 64 + j * 16 + fr;
          uint2* dst = (uint2*)(mo + (size_t)m * 1024 + n);
          float v0 = bf2f(sg[i][j].x & 0xffff) * acc[i][j][0];
          float v1 = bf2f(sg[i][j].x >> 16) * acc[i][j][1];
          float v2 = bf2f(sg[i][j].y & 0xffff) * acc[i][j][2];
          float v3 = bf2f(sg[i][j].y >> 16) * acc[i][j][3];
          if (br > 0) {
            const uint2 o = *dst;
            v0 += bf2f(o.x & 0xffff); v1 += bf2f(o.x >> 16); v2 += bf2f(o.y & 0xffff); v3 += bf2f(o.y >> 16);
          }
          *dst = uint2{pack2(v0, v1), pack2(v2, v3)};
          asm volatile("" ::: "memory");
        }
    }
  }
}

DEVI void resid_tile(const Params& p, int l, int t, int which, unsigned char* smem) {
  TILE_IDS
  const int mt = t >> 3, nt = t & 7;
  const bf16_t* wl = (const bf16_t*)(p.ws + OFF_W) + (size_t)l * WL_TOT;
  f32x4 acc[4][4];
  zero_acc(acc);
  if (which == 0)
    gemm_core(wl + WL_OUT + (size_t)nt * 128 * 1024, 1024, (const bf16_t*)(p.ws + OFF_GT) + (size_t)mt * 128 * 1024, 1024, 1024, acc, smem);
  else
    gemm_core(wl + WL_DN + (size_t)nt * 128 * 2816, 2816, (const bf16_t*)(p.ws + OFF_HG) + (size_t)mt * 128 * 2816, 2816, 2816, acc, smem);
  const float* modl = (const float*)(p.ws + OFF_MOD) + (size_t)l * 9 * 6144 + (which == 0 ? 2048 : 5120);
  const bool from_in = (l == 0 && which == 0);
#pragma unroll
  for (int i = 0; i < 4; ++i)
#pragma unroll
    for (int j = 0; j < 4; ++j) {
      const int n = nt * 128 + wp * 64 + i * 16 + 4 * fq, m = mt * 128 + wq * 64 + j * 16 + fr;
      const float4 gg = *(const float4*)(modl + (size_t)modrow(m) * 6144 + n);
      float* dst = p.out + (size_t)m * 1024 + n;
      const float4 xv = from_in ? *(const float4*)(xin_row(p, m) + n) : *(const float4*)dst;
      *(float4*)dst = float4{ALPHA * xv.x + gg.x * acc[i][j][0], ALPHA * xv.y + gg.y * acc[i][j][1],
                             ALPHA * xv.z + gg.z * acc[i][j][2], ALPHA * xv.w + gg.w * acc[i][j][3]};
    }
}

DEVI void up_tile(const Params& p, int l, int t, unsigned char* smem) {
  TILE_IDS
  const int mt = t / 44, nt = t % 44;
  const bf16_t* P = (const bf16_t*)(p.ws + OFF_W) + (size_t)l * WL_TOT + WL_UP + (size_t)nt * 128 * 1024;
  const bf16_t* Q = (const bf16_t*)(p.ws + OFF_U) + (size_t)mt * 128 * 1024;
  f32x4 acc[4][4];
  zero_acc(acc);
  gemm_core(P, 1024, Q, 1024, 1024, acc, smem);
  bf16_t* T = (bf16_t*)smem;
#pragma unroll
  for (int i = 0; i < 4; ++i)
#pragma unroll
    for (int j = 0; j < 4; ++j) {
      const int n = wp * 64 + i * 16 + 4 * fq, m = wq * 64 + j * 16 + fr;
      *(uint2*)(T + m * 136 + n) = uint2{pack2(acc[i][j][0], acc[i][j][1]), pack2(acc[i][j][2], acc[i][j][3])};
    }
  __syncthreads();
  {
    const int c = tid & 63, r0 = (tid >> 6) * 32;
    const int ca = nt * 64 + c, cb = 2816 + nt * 64 + c;
    const float* cw = p.in[29] + (size_t)l * 3 * 5632;
    const float* cbias = p.in[30] + (size_t)l * 5632;
    const float wa0 = cw[ca], wa1 = cw[5632 + ca], wa2 = cw[2 * 5632 + ca], ba = cbias[ca];
    const float wb0 = cw[cb], wb1 = cw[5632 + cb], wb2 = cw[2 * 5632 + cb], bb = cbias[cb];
    bf16_t* hg = (bf16_t*)(p.ws + OFF_HG) + (size_t)(mt * 128) * 2816 + nt * 64 + c;
    float pa = r0 > 0 ? bf2f(T[(r0 - 1) * 136 + c]) : 0.f, pb = r0 > 0 ? bf2f(T[(r0 - 1) * 136 + 64 + c]) : 0.f;
    float ca_ = bf2f(T[r0 * 136 + c]), cb_ = bf2f(T[r0 * 136 + 64 + c]);
    for (int r = r0; r < r0 + 32; ++r) {
      const float na = r < 127 ? bf2f(T[(r + 1) * 136 + c]) : 0.f, nb = r < 127 ? bf2f(T[(r + 1) * 136 + 64 + c]) : 0.f;
      if (r > 0 && r < 127) {
        const float ha = wa0 * pa + wa1 * ca_ + wa2 * na + ba;
        const float hb = wb0 * pb + wb1 * cb_ + wb2 * nb + bb;
        hg[(size_t)r * 2816] = f2bf(ha * sigmoidf_(ha) * hb);
      }
      pa = ca_; pb = cb_; ca_ = na; cb_ = nb;
    }
    bf16_t* edge = (bf16_t*)(p.ws + OFF_EDGE) + (size_t)mt * 4 * 5632;
    const int e = tid >> 6;
    const int er = e < 2 ? e : 124 + e;
    edge[(size_t)e * 5632 + ca] = T[er * 136 + c];
    edge[(size_t)e * 5632 + cb] = T[er * 136 + 64 + c];
  }
  __syncthreads();
}

DEVI void edge_item(const Params& p, int l, int idx) {
  const int mt = idx >> 1, bot = idx & 1;
  const int L = mt < 32 ? 256 : 1024;
  const int m = mt * 128 + (bot ? 127 : 0);
  const int mloc = mt < 32 ? m : m - MCTX;
  const int pos = mloc & (L - 1);
  const bf16_t* edge = (const bf16_t*)(p.ws + OFF_EDGE);
  const bf16_t *prev, *cur, *next;
  bool hasp, hasn;
  if (!bot) {
    hasp = pos != 0; hasn = true;
    prev = edge + ((size_t)(mt > 0 ? mt - 1 : 0) * 4 + 3) * 5632;
    cur = edge + ((size_t)mt * 4 + 0) * 5632;
    next = edge + ((size_t)mt * 4 + 1) * 5632;
  } else {
    hasp = true; hasn = pos != L - 1;
    prev = edge + ((size_t)mt * 4 + 2) * 5632;
    cur = edge + ((size_t)mt * 4 + 3) * 5632;
    next = edge + ((size_t)(mt < 95 ? mt + 1 : 95) * 4 + 0) * 5632;
  }
  const float* cw = p.in[29] + (size_t)l * 3 * 5632;
  const float* cbias = p.in[30] + (size_t)l * 5632;
  bf16_t* hg = (bf16_t*)(p.ws + OFF_HG) + (size_t)m * 2816;
  for (int c = opaque_tid(); c < 2816; c += 256) {
    const int cb = 2816 + c;
    const float pa = hasp ? bf2f(prev[c]) : 0.f, pb = hasp ? bf2f(prev[cb]) : 0.f;
    const float na = hasn ? bf2f(next[c]) : 0.f, nb = hasn ? bf2f(next[cb]) : 0.f;
    const float ha = cw[c] * pa + cw[5632 + c] * bf2f(cur[c]) + cw[2 * 5632 + c] * na + cbias[c];
    const float hb = cw[cb] * pb + cw[5632 + cb] * bf2f(cur[cb]) + cw[2 * 5632 + cb] * nb + cbias[cb];
    hg[c] = f2bf(ha * sigmoidf_(ha) * hb);
  }
}

__global__ void __launch_bounds__(256, 2) trunk_megakernel(Params p) {
  cg::grid_group grid = cg::this_grid();
  __shared__ __attribute__((aligned(16))) unsigned char smem[65536];
  const int G = gridDim.x, bid = blockIdx.x;

  for (int i = bid; i < 64 + 192 + 8064 + 560; i += G) {
    if (i < 64) ssm_pre_item(p, i, smem);
    else if (i < 256) mod_item(p, i - 64, smem);
    else if (i < 256 + 8064) weights_item(p, i - 256, smem);
    else table_item(p, i - 256 - 8064);
  }
  grid.sync();
  for (int r = bid * 4 + (opaque_tid() >> 6); r < M; r += G * 4) modulate0_row(p, r);
  grid.sync();

  for (int l = 0; l < 2; ++l) {
    for (int t = bid; t < 96 * 14; t += G) z_tile(p, l, t, smem);
    grid.sync();
    for (int i = bid; i < 384 + 768 + 4096; i += G) {
      if (i < 384) ssm_item(p, l, i, smem);
      else if (i < 384 + 768) four1_tile(p, i - 384, smem);
      else prep_token(p, l, (i - 1152) * 4 + (opaque_tid() >> 6));
    }
    grid.sync();
    for (int i = bid; i < 768 + 384 + 384; i += G) {
      if (i < 768) attn_item(p, i, smem);
      else if (i < 768 + 384) four2_tile(p, i - 768, smem);
      else glu_tile(p, l, i - 1152, smem);
    }
    grid.sync();
    for (int t = bid; t < 768; t += G) merged_tile(p, l, t, smem);
    grid.sync();
    for (int t = bid; t < 768; t += G) resid_tile(p, l, t, 0, smem);
    grid.sync();
    {
      const float* modl = (const float*)(p.ws + OFF_MOD) + (size_t)l * 9 * 6144;
      for (int r = bid * 4 + (opaque_tid() >> 6); r < M; r += G * 4) ln_row(p, r, p.in[26] + l * 1024, p.in[27] + l * 1024, modl, 3072, 4096, true);
    }
    grid.sync();
    for (int t = bid; t < 96 * 44; t += G) up_tile(p, l, t, smem);
    grid.sync();
    for (int i = bid; i < 192; i += G) edge_item(p, l, i);
    grid.sync();
    for (int t = bid; t < 768; t += G) resid_tile(p, l, t, 1, smem);
    grid.sync();
    {
      const float* modn = (const float*)(p.ws + OFF_MOD) + (size_t)(l + 1 < 2 ? l + 1 : l) * 9 * 6144;
      for (int r = bid * 4 + (opaque_tid() >> 6); r < M; r += G * 4) ln_row(p, r, p.in[32] + l * 1024, p.in[33] + l * 1024, modn, 0, 1024, l == 0);
    }
    if (l == 0) grid.sync();
  }
}

extern "C" void kernel_launch(void* const* d_in, const int* in_sizes, int n_in,
                              void* d_out, int out_size, void* d_ws, size_t ws_size,
                              hipStream_t stream) {
  static int grid_blocks = 0;
  if (!grid_blocks) {
    int dev = 0, cus = 0, per_cu = 0;
    (void)hipGetDevice(&dev);
    (void)hipDeviceGetAttribute(&cus, hipDeviceAttributeMultiprocessorCount, dev);
    (void)hipOccupancyMaxActiveBlocksPerMultiprocessor(&per_cu, trunk_megakernel, 256, 0);
    if (per_cu < 1) per_cu = 1;
    grid_blocks = cus * per_cu;
  }
  Params p{};
  for (int i = 0; i < 34; ++i) p.in[i] = (const float*)d_in[i];
  p.out = (float*)d_out;
  p.ws = (unsigned char*)d_ws;
  void* args[] = {&p};
  hipError_t e = hipLaunchCooperativeKernel((void*)trunk_megakernel, dim3(grid_blocks), dim3(256), args, 0, stream);
  if (e != hipSuccess) fprintf(stderr, "cooperative launch failed: %s (grid %d)\n", hipGetErrorString(e), grid_blocks);
}
```

```cpp
#include <hip/hip_runtime.h>
#include <hip/hip_cooperative_groups.h>
#include <cstdio>
#include <cstdint>
namespace cg = cooperative_groups;

typedef unsigned short bf16_t;
using bf16x8 = __attribute__((ext_vector_type(8))) short;
using f32x4 = __attribute__((ext_vector_type(4))) float;

#define DEVI __device__ __forceinline__

#ifndef REP_P0
#define REP_P0 1
#endif
#ifndef REP_L2
#define REP_L2 1
#endif
#ifndef REP_L3
#define REP_L3 1
#endif
#ifndef REP_L7
#define REP_L7 1
#endif
#ifndef REP_SYNC
#define REP_SYNC 0
#endif
constexpr int M = 12288;
constexpr int MCTX = 4096;
constexpr float ALPHA = 1.41421356237f;
constexpr float LN_EPS = 1e-6f;

constexpr size_t WL_IN = 0;
constexpr size_t WL_GLU = WL_IN + (size_t)4864 * 1024;
constexpr size_t WL_BR = WL_GLU + (size_t)512 * 512;
constexpr size_t WL_OUT = WL_BR + (size_t)3 * 1024 * 512;
constexpr size_t WL_UP = WL_OUT + (size_t)1024 * 1024;
constexpr size_t WL_DN = WL_UP + (size_t)5632 * 1024;
constexpr size_t WL_TOT = WL_DN + (size_t)1024 * 2816;
constexpr size_t OFF_W = 0;
constexpr size_t SSM_EL = 196608;
constexpr size_t OFF_SSM = OFF_W + 2 * WL_TOT * 2;
constexpr size_t OFF_LAM16 = OFF_SSM + 64 * SSM_EL * 2;
constexpr size_t OFF_T1024 = OFF_LAM16 + 2 * 2 * 32 * 64 * 8;
constexpr size_t OFF_T256 = OFF_T1024 + (size_t)1024 * 2048 * 2;
constexpr size_t OFF_DFT128 = OFF_T256 + (size_t)256 * 512 * 2;
constexpr size_t OFF_ROPE = OFF_DFT128 + (size_t)256 * 128 * 2;
constexpr size_t OFF_MOD = OFF_ROPE + (size_t)1024 * 32 * 8;
constexpr size_t OFF_U = OFF_MOD + (size_t)2 * 9 * 6144 * 4;
constexpr size_t OFF_R = OFF_U + (size_t)M * 1024 * 2;
constexpr size_t OFF_Z = OFF_R;
constexpr size_t OFF_ATT = OFF_R;
constexpr size_t OFF_SSMG = OFF_R + (size_t)M * 512 * 2;
constexpr size_t OFF_FOUR = OFF_R + (size_t)2 * M * 512 * 2;
constexpr size_t OFF_QN = OFF_Z + (size_t)M * 1792 * 2;
constexpr size_t OFF_KD = OFF_QN + (size_t)M * 512 * 2;
constexpr size_t OFF_VTD = OFF_KD + (size_t)16 * 1536 * 64 * 2;
constexpr size_t OFF_KC = OFF_VTD + (size_t)16 * 1536 * 64 * 2;
constexpr size_t OFF_VTC = OFF_KC + (size_t)32 * 256 * 64 * 2;
constexpr size_t OFF_SSMP = OFF_VTC + (size_t)32 * 256 * 64 * 2;
constexpr size_t OFF_GT = OFF_SSMP + (size_t)M * 512 * 2;
constexpr size_t OFF_HG = OFF_R;
constexpr size_t OFF_EDGE = OFF_HG + (size_t)M * 2816 * 2;
constexpr size_t OFF_BAR = OFF_GT + (size_t)M * 1024 * 2;
constexpr size_t WS_NEEDED = OFF_BAR + 16384;

constexpr size_t OUT_CK = (size_t)M * 1024;
constexpr size_t OUT_CV = OUT_CK + (size_t)16 * 2 * 256 * 128;
constexpr size_t OUT_ST = OUT_CV + (size_t)16 * 2 * 256 * 128;

struct Params {
  const float* in[34];
  float* out;
  unsigned char* ws;
};

DEVI int opaque_tid() {
  int t = threadIdx.x;
  asm volatile("" : "+v"(t));
  return t;
}
DEVI unsigned short f2bf(float f) {
  unsigned u = __float_as_uint(f);
  u += 0x7fffu + ((u >> 16) & 1u);
  return (unsigned short)(u >> 16);
}
DEVI float bf2f(unsigned short h) { return __uint_as_float(((unsigned)h) << 16); }
DEVI unsigned pack2(float a, float b) { return (unsigned)f2bf(a) | ((unsigned)f2bf(b) << 16); }
DEVI float sigmoidf_(float x) { return 1.0f / (1.0f + __expf(-x)); }
DEVI float gelu_tanh(float x) {
  float y = 0.7978845608028654f * (x + 0.044715f * x * x * x);
  float t = 1.0f - 2.0f / (1.0f + __expf(2.0f * y));
  return 0.5f * x * (1.0f + t);
}
DEVI void grp_tile(int idx, int NT, int& mt, int& nt) {
  const int gsz = 8 * NT, gid = idx / gsz, rem = idx - gid * gsz;
  mt = gid * 8 + (rem & 7); nt = rem >> 3;
}
DEVI int modrow(int m) { return m < MCTX ? 0 : 1 + ((m - MCTX) >> 10); }

DEVI void gemm_core(const bf16_t* P, int ldp, const bf16_t* Q, int ldq, int K, f32x4 (&acc)[4][4],
                    unsigned char* smem) {
  const int tid = opaque_tid(), lane = tid & 63, wave = tid >> 6, wp = wave >> 1, wq = wave & 1;
  const int fr = lane & 15, fq = lane >> 4;
  const int srow = tid >> 3, sch = tid & 7;
  const bf16_t* gp = P + (size_t)srow * ldp + sch * 8;
  const bf16_t* gq = Q + (size_t)srow * ldq + sch * 8;
  const int woff = srow * 128 + ((sch ^ ((srow >> 1) & 7)) << 4);
  const int swz = fr >> 1;
  const int poff = (wp * 64 + fr) * 128;
  const int qoff = 16384 + (wq * 64 + fr) * 128;
  uint4 rp[4], rq[4];
  const int nk = K >> 6;
#pragma unroll
  for (int it = 0; it < 4; ++it) {
    rp[it] = *(const uint4*)(gp + (size_t)(32 * it) * ldp);
    rq[it] = *(const uint4*)(gq + (size_t)(32 * it) * ldq);
  }
#pragma unroll
  for (int it = 0; it < 4; ++it) {
    *(uint4*)(smem + woff + it * 4096) = rp[it];
    *(uint4*)(smem + 16384 + woff + it * 4096) = rq[it];
  }
  __syncthreads();
#pragma unroll 1
  for (int kt = 0; kt < nk; ++kt) {
    const int cur = (kt & 1) * 32768;
    {
      const int kn = (kt + 1 < nk) ? kt + 1 : kt;
      const bf16_t* gp2 = gp + (size_t)kn * 64;
      const bf16_t* gq2 = gq + (size_t)kn * 64;
#pragma unroll
      for (int it = 0; it < 4; ++it) {
        rp[it] = *(const uint4*)(gp2 + (size_t)(32 * it) * ldp);
        rq[it] = *(const uint4*)(gq2 + (size_t)(32 * it) * ldq);
      }
    }
#pragma unroll
    for (int ks = 0; ks < 2; ++ks) {
      const int co = ((ks * 4 + fq) ^ swz) << 4;
      bf16x8 a[4], b[4];
#pragma unroll
      for (int i = 0; i < 4; ++i) a[i] = *(const bf16x8*)(smem + cur + poff + i * 2048 + co);
#pragma unroll
      for (int j = 0; j < 4; ++j) b[j] = *(const bf16x8*)(smem + cur + qoff + j * 2048 + co);
#pragma unroll
      for (int i = 0; i < 4; ++i)
#pragma unroll
        for (int j = 0; j < 4; ++j)
          acc[i][j] = __builtin_amdgcn_mfma_f32_16x16x32_bf16(a[i], b[j], acc[i][j], 0, 0, 0);
    }
    {
      const int nxt = 32768 - cur;
#pragma unroll
      for (int it = 0; it < 4; ++it) {
        *(uint4*)(smem + nxt + woff + it * 4096) = rp[it];
        *(uint4*)(smem + nxt + 16384 + woff + it * 4096) = rq[it];
      }
    }
    __syncthreads();
  }
}

DEVI void zero_acc(f32x4 (&acc)[4][4]) {
#pragma unroll
  for (int i = 0; i < 4; ++i)
#pragma unroll
    for (int j = 0; j < 4; ++j) acc[i][j] = f32x4{0.f, 0.f, 0.f, 0.f};
}

DEVI void transpose_tile(const float* W, int K, int N, bf16_t* WT, int kt, int nt, int mode, unsigned char* smem) {
  float* t = (float*)smem;
  const int tid = opaque_tid();
  {
    const int r = tid >> 4, c4 = tid & 15;
#pragma unroll
    for (int it = 0; it < 4; ++it) {
      float4 v = *(const float4*)(W + (size_t)(kt * 64 + r + 16 * it) * N + nt * 64 + c4 * 4);
      float* d = t + (r + 16 * it) * 65 + c4 * 4;
      d[0] = v.x; d[1] = v.y; d[2] = v.z; d[3] = v.w;
    }
  }
  __syncthreads();
  {
    const int n = tid >> 2, kq = tid & 3;
    unsigned w[8];
#pragma unroll
    for (int e = 0; e < 8; ++e) w[e] = pack2(t[(kq * 16 + 2 * e) * 65 + n], t[(kq * 16 + 2 * e + 1) * 65 + n]);
    int c = nt * 64 + n, row = c;
    if (mode == 1) {
      int half = c >= 2816 ? 1 : 0;
      int cc = c - half * 2816;
      row = (cc >> 6) * 128 + half * 64 + (cc & 63);
    }
    uint4* dst = (uint4*)(WT + (size_t)row * K + kt * 64 + kq * 16);
    dst[0] = uint4{w[0], w[1], w[2], w[3]};
    dst[1] = uint4{w[4], w[5], w[6], w[7]};
  }
  __syncthreads();
}

DEVI void weights_item(const Params& p, int idx, unsigned char* smem) {
  const int l = idx / 4032;
  int t = idx - l * 4032;
  bf16_t* wl = (bf16_t*)(p.ws + OFF_W) + (size_t)l * WL_TOT;
  if (t < 1216) { transpose_tile(p.in[9] + (size_t)l * 1024 * 4864, 1024, 4864, wl + WL_IN, t / 76, t % 76, 0, smem); return; }
  t -= 1216;
  if (t < 64) { transpose_tile(p.in[20] + (size_t)l * 512 * 512, 512, 512, wl + WL_GLU, t / 8, t % 8, 0, smem); return; }
  t -= 64;
  if (t < 384) {
    const int br = t / 128; t -= br * 128;
    transpose_tile(p.in[22 + br] + (size_t)l * 512 * 1024, 512, 1024, wl + WL_BR + (size_t)br * 1024 * 512, t / 16, t % 16, 0, smem);
    return;
  }
  t -= 384;
  if (t < 256) { transpose_tile(p.in[25] + (size_t)l * 1024 * 1024, 1024, 1024, wl + WL_OUT, t / 16, t % 16, 0, smem); return; }
  t -= 256;
  if (t < 1408) { transpose_tile(p.in[28] + (size_t)l * 1024 * 5632, 1024, 5632, wl + WL_UP, t / 88, t % 88, 1, smem); return; }
  t -= 1408;
  transpose_tile(p.in[31] + (size_t)l * 2816 * 1024, 2816, 1024, wl + WL_DN, t / 16, t % 16, 0, smem);
}

DEVI void mod_item(const Params& p, int idx, unsigned char* smem) {
  const int l = idx / 96, nt = idx % 96;
  float* sc = (float*)smem;
  float* red = (float*)(smem + 36864);
  const int tid = opaque_tid();
  for (int e = tid; e < 9 * 1024; e += 256) {
    const int r = e >> 10, k = e & 1023;
    const float v = (r == 0) ? p.in[6][k] : p.in[2][(r - 1) * 1024 + k];
    sc[e] = v * sigmoidf_(v);
  }
  __syncthreads();
  const int kq = tid >> 6, col = tid & 63;
  const float* w = p.in[7] + (size_t)l * 1024 * 6144 + (size_t)(kq * 256) * 6144 + nt * 64 + col;
  float acc[9];
#pragma unroll
  for (int r = 0; r < 9; ++r) acc[r] = 0.f;
  for (int k0 = 0; k0 < 256; k0 += 8) {
    float wv[8];
#pragma unroll
    for (int e = 0; e < 8; ++e) wv[e] = w[(size_t)(k0 + e) * 6144];
#pragma unroll
    for (int e = 0; e < 8; ++e)
#pragma unroll
      for (int r = 0; r < 9; ++r) acc[r] += sc[r * 1024 + kq * 256 + k0 + e] * wv[e];
  }
#pragma unroll
  for (int r = 0; r < 9; ++r) red[(kq * 9 + r) * 64 + col] = acc[r];
  __syncthreads();
  float* mod = (float*)(p.ws + OFF_MOD) + (size_t)l * 9 * 6144;
  for (int e = tid; e < 9 * 64; e += 256) {
    const int r = e >> 6, c = e & 63;
    float s = red[(0 * 9 + r) * 64 + c] + red[(1 * 9 + r) * 64 + c] + red[(2 * 9 + r) * 64 + c] + red[(3 * 9 + r) * 64 + c];
    mod[r * 6144 + nt * 64 + c] = s + p.in[8][l * 6144 + nt * 64 + c];
  }
  __syncthreads();
}

DEVI void ssm_pre_item(const Params& p, int idx, unsigned char* smem) {
  const int l = idx >> 5, g = idx & 31;
  const int tid = opaque_tid();
  float2* Lpow = (float2*)smem;
  float2* Bbar = (float2*)(smem + 17408);
  float* Kc = (float*)(smem + 17408 + 16384);
  const float* a_re = p.in[12]; const float* a_im = p.in[13]; const float* log_dt = p.in[14];
  const float* b_re = p.in[15]; const float* b_im = p.in[16]; const float* c_re = p.in[17]; const float* c_im = p.in[18];
  for (int e = tid; e < 2 * 17 * 64; e += 256) {
    const int dir = e / (17 * 64), tau = (e >> 6) % 17, pp = e & 63;
    const int ai = ((l * 2 + dir) * 32 + g) * 64 + pp;
    const float dt = expf(log_dt[(l * 2 + dir) * 32 + g]);
    const float mag = expf(a_re[ai] * dt * (float)tau);
    const float ang = a_im[ai] * dt * (float)tau;
    float s, c; sincosf(ang, &s, &c);
    Lpow[e] = float2{mag * c, mag * s};
    if (tau == 16) ((float2*)(p.ws + OFF_LAM16))[ai] = float2{mag * c, mag * s};
  }
  for (int e = tid; e < 2 * 64 * 16; e += 256) {
    const int dir = e >> 10, pp = (e >> 4) & 63, n = e & 15;
    const int ai = ((l * 2 + dir) * 32 + g) * 64 + pp;
    const float dt = expf(log_dt[(l * 2 + dir) * 32 + g]);
    const float ar = a_re[ai], aim = a_im[ai];
    const float mag = expf(ar * dt);
    float s, c; sincosf(aim * dt, &s, &c);
    const float nr = mag * c - 1.0f, ni = mag * s;
    const float den = ar * ar + aim * aim;
    const float fr_ = (nr * ar + ni * aim) / den, fi_ = (ni * ar - nr * aim) / den;
    const float br = b_re[(size_t)ai * 16 + n], bi = b_im[(size_t)ai * 16 + n];
    Bbar[e] = float2{fr_ * br - fi_ * bi, fr_ * bi + fi_ * br};
  }
  __syncthreads();
  for (int dir = 0; dir < 2; ++dir) {
    const int tau = tid >> 4, n = tid & 15;
    float acc[16];
#pragma unroll
    for (int m = 0; m < 16; ++m) acc[m] = 0.f;
    const size_t cbase = ((size_t)((l * 2 + dir) * 32 + g) * 16 + n) * 64;
    for (int pp = 0; pp < 64; ++pp) {
      const float cr = c_re[cbase + pp], ci = c_im[cbase + pp];
      const float2 lp = Lpow[(dir * 17 + tau) * 64 + pp];
      const float gr = cr * lp.x - ci * lp.y, gi = cr * lp.y + ci * lp.x;
#pragma unroll
      for (int m = 0; m < 16; ++m) {
        const float2 bb = Bbar[(dir * 64 + pp) * 16 + m];
        acc[m] += gr * bb.x - gi * bb.y;
      }
    }
    const int delta = dir == 0 ? 15 - tau : 15 + tau;
#pragma unroll
    for (int m = 0; m < 16; ++m) {
      if (dir == 1 && tau == 0) Kc[(delta * 16 + n) * 16 + m] += acc[m];
      else Kc[(delta * 16 + n) * 16 + m] = acc[m];
    }
    __syncthreads();
  }
  bf16_t* AC = (bf16_t*)(p.ws + OFF_SSM) + (size_t)idx * SSM_EL;
  bf16_t* W1 = AC + 256 * 512;
  for (int v = tid; v < 256 * 64; v += 256) {
    const int row = v >> 6, kc = v & 63;
    const int t = row >> 4, n = row & 15;
    float val[8];
    if (kc < 32) {
      const int s = kc >> 1, m0 = (kc & 1) * 8;
      const int delta = s - t + 15;
#pragma unroll
      for (int e = 0; e < 8; ++e) val[e] = Kc[(delta * 16 + n) * 16 + m0 + e];
    } else {
      const int dir = kc >= 48 ? 1 : 0;
      const int p0 = ((kc - 32) & 15) * 4;
      const int tau = dir == 0 ? t + 1 : 16 - t;
      const size_t cbase = ((size_t)((l * 2 + dir) * 32 + g) * 16 + n) * 64;
#pragma unroll
      for (int e = 0; e < 4; ++e) {
        const float cr = c_re[cbase + p0 + e], ci = c_im[cbase + p0 + e];
        const float2 lp = Lpow[(dir * 17 + tau) * 64 + p0 + e];
        val[2 * e] = cr * lp.x - ci * lp.y;
        val[2 * e + 1] = -(cr * lp.y + ci * lp.x);
      }
    }
    *(uint4*)(AC + (size_t)row * 512 + kc * 8) =
        uint4{pack2(val[0], val[1]), pack2(val[2], val[3]), pack2(val[4], val[5]), pack2(val[6], val[7])};
  }
  for (int v = tid; v < 256 * 32; v += 256) {
    const int row = v >> 5, kc = v & 31;
    const int dir = row >> 7, pp = (row >> 1) & 63, ri = row & 1;
    const int s = kc >> 1, m0 = (kc & 1) * 8;
    const float2 lp = Lpow[(dir * 17 + (dir == 0 ? 15 - s : s)) * 64 + pp];
    float val[8];
#pragma unroll
    for (int e = 0; e < 8; ++e) {
      const float2 bb = Bbar[(dir * 64 + pp) * 16 + m0 + e];
      val[e] = ri == 0 ? (lp.x * bb.x - lp.y * bb.y) : (lp.x * bb.y + lp.y * bb.x);
    }
    *(uint4*)(W1 + (size_t)row * 256 + kc * 8) =
        uint4{pack2(val[0], val[1]), pack2(val[2], val[3]), pack2(val[4], val[5]), pack2(val[6], val[7])};
  }
  __syncthreads();
}

DEVI void table_item(const Params& p, int idx) {
  const int tid = opaque_tid();
  if (idx < 512) {
    bf16_t* T = (bf16_t*)(p.ws + OFF_T1024);
    for (int e = tid; e < 4096; e += 256) {
      const int g = idx * 4096 + e, k = g >> 11, kk = g & 2047;
      const int ph = (k * (kk & 1023)) & 1023;
      float s, c; sincospif((float)ph * (2.0f / 1024.0f), &s, &c);
      T[g] = f2bf(kk < 1024 ? c : -s);
    }
    return;
  }
  idx -= 512;
  if (idx < 32) {
    bf16_t* T = (bf16_t*)(p.ws + OFF_T256);
    for (int e = tid; e < 4096; e += 256) {
      const int g = idx * 4096 + e, k = g >> 9, kk = g & 511;
      const int ph = (k * (kk & 255)) & 255;
      float s, c; sincospif((float)ph * (2.0f / 256.0f), &s, &c);
      T[g] = f2bf(kk < 256 ? c : -s);
    }
    return;
  }
  idx -= 32;
  if (idx < 8) {
    bf16_t* T = (bf16_t*)(p.ws + OFF_DFT128);
    for (int e = tid; e < 4096; e += 256) {
      const int g = idx * 4096 + e, n1 = g >> 7, c_ = g & 127;
      const int ph = (c_ * (n1 & 127)) & 127;
      float s, c; sincospif((float)ph * (2.0f / 128.0f), &s, &c);
      T[g] = f2bf(n1 < 128 ? c : s);
    }
    return;
  }
  idx -= 8;
  {
    float2* T = (float2*)(p.ws + OFF_ROPE);
    for (int e = tid; e < 4096; e += 256) {
      const int g = idx * 4096 + e, t = g >> 5, i = g & 31;
      const float pos = (i < 16) ? (float)(t >> 6) : (float)(t & 63);
      const float fr_ = powf(10000.0f, -(float)(i & 15) / 16.0f);
      float s, c; sincosf(pos * fr_, &s, &c);
      T[g] = float2{c, s};
    }
  }
}

DEVI const float* xin_row(const Params& p, int m) {
  return m < MCTX ? p.in[0] + (size_t)m * 1024 : p.in[1] + (size_t)(m - MCTX) * 1024;
}

DEVI void modulate0_row(const Params& p, int m) {
  const int lane = opaque_tid() & 63;
  const float* x = xin_row(p, m);
  const float* mod = (const float*)(p.ws + OFF_MOD) + (size_t)modrow(m) * 6144;
  bf16_t* u = (bf16_t*)(p.ws + OFF_U) + (size_t)m * 1024;
#pragma unroll
  for (int k = 0; k < 4; ++k) {
    const int c = lane * 4 + 256 * k;
    const float4 v = *(const float4*)(x + c);
    const float4 sh = *(const float4*)(mod + c);
    const float4 sc = *(const float4*)(mod + 1024 + c);
    uint2 o;
    o.x = pack2(v.x * (1.f + sc.x) + sh.x, v.y * (1.f + sc.y) + sh.y);
    o.y = pack2(v.z * (1.f + sc.z) + sh.z, v.w * (1.f + sc.w) + sh.w);
    *(uint2*)(u + c) = o;
  }
}

DEVI void ln_row(const Params& p, int m, const float* g, const float* b, const float* modl, int sh_off, int sc_off, bool write_u) {
  const int lane = opaque_tid() & 63;
  float* x = p.out + (size_t)m * 1024;
  float4 v[4];
  float s = 0.f;
#pragma unroll
  for (int k = 0; k < 4; ++k) {
    v[k] = *(const float4*)(x + lane * 4 + 256 * k);
    s += v[k].x + v[k].y + v[k].z + v[k].w;
  }
#pragma unroll
  for (int o = 32; o >= 1; o >>= 1) s += __shfl_xor(s, o);
  const float mu = s * (1.0f / 1024.0f);
  float q = 0.f;
#pragma unroll
  for (int k = 0; k < 4; ++k) {
    v[k].x -= mu; v[k].y -= mu; v[k].z -= mu; v[k].w -= mu;
    q += v[k].x * v[k].x + v[k].y * v[k].y + v[k].z * v[k].z + v[k].w * v[k].w;
  }
#pragma unroll
  for (int o = 32; o >= 1; o >>= 1) q += __shfl_xor(q, o);
  const float rs = rsqrtf(q * (1.0f / 1024.0f) + LN_EPS);
  const float* mod = modl + (size_t)modrow(m) * 6144;
  bf16_t* u = (bf16_t*)(p.ws + OFF_U) + (size_t)m * 1024;
#pragma unroll
  for (int k = 0; k < 4; ++k) {
    const int c = lane * 4 + 256 * k;
    const float4 gg = *(const float4*)(g + c);
    const float4 bb = *(const float4*)(b + c);
    float4 y;
    y.x = v[k].x * rs * gg.x + bb.x; y.y = v[k].y * rs * gg.y + bb.y;
    y.z = v[k].z * rs * gg.z + bb.z; y.w = v[k].w * rs * gg.w + bb.w;
    *(float4*)(x + c) = y;
    if (write_u) {
      const float4 sh = *(const float4*)(mod + sh_off + c);
      const float4 sc = *(const float4*)(mod + sc_off + c);
      uint2 o;
      o.x = pack2(y.x * (1.f + sc.x) + sh.x, y.y * (1.f + sc.y) + sh.y);
      o.y = pack2(y.z * (1.f + sc.z) + sh.z, y.w * (1.f + sc.w) + sh.w);
      *(uint2*)(u + c) = o;
    }
  }
}

DEVI void prep_token(const Params& p, int l, int tok) {
  const int lane = opaque_tid() & 63;
  bf16_t* Kd = (bf16_t*)(p.ws + OFF_KD); bf16_t* VTd = (bf16_t*)(p.ws + OFF_VTD);
  bf16_t* Kc = (bf16_t*)(p.ws + OFF_KC); bf16_t* VTc = (bf16_t*)(p.ws + OFF_VTC);
  if (tok >= M) {
    const int b = (tok - M) >> 9, j = (tok - M) & 511;
    if (lane < 32) {
      const int li = lane & 15, hk = li >> 3, d0 = (li & 7) * 8;
      const float* src = (lane < 16 ? p.in[3] : p.in[4]) + ((size_t)((b * 2 + l) * 512 + j)) * 128 + li * 8;
      const float4 v0 = *(const float4*)src, v1 = *(const float4*)(src + 4);
      const float vv[8] = {v0.x, v0.y, v0.z, v0.w, v1.x, v1.y, v1.z, v1.w};
      if (lane < 16) {
        *(uint4*)(Kd + ((size_t)(b * 2 + hk) * 1536 + 1024 + j) * 64 + d0) =
            uint4{pack2(vv[0], vv[1]), pack2(vv[2], vv[3]), pack2(vv[4], vv[5]), pack2(vv[6], vv[7])};
      } else {
#pragma unroll
        for (int e = 0; e < 8; ++e) VTd[((size_t)(b * 2 + hk) * 64 + d0 + e) * 1536 + 1024 + j] = f2bf(vv[e]);
      }
    }
    return;
  }
  const int m = tok;
  const bool dec = m >= MCTX;
  const int b = dec ? (m - MCTX) >> 10 : m >> 8;
  const int t = dec ? (m - MCTX) & 1023 : m & 255;
  const bf16_t* z = (const bf16_t*)(p.ws + OFF_Z) + (size_t)m * 1792;
  const float2* rope = (const float2*)(p.ws + OFF_ROPE) + (size_t)t * 32;
  {
    const uint4 raw = *(const uint4*)(z + lane * 8);
    float x[8];
    x[0] = bf2f(raw.x & 0xffff); x[1] = bf2f(raw.x >> 16); x[2] = bf2f(raw.y & 0xffff); x[3] = bf2f(raw.y >> 16);
    x[4] = bf2f(raw.z & 0xffff); x[5] = bf2f(raw.z >> 16); x[6] = bf2f(raw.w & 0xffff); x[7] = bf2f(raw.w >> 16);
    float ss = 0.f;
#pragma unroll
    for (int e = 0; e < 8; ++e) ss += x[e] * x[e];
    ss += __shfl_xor(ss, 1); ss += __shfl_xor(ss, 2); ss += __shfl_xor(ss, 4);
    const float rn = rsqrtf(ss * (1.0f / 64.0f) + LN_EPS);
    const int d0 = (lane & 7) * 8;
    const float* gq = p.in[10] + l * 64 + d0;
#pragma unroll
    for (int e = 0; e < 8; ++e) x[e] = x[e] * rn * gq[e];
    if (dec) {
#pragma unroll
      for (int e = 0; e < 4; ++e) {
        const float2 cs = rope[(d0 >> 1) + e];
        const float x0 = x[2 * e], x1 = x[2 * e + 1];
        x[2 * e] = x0 * cs.x - x1 * cs.y;
        x[2 * e + 1] = x0 * cs.y + x1 * cs.x;
      }
    }
    const float qs = 0.125f * 1.4426950408889634f;
    *(uint4*)((bf16_t*)(p.ws + OFF_QN) + (size_t)m * 512 + lane * 8) =
        uint4{pack2(x[0] * qs, x[1] * qs), pack2(x[2] * qs, x[3] * qs), pack2(x[4] * qs, x[5] * qs), pack2(x[6] * qs, x[7] * qs)};
  }
  {
    const int li = lane & 15, hk = li >> 3, d0 = (li & 7) * 8;
    const uint4 raw = *(const uint4*)(z + 512 + li * 8);
    float x[8];
    x[0] = bf2f(raw.x & 0xffff); x[1] = bf2f(raw.x >> 16); x[2] = bf2f(raw.y & 0xffff); x[3] = bf2f(raw.y >> 16);
    x[4] = bf2f(raw.z & 0xffff); x[5] = bf2f(raw.z >> 16); x[6] = bf2f(raw.w & 0xffff); x[7] = bf2f(raw.w >> 16);
    float ss = 0.f;
#pragma unroll
    for (int e = 0; e < 8; ++e) ss += x[e] * x[e];
    ss += __shfl_xor(ss, 1); ss += __shfl_xor(ss, 2); ss += __shfl_xor(ss, 4);
    const float rn = rsqrtf(ss * (1.0f / 64.0f) + LN_EPS);
    const float* gk = p.in[11] + l * 64 + d0;
#pragma unroll
    for (int e = 0; e < 8; ++e) x[e] = x[e] * rn * gk[e];
    if (lane < 16) {
      if (!dec) {
        float* ck = p.out + OUT_CK + ((size_t)((b * 2 + l) * 256 + t)) * 128 + li * 8;
        *(float4*)ck = float4{x[0], x[1], x[2], x[3]};
        *(float4*)(ck + 4) = float4{x[4], x[5], x[6], x[7]};
        *(uint4*)(Kc + ((size_t)(b * 2 + hk) * 256 + t) * 64 + d0) =
            uint4{pack2(x[0], x[1]), pack2(x[2], x[3]), pack2(x[4], x[5]), pack2(x[6], x[7])};
      } else {
#pragma unroll
        for (int e = 0; e < 4; ++e) {
          const float2 cs = rope[(d0 >> 1) + e];
          const float x0 = x[2 * e], x1 = x[2 * e + 1];
          x[2 * e] = x0 * cs.x - x1 * cs.y;
          x[2 * e + 1] = x0 * cs.y + x1 * cs.x;
        }
        *(uint4*)(Kd + ((size_t)(b * 2 + hk) * 1536 + t) * 64 + d0) =
            uint4{pack2(x[0], x[1]), pack2(x[2], x[3]), pack2(x[4], x[5]), pack2(x[6], x[7])};
      }
    }
  }
  if (lane >= 16 && lane < 32) {
    const int li = lane - 16, hk = li >> 3, d0 = (li & 7) * 8;
    const uint4 raw = *(const uint4*)(z + 640 + li * 8);
    float x[8];
    x[0] = bf2f(raw.x & 0xffff); x[1] = bf2f(raw.x >> 16); x[2] = bf2f(raw.y & 0xffff); x[3] = bf2f(raw.y >> 16);
    x[4] = bf2f(raw.z & 0xffff); x[5] = bf2f(raw.z >> 16); x[6] = bf2f(raw.w & 0xffff); x[7] = bf2f(raw.w >> 16);
    if (!dec) {
      float* cv = p.out + OUT_CV + ((size_t)((b * 2 + l) * 256 + t)) * 128 + li * 8;
      *(float4*)cv = float4{x[0], x[1], x[2], x[3]};
      *(float4*)(cv + 4) = float4{x[4], x[5], x[6], x[7]};
#pragma unroll
      for (int e = 0; e < 8; ++e) VTc[((size_t)(b * 2 + hk) * 64 + d0 + e) * 256 + t] = f2bf(x[e]);
    } else {
#pragma unroll
      for (int e = 0; e < 8; ++e) VTd[((size_t)(b * 2 + hk) * 64 + d0 + e) * 1536 + t] = f2bf(x[e]);
    }
  }
}

DEVI void attn_item(const Params& p, int a, unsigned char* smem) {
  const int tid = opaque_tid(), lane = tid & 63, wave = tid >> 6, fr = lane & 15, fq = lane >> 4;
  int h, Lk, m0;
  const bf16_t *Kb, *Vb;
  if (a < 512) {
    const int b = a >> 6; h = (a >> 3) & 7; const int qb = a & 7; Lk = 1536; m0 = MCTX + b * 1024 + qb * 128;
    const int bh = b * 2 + (h >> 2);
    Kb = (const bf16_t*)(p.ws + OFF_KD) + (size_t)bh * 1536 * 64;
    Vb = (const bf16_t*)(p.ws + OFF_VTD) + (size_t)bh * 64 * 1536;
  } else {
    a -= 512;
    const int b = a >> 4; h = (a >> 1) & 7; const int qb = a & 1; Lk = 256; m0 = b * 256 + qb * 128;
    const int bh = b * 2 + (h >> 2);
    Kb = (const bf16_t*)(p.ws + OFF_KC) + (size_t)bh * 256 * 64;
    Vb = (const bf16_t*)(p.ws + OFF_VTC) + (size_t)bh * 64 * 256;
  }
  const bf16_t* Qn = (const bf16_t*)(p.ws + OFF_QN);
  bf16x8 qf[2][2];
#pragma unroll
  for (int jq = 0; jq < 2; ++jq)
#pragma unroll
    for (int ks = 0; ks < 2; ++ks)
      qf[jq][ks] = *(const bf16x8*)(Qn + (size_t)(m0 + wave * 32 + jq * 16 + fr) * 512 + h * 64 + ks * 32 + fq * 8);
  f32x4 o[4][2];
#pragma unroll
  for (int di = 0; di < 4; ++di)
#pragma unroll
    for (int jq = 0; jq < 2; ++jq) o[di][jq] = f32x4{0.f, 0.f, 0.f, 0.f};
  float mrow[2] = {-1e30f, -1e30f}, lrow[2] = {0.f, 0.f};
  const int nt = Lk >> 6;
  const int srow = tid >> 3, sch = tid & 7;
  const int woff = srow * 128 + ((sch ^ ((srow >> 1) & 7)) << 4);
  const int swz = fr >> 1;
  uint4 rk[2], rv[2];
#pragma unroll
  for (int it = 0; it < 2; ++it) {
    rk[it] = *(const uint4*)(Kb + (size_t)(srow + 32 * it) * 64 + sch * 8);
    rv[it] = *(const uint4*)(Vb + (size_t)(srow + 32 * it) * Lk + sch * 8);
  }
#pragma unroll
  for (int it = 0; it < 2; ++it) {
    *(uint4*)(smem + woff + it * 4096) = rk[it];
    *(uint4*)(smem + 8192 + woff + it * 4096) = rv[it];
  }
  __syncthreads();
#pragma unroll 1
  for (int kt = 0; kt < nt; ++kt) {
    const int cur = (kt & 1) * 16384;
    {
      const int kn = (kt + 1 < nt) ? kt + 1 : kt;
#pragma unroll
      for (int it = 0; it < 2; ++it) {
        rk[it] = *(const uint4*)(Kb + (size_t)(kn * 64 + srow + 32 * it) * 64 + sch * 8);
        rv[it] = *(const uint4*)(Vb + (size_t)(srow + 32 * it) * Lk + kn * 64 + sch * 8);
      }
    }
    f32x4 s[4][2];
#pragma unroll
    for (int i = 0; i < 4; ++i)
#pragma unroll
      for (int jq = 0; jq < 2; ++jq) s[i][jq] = f32x4{0.f, 0.f, 0.f, 0.f};
#pragma unroll
    for (int ks = 0; ks < 2; ++ks) {
      const int co = ((ks * 4 + fq) ^ swz) << 4;
#pragma unroll
      for (int i = 0; i < 4; ++i) {
        const bf16x8 kf = *(const bf16x8*)(smem + cur + (i * 16 + fr) * 128 + co);
#pragma unroll
        for (int jq = 0; jq < 2; ++jq) s[i][jq] = __builtin_amdgcn_mfma_f32_16x16x32_bf16(kf, qf[jq][ks], s[i][jq], 0, 0, 0);
      }
    }
#pragma unroll
    for (int jq = 0; jq < 2; ++jq) {
      float mx = -1e30f;
#pragma unroll
      for (int i = 0; i < 4; ++i)
#pragma unroll
        for (int r = 0; r < 4; ++r) mx = fmaxf(mx, s[i][jq][r]);
      mx = fmaxf(mx, __shfl_xor(mx, 16));
      mx = fmaxf(mx, __shfl_xor(mx, 32));
      const float mnew = fmaxf(mrow[jq], mx);
      const float alpha = exp2f(mrow[jq] - mnew);
      mrow[jq] = mnew;
      float ls = 0.f;
#pragma unroll
      for (int i = 0; i < 4; ++i)
#pragma unroll
        for (int r = 0; r < 4; ++r) { const float e = exp2f(s[i][jq][r] - mnew); s[i][jq][r] = e; ls += e; }
      lrow[jq] = lrow[jq] * alpha + ls;
#pragma unroll
      for (int di = 0; di < 4; ++di)
#pragma unroll
        for (int r = 0; r < 4; ++r) o[di][jq][r] *= alpha;
    }
#pragma unroll
    for (int kk = 0; kk < 2; ++kk) {
      bf16x8 pf[2];
#pragma unroll
      for (int jq = 0; jq < 2; ++jq) {
        union { uint4 u; bf16x8 v; } cv;
        cv.u = uint4{pack2(s[2 * kk][jq][0], s[2 * kk][jq][1]), pack2(s[2 * kk][jq][2], s[2 * kk][jq][3]),
                     pack2(s[2 * kk + 1][jq][0], s[2 * kk + 1][jq][1]), pack2(s[2 * kk + 1][jq][2], s[2 * kk + 1][jq][3])};
        pf[jq] = cv.v;
      }
      const int c0 = ((4 * kk + (fq >> 1)) ^ swz) << 4;
      const int c1 = ((4 * kk + 2 + (fq >> 1)) ^ swz) << 4;
      const int wi = (fq & 1) * 8;
#pragma unroll
      for (int di = 0; di < 4; ++di) {
        const unsigned char* vrow = smem + cur + 8192 + (di * 16 + fr) * 128;
        union { uint2 u[2]; bf16x8 v; } cv;
        cv.u[0] = *(const uint2*)(vrow + c0 + wi);
        cv.u[1] = *(const uint2*)(vrow + c1 + wi);
#pragma unroll
        for (int jq = 0; jq < 2; ++jq) o[di][jq] = __builtin_amdgcn_mfma_f32_16x16x32_bf16(cv.v, pf[jq], o[di][jq], 0, 0, 0);
      }
    }
    {
      const int nxt = 16384 - cur;
#pragma unroll
      for (int it = 0; it < 2; ++it) {
        *(uint4*)(smem + nxt + woff + it * 4096) = rk[it];
        *(uint4*)(smem + nxt + 8192 + woff + it * 4096) = rv[it];
      }
    }
    __syncthreads();
  }
  bf16_t* att = (bf16_t*)(p.ws + OFF_ATT);
#pragma unroll
  for (int jq = 0; jq < 2; ++jq) {
    float lt = lrow[jq];
    lt += __shfl_xor(lt, 16);
    lt += __shfl_xor(lt, 32);
    const float inv = 1.0f / lt;
    bf16_t* dst = att + (size_t)(m0 + wave * 32 + jq * 16 + fr) * 512 + h * 64 + 4 * fq;
#pragma unroll
    for (int di = 0; di < 4; ++di)
      *(uint2*)(dst + di * 16) = uint2{pack2(o[di][jq][0] * inv, o[di][jq][1] * inv), pack2(o[di][jq][2] * inv, o[di][jq][3] * inv)};
  }
}

DEVI int ssm_col_row(int sub, int j) {
  return sub < 8 ? MCTX + sub * 1024 + j * 16 : ((sub - 8) * 4 + (j >> 4)) * 256 + (j & 15) * 16;
}

DEVI void ssm_item(const Params& p, int l, int idx, unsigned char* smem) {
  const int g = idx / 12, sub = idx % 12;
  const int tid = opaque_tid(), lane = tid & 63, wave = tid >> 6, fr = lane & 15, fq = lane >> 4;
  const bf16_t* AC = (const bf16_t*)(p.ws + OFF_SSM) + (size_t)(l * 32 + g) * SSM_EL;
  const bf16_t* W1 = AC + 256 * 512;
  const bf16_t* z = (const bf16_t*)(p.ws + OFF_Z);
  const int ucol = 768 + g * 16;
  size_t ubase[4];
#pragma unroll
  for (int jt = 0; jt < 4; ++jt) ubase[jt] = (size_t)ssm_col_row(sub, jt * 16 + fr) * 1792 + ucol;
  f32x4 acc[4][4];
  zero_acc(acc);
#pragma unroll 1
  for (int ks = 0; ks < 8; ++ks) {
    const int s = 2 * ks + (fq >> 1), m8 = (fq & 1) * 8;
    bf16x8 a[4], b[4];
#pragma unroll
    for (int i = 0; i < 4; ++i) a[i] = *(const bf16x8*)(W1 + (size_t)(wave * 64 + i * 16 + fr) * 256 + ks * 32 + fq * 8);
#pragma unroll
    for (int jt = 0; jt < 4; ++jt) b[jt] = *(const bf16x8*)(z + ubase[jt] + (size_t)s * 1792 + m8);
#pragma unroll
    for (int i = 0; i < 4; ++i)
#pragma unroll
      for (int jt = 0; jt < 4; ++jt) acc[i][jt] = __builtin_amdgcn_mfma_f32_16x16x32_bf16(a[i], b[jt], acc[i][jt], 0, 0, 0);
  }
#pragma unroll
  for (int i = 0; i < 4; ++i)
#pragma unroll
    for (int jt = 0; jt < 4; ++jt) {
      const int j = jt * 16 + fr;
      const int ch = (wave * 64 + i * 16 + 4 * fq) >> 2;
      *(f32x4*)(smem + j * 1024 + ((ch ^ (j & 15)) << 4)) = acc[i][jt];
    }
  __syncthreads();
  if (tid < 128) {
    const int dir = tid >> 6, pp = tid & 63;
    const float2 lam = ((const float2*)(p.ws + OFF_LAM16))[((l * 2 + dir) * 32 + g) * 64 + pp];
    const int nseq = sub < 8 ? 1 : 4, nch = sub < 8 ? 64 : 16;
    const int ch = (dir * 64 + pp) >> 1, wi = (pp & 1) * 8;
    for (int q = 0; q < nseq; ++q) {
      float hr = 0.f, hi = 0.f;
      if (sub < 8) {
        const float* h0 = p.in[5] + ((size_t)(((sub * 2 + l) * 2 + dir) * 32 + g) * 64 + pp) * 2;
        hr = h0[0]; hi = h0[1];
      }
      for (int c = 0; c < nch; ++c) {
        const int j = q * nch + (dir == 0 ? c : nch - 1 - c);
        float2* f = (float2*)(smem + j * 1024 + ((ch ^ (j & 15)) << 4) + wi);
        const float2 F = *f;
        *f = float2{hr, hi};
        const float nr = lam.x * hr - lam.y * hi + F.x;
        const float ni = lam.x * hi + lam.y * hr + F.y;
        hr = nr; hi = ni;
      }
      if (sub >= 8) {
        const int b = (sub - 8) * 4 + q;
        float* st = p.out + OUT_ST + ((size_t)(((b * 2 + l) * 2 + dir) * 32 + g) * 64 + pp) * 2;
        st[0] = hr; st[1] = hi;
      }
    }
  }
  __syncthreads();
  zero_acc(acc);
#pragma unroll 1
  for (int ks = 0; ks < 16; ++ks) {
    bf16x8 a[4], b[4];
#pragma unroll
    for (int i = 0; i < 4; ++i) a[i] = *(const bf16x8*)(AC + (size_t)(wave * 64 + i * 16 + fr) * 512 + ks * 32 + fq * 8);
    if (ks < 8) {
      const int s = 2 * ks + (fq >> 1), m8 = (fq & 1) * 8;
#pragma unroll
      for (int jt = 0; jt < 4; ++jt) b[jt] = *(const bf16x8*)(z + ubase[jt] + (size_t)s * 1792 + m8);
    } else {
      const int c0 = ((ks - 8) * 32 + fq * 8) >> 2;
#pragma unroll
      for (int jt = 0; jt < 4; ++jt) {
        const int j = jt * 16 + fr;
        const f32x4 v0 = *(const f32x4*)(smem + j * 1024 + ((c0 ^ (j & 15)) << 4));
        const f32x4 v1 = *(const f32x4*)(smem + j * 1024 + (((c0 + 1) ^ (j & 15)) << 4));
        union { uint4 u; bf16x8 v; } cv;
        cv.u = uint4{pack2(v0[0], v0[1]), pack2(v0[2], v0[3]), pack2(v1[0], v1[1]), pack2(v1[2], v1[3])};
        b[jt] = cv.v;
      }
    }
#pragma unroll
    for (int i = 0; i < 4; ++i)
#pragma unroll
      for (int jt = 0; jt < 4; ++jt) acc[i][jt] = __builtin_amdgcn_mfma_f32_16x16x32_bf16(a[i], b[jt], acc[i][jt], 0, 0, 0);
  }
  bf16_t* sp = (bf16_t*)(p.ws + OFF_SSMP);
  const float4 dv = *(const float4*)(p.in[19] + l * 512 + g * 16 + 4 * fq);
#pragma unroll
  for (int i = 0; i < 4; ++i) {
    const int t = wave * 4 + i;
#pragma unroll
    for (int jt = 0; jt < 4; ++jt) {
      const size_t row = (size_t)ssm_col_row(sub, jt * 16 + fr) + t;
      const uint2 uu = *(const uint2*)(z + row * 1792 + ucol + 4 * fq);
      const float y0 = gelu_tanh(acc[i][jt][0] + dv.x * bf2f(uu.x & 0xffff));
      const float y1 = gelu_tanh(acc[i][jt][1] + dv.y * bf2f(uu.x >> 16));
      const float y2 = gelu_tanh(acc[i][jt][2] + dv.z * bf2f(uu.y & 0xffff));
      const float y3 = gelu_tanh(acc[i][jt][3] + dv.w * bf2f(uu.y >> 16));
      *(uint2*)(sp + row * 512 + g * 16 + 4 * fq) = uint2{pack2(y0, y1), pack2(y2, y3)};
      asm volatile("" ::: "memory");
    }
  }
  __syncthreads();
}

#define TILE_IDS \
  const int tid = opaque_tid(), lane = tid & 63, wave = tid >> 6, wp = wave >> 1, wq = wave & 1, fr = lane & 15, fq = lane >> 4; \
  (void)tid; (void)wp; (void)wq; (void)fr; (void)fq;

DEVI void z_tile(const Params& p, int l, int t, unsigned char* smem) {
  TILE_IDS
  int mt, nt; grp_tile(t, 14, mt, nt);
  const bf16_t* P = (const bf16_t*)(p.ws + OFF_W) + (size_t)l * WL_TOT + WL_IN + (size_t)nt * 128 * 1024;
  const bf16_t* Q = (const bf16_t*)(p.ws + OFF_U) + (size_t)mt * 128 * 1024;
  f32x4 acc[4][4];
  zero_acc(acc);
  gemm_core(P, 1024, Q, 1024, 1024, acc, smem);
  bf16_t* z = (bf16_t*)(p.ws + OFF_Z);
#pragma unroll
  for (int i = 0; i < 4; ++i)
#pragma unroll
    for (int j = 0; j < 4; ++j) {
      const int n = nt * 128 + wp * 64 + i * 16 + 4 * fq, m = mt * 128 + wq * 64 + j * 16 + fr;
      *(uint2*)(z + (size_t)m * 1792 + n) = uint2{pack2(acc[i][j][0], acc[i][j][1]), pack2(acc[i][j][2], acc[i][j][3])};
    }
}

DEVI void four1_tile(const Params& p, int t, unsigned char* smem) {
  TILE_IDS
  const int mt = t >> 3, grp = (t >> 1) & 3, half = t & 1;
  const bf16_t* P = (const bf16_t*)(p.ws + OFF_Z) + (size_t)mt * 128 * 1792 + 1280 + grp * 128;
  const bf16_t* Q = (const bf16_t*)(p.ws + OFF_DFT128) + (size_t)half * 128 * 128;
  f32x4 acc[4][4];
  zero_acc(acc);
  gemm_core(P, 1792, Q, 128, 128, acc, smem);
  bf16_t* GT = (bf16_t*)(p.ws + OFF_GT);
  const int m0 = mt * 128;
  int L; bf16_t* gb; int lpos0;
  if (m0 < MCTX) { L = 256; gb = GT + (size_t)(m0 >> 8) * 512 * 512; lpos0 = m0 & 255; }
  else { L = 1024; gb = GT + (size_t)16 * 512 * 512 + (size_t)((m0 - MCTX) >> 10) * 512 * 2048; lpos0 = (m0 - MCTX) & 1023; }
#pragma unroll
  for (int i = 0; i < 4; ++i)
#pragma unroll
    for (int j = 0; j < 4; ++j) {
      const int lp = lpos0 + wp * 64 + i * 16 + 4 * fq;
      const int cp = wq * 64 + j * 16 + fr;
      *(uint2*)(gb + (size_t)(grp * 128 + cp) * (2 * L) + half * L + lp) =
          uint2{pack2(acc[i][j][0], acc[i][j][1]), pack2(acc[i][j][2], acc[i][j][3])};
    }
}

DEVI void four2_tile(const Params& p, int t, unsigned char* smem) {
  TILE_IDS
  const bf16_t* GT = (const bf16_t*)(p.ws + OFF_GT);
  const bf16_t *P, *Q; int K, mrow0, nt; float scale;
  if (t < 128) {
    const int b = t >> 3, pt = (t >> 2) & 1; nt = t & 3;
    P = GT + (size_t)b * 512 * 512 + (size_t)nt * 128 * 512;
    Q = (const bf16_t*)(p.ws + OFF_T256) + (size_t)pt * 128 * 512;
    K = 512; mrow0 = b * 256 + pt * 128; scale = 0.005524271728019903f;
  } else {
    t -= 128;
    const int b = t >> 5, pt = (t >> 2) & 7; nt = t & 3;
    P = GT + (size_t)16 * 512 * 512 + (size_t)b * 512 * 2048 + (size_t)nt * 128 * 2048;
    Q = (const bf16_t*)(p.ws + OFF_T1024) + (size_t)pt * 128 * 2048;
    K = 2048; mrow0 = MCTX + b * 1024 + pt * 128; scale = 0.0027621358640099515f;
  }
  f32x4 acc[4][4];
  zero_acc(acc);
  gemm_core(P, K, Q, K, K, acc, smem);
  bf16_t* fo = (bf16_t*)(p.ws + OFF_FOUR);
#pragma unroll
  for (int i = 0; i < 4; ++i)
#pragma unroll
    for (int j = 0; j < 4; ++j) {
      const int n = nt * 128 + wp * 64 + i * 16 + 4 * fq, m = mrow0 + wq * 64 + j * 16 + fr;
      *(uint2*)(fo + (size_t)m * 512 + n) =
          uint2{pack2(acc[i][j][0] * scale, acc[i][j][1] * scale), pack2(acc[i][j][2] * scale, acc[i][j][3] * scale)};
    }
}

DEVI void glu_tile(const Params& p, int l, int t, unsigned char* smem) {
  TILE_IDS
  int mt, nt; grp_tile(t, 4, mt, nt);
  const bf16_t* P = (const bf16_t*)(p.ws + OFF_W) + (size_t)l * WL_TOT + WL_GLU + (size_t)nt * 128 * 512;
  const bf16_t* sp = (const bf16_t*)(p.ws + OFF_SSMP);
  const bf16_t* Q = sp + (size_t)mt * 128 * 512;
  f32x4 acc[4][4];
  zero_acc(acc);
  gemm_core(P, 512, Q, 512, 512, acc, smem);
  bf16_t* sg = (bf16_t*)(p.ws + OFF_SSMG);
#pragma unroll
  for (int i = 0; i < 4; ++i)
#pragma unroll
    for (int j = 0; j < 4; ++j) {
      const int n = nt * 128 + wp * 64 + i * 16 + 4 * fq, m = mt * 128 + wq * 64 + j * 16 + fr;
      const float4 bg = *(const float4*)(p.in[21] + l * 512 + n);
      const uint2 yy = *(const uint2*)(sp + (size_t)m * 512 + n);
      const float y0 = bf2f(yy.x & 0xffff), y1 = bf2f(yy.x >> 16), y2 = bf2f(yy.y & 0xffff), y3 = bf2f(yy.y >> 16);
      *(uint2*)(sg + (size_t)m * 512 + n) =
          uint2{pack2(y0 * sigmoidf_(acc[i][j][0] + bg.x), y1 * sigmoidf_(acc[i][j][1] + bg.y)),
                pack2(y2 * sigmoidf_(acc[i][j][2] + bg.z), y3 * sigmoidf_(acc[i][j][3] + bg.w))};
      asm volatile("" ::: "memory");
    }
}

DEVI void merged_tile(const Params& p, int l, int t, unsigned char* smem) {
  TILE_IDS
  int mt, nt; grp_tile(t, 8, mt, nt);
  const bf16_t* wl = (const bf16_t*)(p.ws + OFF_W) + (size_t)l * WL_TOT;
  const bf16_t* u = (const bf16_t*)(p.ws + OFF_U) + (size_t)mt * 128 * 1024;
  bf16_t* mo = (bf16_t*)(p.ws + OFF_GT);
#pragma unroll 1
  for (int br = 0; br < 3; ++br) {
    uint2 sg[4][4];
    {
      f32x4 acc[4][4];
      zero_acc(acc);
      gemm_core(wl + WL_IN + (size_t)(1792 + br * 1024 + nt * 128) * 1024, 1024, u, 1024, 1024, acc, smem);
#pragma unroll
      for (int i = 0; i < 4; ++i)
#pragma unroll
        for (int j = 0; j < 4; ++j)
          sg[i][j] = uint2{pack2(sigmoidf_(acc[i][j][0]), sigmoidf_(acc[i][j][1])), pack2(sigmoidf_(acc[i][j][2]), sigmoidf_(acc[i][j][3]))};
    }
    {
      f32x4 acc[4][4];
      zero_acc(acc);
      const bf16_t* X = (const bf16_t*)(p.ws + OFF_ATT) + (size_t)br * M * 512 + (size_t)mt * 128 * 512;
      gemm_core(wl + WL_BR + (size_t)br * 1024 * 512 + (size_t)nt * 128 * 512, 512, X, 512, 512, acc, smem);
#pragma unroll
      for (int i = 0; i < 4; ++i)
#pragma unroll
        for (int j = 0; j < 4; ++j) {
          const int n = nt * 128 + wp * 64 + i * 16 + 4 * fq, m = mt * 128 + wq * 64 + j * 16 + fr;
          uint2* dst = (uint2*)(mo + (size_t)m * 1024 + n);
          float v0 = bf2f(sg[i][j].x & 0xffff) * acc[i][j][0];
          float v1 = bf2f(sg[i][j].x >> 16) * acc[i][j][1];
          float v2 = bf2f(sg[i][j].y & 0xffff) * acc[i][j][2];
          float v3 = bf2f(sg[i][j].y >> 16) * acc[i][j][3];
          if (br > 0) {
            const uint2 o = *dst;
            v0 += bf2f(o.x & 0xffff); v1 += bf2f(o.x >> 16); v2 += bf2f(o.y & 0xffff); v3 += bf2f(o.y >> 16);
          }
          *dst = uint2{pack2(v0, v1), pack2(v2, v3)};
          asm volatile("" ::: "memory");
        }
    }
  }
}

DEVI void resid_tile(const Params& p, int l, int t, int which, unsigned char* smem) {
  TILE_IDS
  int mt, nt; grp_tile(t, 8, mt, nt);
  const bf16_t* wl = (const bf16_t*)(p.ws + OFF_W) + (size_t)l * WL_TOT;
  f32x4 acc[4][4];
  zero_acc(acc);
  if (which == 0)
    gemm_core(wl + WL_OUT + (size_t)nt * 128 * 1024, 1024, (const bf16_t*)(p.ws + OFF_GT) + (size_t)mt * 128 * 1024, 1024, 1024, acc, smem);
  else
    gemm_core(wl + WL_DN + (size_t)nt * 128 * 2816, 2816, (const bf16_t*)(p.ws + OFF_HG) + (size_t)mt * 128 * 2816, 2816, 2816, acc, smem);
  const float* modl = (const float*)(p.ws + OFF_MOD) + (size_t)l * 9 * 6144 + (which == 0 ? 2048 : 5120);
  const bool from_in = (l == 0 && which == 0);
#pragma unroll
  for (int i = 0; i < 4; ++i)
#pragma unroll
    for (int j = 0; j < 4; ++j) {
      const int n = nt * 128 + wp * 64 + i * 16 + 4 * fq, m = mt * 128 + wq * 64 + j * 16 + fr;
      const float4 gg = *(const float4*)(modl + (size_t)modrow(m) * 6144 + n);
      float* dst = p.out + (size_t)m * 1024 + n;
      const float4 xv = from_in ? *(const float4*)(xin_row(p, m) + n) : *(const float4*)dst;
      *(float4*)dst = float4{ALPHA * xv.x + gg.x * acc[i][j][0], ALPHA * xv.y + gg.y * acc[i][j][1],
                             ALPHA * xv.z + gg.z * acc[i][j][2], ALPHA * xv.w + gg.w * acc[i][j][3]};
    }
}

DEVI void up_tile(const Params& p, int l, int t, unsigned char* smem) {
  TILE_IDS
  int mt, nt; grp_tile(t, 44, mt, nt);
  const bf16_t* P = (const bf16_t*)(p.ws + OFF_W) + (size_t)l * WL_TOT + WL_UP + (size_t)nt * 128 * 1024;
  const bf16_t* Q = (const bf16_t*)(p.ws + OFF_U) + (size_t)mt * 128 * 1024;
  f32x4 acc[4][4];
  zero_acc(acc);
  gemm_core(P, 1024, Q, 1024, 1024, acc, smem);
  bf16_t* T = (bf16_t*)smem;
#pragma unroll
  for (int i = 0; i < 4; ++i)
#pragma unroll
    for (int j = 0; j < 4; ++j) {
      const int n = wp * 64 + i * 16 + 4 * fq, m = wq * 64 + j * 16 + fr;
      *(uint2*)(T + m * 136 + n) = uint2{pack2(acc[i][j][0], acc[i][j][1]), pack2(acc[i][j][2], acc[i][j][3])};
    }
  __syncthreads();
  {
    const int c = tid & 63, r0 = (tid >> 6) * 32;
    const int ca = nt * 64 + c, cb = 2816 + nt * 64 + c;
    const float* cw = p.in[29] + (size_t)l * 3 * 5632;
    const float* cbias = p.in[30] + (size_t)l * 5632;
    const float wa0 = cw[ca], wa1 = cw[5632 + ca], wa2 = cw[2 * 5632 + ca], ba = cbias[ca];
    const float wb0 = cw[cb], wb1 = cw[5632 + cb], wb2 = cw[2 * 5632 + cb], bb = cbias[cb];
    bf16_t* hg = (bf16_t*)(p.ws + OFF_HG) + (size_t)(mt * 128) * 2816 + nt * 64 + c;
    float pa = r0 > 0 ? bf2f(T[(r0 - 1) * 136 + c]) : 0.f, pb = r0 > 0 ? bf2f(T[(r0 - 1) * 136 + 64 + c]) : 0.f;
    float ca_ = bf2f(T[r0 * 136 + c]), cb_ = bf2f(T[r0 * 136 + 64 + c]);
    for (int r = r0; r < r0 + 32; ++r) {
      const float na = r < 127 ? bf2f(T[(r + 1) * 136 + c]) : 0.f, nb = r < 127 ? bf2f(T[(r + 1) * 136 + 64 + c]) : 0.f;
      if (r > 0 && r < 127) {
        const float ha = wa0 * pa + wa1 * ca_ + wa2 * na + ba;
        const float hb = wb0 * pb + wb1 * cb_ + wb2 * nb + bb;
        hg[(size_t)r * 2816] = f2bf(ha * sigmoidf_(ha) * hb);
      }
      pa = ca_; pb = cb_; ca_ = na; cb_ = nb;
    }
    bf16_t* edge = (bf16_t*)(p.ws + OFF_EDGE) + (size_t)mt * 4 * 5632;
    const int e = tid >> 6;
    const int er = e < 2 ? e : 124 + e;
    edge[(size_t)e * 5632 + ca] = T[er * 136 + c];
    edge[(size_t)e * 5632 + cb] = T[er * 136 + 64 + c];
  }
  __syncthreads();
}

DEVI void edge_item(const Params& p, int l, int idx) {
  const int mt = idx >> 1, bot = idx & 1;
  const int L = mt < 32 ? 256 : 1024;
  const int m = mt * 128 + (bot ? 127 : 0);
  const int mloc = mt < 32 ? m : m - MCTX;
  const int pos = mloc & (L - 1);
  const bf16_t* edge = (const bf16_t*)(p.ws + OFF_EDGE);
  const bf16_t *prev, *cur, *next;
  bool hasp, hasn;
  if (!bot) {
    hasp = pos != 0; hasn = true;
    prev = edge + ((size_t)(mt > 0 ? mt - 1 : 0) * 4 + 3) * 5632;
    cur = edge + ((size_t)mt * 4 + 0) * 5632;
    next = edge + ((size_t)mt * 4 + 1) * 5632;
  } else {
    hasp = true; hasn = pos != L - 1;
    prev = edge + ((size_t)mt * 4 + 2) * 5632;
    cur = edge + ((size_t)mt * 4 + 3) * 5632;
    next = edge + ((size_t)(mt < 95 ? mt + 1 : 95) * 4 + 0) * 5632;
  }
  const float* cw = p.in[29] + (size_t)l * 3 * 5632;
  const float* cbias = p.in[30] + (size_t)l * 5632;
  bf16_t* hg = (bf16_t*)(p.ws + OFF_HG) + (size_t)m * 2816;
  for (int c = opaque_tid(); c < 2816; c += 256) {
    const int cb = 2816 + c;
    const float pa = hasp ? bf2f(prev[c]) : 0.f, pb = hasp ? bf2f(prev[cb]) : 0.f;
    const float na = hasn ? bf2f(next[c]) : 0.f, nb = hasn ? bf2f(next[cb]) : 0.f;
    const float ha = cw[c] * pa + cw[5632 + c] * bf2f(cur[c]) + cw[2 * 5632 + c] * na + cbias[c];
    const float hb = cw[cb] * pb + cw[5632 + cb] * bf2f(cur[cb]) + cw[2 * 5632 + cb] * nb + cbias[cb];
    hg[c] = f2bf(ha * sigmoidf_(ha) * hb);
  }
}


#define XB_TMO      128
#define XB_XCNT(j)  (256  + 64 * (j))
#define XB_XSUB(j)  (1280 + 64 * (j))
#define XB_XGEN(j)  (2304 + 64 * (j))
#define XB_TOP      3328
#define XB_TOPGEN   3392
#define XCD_BAR_WORDS 3456
#define XB_SPIN_CAP (1u << 20)
#define LAS __attribute__((address_space(3)))
DEVI unsigned xb_ld(unsigned* p) { return __hip_atomic_load(p, __ATOMIC_RELAXED, __HIP_MEMORY_SCOPE_AGENT); }
DEVI unsigned xb_add(unsigned* p, unsigned v) { return __hip_atomic_fetch_add(p, v, __ATOMIC_RELAXED, __HIP_MEMORY_SCOPE_AGENT); }
DEVI unsigned xb_xcc_id() { return (unsigned)__builtin_amdgcn_s_getreg((3 << 11) | 20) & 0xFu; }
#define XB_SPIN(cond, bar) do { unsigned _sp = 0; while (cond) { __builtin_amdgcn_s_sleep(1); \
    if ((++_sp & 255u) == 0u) { if (xb_ld(&(bar)[XB_TMO])) break; if (_sp > XB_SPIN_CAP) { atomicAdd(&(bar)[XB_TMO], 1u); break; } } } } while (0)
struct XcdBarrier { unsigned* bar; unsigned x; volatile LAS unsigned* st; };
DEVI XcdBarrier xcd_barrier_post(unsigned* bar, volatile LAS unsigned* st) {
  XcdBarrier b; b.bar = bar; b.x = xb_xcc_id(); b.st = st;
  if (threadIdx.x == 0) (void)xb_add(&bar[XB_XCNT(b.x)], 1u);
  return b;
}
DEVI void xcd_barrier_complete(unsigned* bar, unsigned x, unsigned& nloc, unsigned& nx) {
  const unsigned G = gridDim.x * gridDim.y * gridDim.z;
  unsigned sum, cnt, mine, sp = 0u;
  for (;;) {
    sum = 0u; cnt = 0u; mine = 0u;
#pragma unroll
    for (unsigned j = 0; j < 16; ++j) { const unsigned c = xb_ld(&bar[XB_XCNT(j)]); sum += c; cnt += (c > 0u) ? 1u : 0u; mine = (j == x) ? c : mine; }
    if (sum == G) break;
    __builtin_amdgcn_s_sleep(1);
    if ((++sp & 255u) == 0u) { if (xb_ld(&bar[XB_TMO])) break; if (sp > XB_SPIN_CAP) { atomicAdd(&bar[XB_TMO], 1u); break; } }
  }
  nloc = mine > 0u ? mine : 1u; nx = cnt > 0u ? cnt : 1u;
}
DEVI void xcd_barrier(const XcdBarrier& b) {
  asm volatile("s_waitcnt vmcnt(0)" ::: "memory");
  __syncthreads();
  if (threadIdx.x == 0) {
    unsigned* bar = b.bar;
    __builtin_amdgcn_s_waitcnt(0);
    unsigned nloc = b.st[0], nx = b.st[1];
    if (nloc == 0u) { xcd_barrier_complete(bar, b.x, nloc, nx); b.st[0] = nloc; b.st[1] = nx; }
    const unsigned old = xb_add(&bar[XB_XSUB(b.x)], 1u);
    const unsigned gen = old / nloc;
    if (old + 1u == (gen + 1u) * nloc) {
      __builtin_amdgcn_fence(__ATOMIC_RELEASE, "agent");
      asm volatile("s_waitcnt vmcnt(0)" ::: "memory");
      const unsigned og = xb_add(&bar[XB_TOP], 1u);
      const unsigned tg = og / nx;
      if (og + 1u == (tg + 1u) * nx) xb_add(&bar[XB_TOPGEN], 1u);
      else XB_SPIN(xb_ld(&bar[XB_TOPGEN]) == tg, bar);
      __builtin_amdgcn_fence(__ATOMIC_ACQUIRE, "agent");
      xb_add(&bar[XB_XGEN(b.x)], 1u);
      asm volatile("s_waitcnt vmcnt(0)" ::: "memory");
    } else {
      XB_SPIN(xb_ld(&bar[XB_XGEN(b.x)]) == gen, bar);
      __builtin_amdgcn_fence(__ATOMIC_ACQUIRE, "agent");
      asm volatile("s_waitcnt vmcnt(0)" ::: "memory");
    }
  }
  __syncthreads();
}

#define FOR_ITEMS(idx, T) for (int idx = (bid & 7) * (G >> 3) + (bid >> 3); idx < (T); idx += G)

__global__ void __launch_bounds__(256, 2) trunk_megakernel(Params p) {
  cg::grid_group grid = cg::this_grid();
  __shared__ __attribute__((aligned(16))) unsigned char smem_all[65536 + 16];
  unsigned char* smem = smem_all;
  const int G = gridDim.x, bid = blockIdx.x;
  if (threadIdx.x == 0) *(uint4*)(smem_all + 65536) = uint4{0u, 0u, 0u, 0u};
  __syncthreads();
  const XcdBarrier xb = xcd_barrier_post((unsigned*)(p.ws + OFF_BAR), (volatile LAS unsigned*)(smem_all + 65536));
  grid.sync();

  for (int i = bid; i < 64 + 192 + 8064 + 560; i += G) {
    if (i < 64) ssm_pre_item(p, i, smem);
    else if (i < 256) mod_item(p, i - 64, smem);
    else if (i < 256 + 8064) weights_item(p, i - 256, smem);
    else table_item(p, i - 256 - 8064);
  }
  xcd_barrier(xb);
  for (int r = bid * 4 + (opaque_tid() >> 6); r < M; r += G * 4) modulate0_row(p, r);
  xcd_barrier(xb);

  for (int l = 0; l < 2; ++l) {
    FOR_ITEMS(t, 96 * 14) z_tile(p, l, t, smem);
    xcd_barrier(xb);
    FOR_ITEMS(i, 384 + 768 + 4096) {
      if (i < 384) ssm_item(p, l, i, smem);
      else if (i < 384 + 768) four1_tile(p, i - 384, smem);
      else prep_token(p, l, (i - 1152) * 4 + (opaque_tid() >> 6));
    }
    xcd_barrier(xb);
    FOR_ITEMS(i, 768 + 384 + 384) {
      if (i < 768) attn_item(p, i, smem);
      else if (i < 768 + 384) four2_tile(p, i - 768, smem);
      else glu_tile(p, l, i - 1152, smem);
    }
    xcd_barrier(xb);
    FOR_ITEMS(t, 768) merged_tile(p, l, t, smem);
    xcd_barrier(xb);
    FOR_ITEMS(t, 768) resid_tile(p, l, t, 0, smem);
    xcd_barrier(xb);
    {
      const float* modl = (const float*)(p.ws + OFF_MOD) + (size_t)l * 9 * 6144;
      for (int r = bid * 4 + (opaque_tid() >> 6); r < M; r += G * 4) ln_row(p, r, p.in[26] + l * 1024, p.in[27] + l * 1024, modl, 3072, 4096, true);
    }
    xcd_barrier(xb);
    FOR_ITEMS(t, 96 * 44) up_tile(p, l, t, smem);
    xcd_barrier(xb);
    for (int i = bid; i < 192; i += G) edge_item(p, l, i);
    xcd_barrier(xb);
    FOR_ITEMS(t, 768) resid_tile(p, l, t, 1, smem);
    xcd_barrier(xb);
    {
      const float* modn = (const float*)(p.ws + OFF_MOD) + (size_t)(l + 1 < 2 ? l + 1 : l) * 9 * 6144;
      for (int r = bid * 4 + (opaque_tid() >> 6); r < M; r += G * 4) ln_row(p, r, p.in[32] + l * 1024, p.in[33] + l * 1024, modn, 0, 1024, l == 0);
    }
    if (l == 0) xcd_barrier(xb);
  }
}

extern "C" void kernel_launch(void* const* d_in, const int* in_sizes, int n_in,
                              void* d_out, int out_size, void* d_ws, size_t ws_size,
                              hipStream_t stream) {
  static int grid_blocks = 0;
  if (!grid_blocks) {
    int dev = 0, cus = 0, per_cu = 0;
    (void)hipGetDevice(&dev);
    (void)hipDeviceGetAttribute(&cus, hipDeviceAttributeMultiprocessorCount, dev);
    (void)hipOccupancyMaxActiveBlocksPerMultiprocessor(&per_cu, trunk_megakernel, 256, 0);
    if (per_cu < 1) per_cu = 1;
    grid_blocks = cus * per_cu;
  }
  Params p{};
  for (int i = 0; i < 34; ++i) p.in[i] = (const float*)d_in[i];
  p.out = (float*)d_out;
  p.ws = (unsigned char*)d_ws;
  (void)hipMemsetAsync((unsigned char*)d_ws + OFF_BAR, 0, XCD_BAR_WORDS * 4, stream);
  void* args[] = {&p};
  hipError_t e = hipLaunchCooperativeKernel((void*)trunk_megakernel, dim3(grid_blocks), dim3(256), args, 0, stream);
  if (e != hipSuccess) fprintf(stderr, "cooperative launch failed: %s (grid %d)\n", hipGetErrorString(e), grid_blocks);
}
```

```cpp
#include <hip/hip_runtime.h>
#include <hip/hip_cooperative_groups.h>
#include <cstdio>
#include <cstdint>
namespace cg = cooperative_groups;

typedef unsigned short bf16_t;
using bf16x8 = __attribute__((ext_vector_type(8))) short;
using f32x4 = __attribute__((ext_vector_type(4))) float;

#define DEVI __device__ __forceinline__

#ifndef REP_P0
#define REP_P0 1
#endif
#ifndef REP_L2
#define REP_L2 1
#endif
#ifndef REP_L3
#define REP_L3 1
#endif
#ifndef REP_L7
#define REP_L7 1
#endif
#ifndef REP_SYNC
#define REP_SYNC 0
#endif
constexpr int M = 12288;
constexpr int MCTX = 4096;
constexpr float ALPHA = 1.41421356237f;
constexpr float LN_EPS = 1e-6f;

constexpr size_t WL_IN = 0;
constexpr size_t WL_GLU = WL_IN + (size_t)4864 * 1024;
constexpr size_t WL_BR = WL_GLU + (size_t)512 * 512;
constexpr size_t WL_OUT = WL_BR + (size_t)3 * 1024 * 512;
constexpr size_t WL_UP = WL_OUT + (size_t)1024 * 1024;
constexpr size_t WL_DN = WL_UP + (size_t)5632 * 1024;
constexpr size_t WL_TOT = WL_DN + (size_t)1024 * 2816;
constexpr size_t OFF_W = 0;
constexpr size_t SSM_EL = 196608;
constexpr size_t OFF_SSM = OFF_W + 2 * WL_TOT * 2;
constexpr size_t OFF_LAM16 = OFF_SSM + 64 * SSM_EL * 2;
constexpr size_t OFF_T1024 = OFF_LAM16 + 2 * 2 * 32 * 64 * 8;
constexpr size_t OFF_T256 = OFF_T1024 + (size_t)1024 * 2048 * 2;
constexpr size_t OFF_DFT128 = OFF_T256 + (size_t)256 * 512 * 2;
constexpr size_t OFF_ROPE = OFF_DFT128 + (size_t)256 * 128 * 2;
constexpr size_t OFF_MOD = OFF_ROPE + (size_t)1024 * 32 * 8;
constexpr size_t OFF_U = OFF_MOD + (size_t)2 * 9 * 6144 * 4;
constexpr size_t OFF_R = OFF_U + (size_t)M * 1024 * 2;
constexpr size_t OFF_Z = OFF_R;
constexpr size_t OFF_ATT = OFF_R;
constexpr size_t OFF_SSMG = OFF_R + (size_t)M * 512 * 2;
constexpr size_t OFF_FOUR = OFF_R + (size_t)2 * M * 512 * 2;
constexpr size_t OFF_QN = OFF_Z + (size_t)M * 1792 * 2;
constexpr size_t OFF_KD = OFF_QN + (size_t)M * 512 * 2;
constexpr size_t OFF_VTD = OFF_KD + (size_t)16 * 1536 * 64 * 2;
constexpr size_t OFF_KC = OFF_VTD + (size_t)16 * 1536 * 64 * 2;
constexpr size_t OFF_VTC = OFF_KC + (size_t)32 * 256 * 64 * 2;
constexpr size_t OFF_SSMP = OFF_VTC + (size_t)32 * 256 * 64 * 2;
constexpr size_t OFF_GT = OFF_SSMP + (size_t)M * 512 * 2;
constexpr size_t OFF_HG = OFF_R;
constexpr size_t OFF_EDGE = OFF_HG + (size_t)M * 2816 * 2;
constexpr size_t OFF_BAR = OFF_GT + (size_t)M * 1024 * 2;
constexpr size_t WS_NEEDED = OFF_BAR + 16384;

constexpr size_t OUT_CK = (size_t)M * 1024;
constexpr size_t OUT_CV = OUT_CK + (size_t)16 * 2 * 256 * 128;
constexpr size_t OUT_ST = OUT_CV + (size_t)16 * 2 * 256 * 128;

struct Params {
  const float* in[34];
  float* out;
  unsigned char* ws;
};

DEVI int opaque_tid() {
  int t = threadIdx.x;
  asm volatile("" : "+v"(t));
  return t;
}
DEVI unsigned short f2bf(float f) {
  unsigned u = __float_as_uint(f);
  u += 0x7fffu + ((u >> 16) & 1u);
  return (unsigned short)(u >> 16);
}
DEVI float bf2f(unsigned short h) { return __uint_as_float(((unsigned)h) << 16); }
DEVI unsigned pack2(float a, float b) { return (unsigned)f2bf(a) | ((unsigned)f2bf(b) << 16); }
DEVI float sigmoidf_(float x) { return 1.0f / (1.0f + __expf(-x)); }
DEVI float gelu_tanh(float x) {
  float y = 0.7978845608028654f * (x + 0.044715f * x * x * x);
  float t = 1.0f - 2.0f / (1.0f + __expf(2.0f * y));
  return 0.5f * x * (1.0f + t);
}
DEVI void grp_tile(int idx, int NT, int& mt, int& nt) {
  const int gsz = 8 * NT, gid = idx / gsz, rem = idx - gid * gsz;
  mt = gid * 8 + (rem & 7); nt = rem >> 3;
}
DEVI int modrow(int m) { return m < MCTX ? 0 : 1 + ((m - MCTX) >> 10); }

DEVI void gemm_core(const bf16_t* P, int ldp, const bf16_t* Q, int ldq, int K, f32x4 (&acc)[4][4],
                    unsigned char* smem) {
  const int tid = opaque_tid(), lane = tid & 63, wave = tid >> 6, wp = wave >> 1, wq = wave & 1;
  const int fr = lane & 15, fq = lane >> 4;
  const int srow = tid >> 3, sch = tid & 7;
  const bf16_t* gp = P + (size_t)srow * ldp + sch * 8;
  const bf16_t* gq = Q + (size_t)srow * ldq + sch * 8;
  const int woff = srow * 128 + ((sch ^ ((srow >> 1) & 7)) << 4);
  const int swz = fr >> 1;
  const int poff = (wp * 64 + fr) * 128;
  const int qoff = 16384 + (wq * 64 + fr) * 128;
  uint4 rp[4], rq[4];
  const int nk = K >> 6;
#pragma unroll
  for (int it = 0; it < 4; ++it) {
    rp[it] = *(const uint4*)(gp + (size_t)(32 * it) * ldp);
    rq[it] = *(const uint4*)(gq + (size_t)(32 * it) * ldq);
  }
#pragma unroll
  for (int it = 0; it < 4; ++it) {
    *(uint4*)(smem + woff + it * 4096) = rp[it];
    *(uint4*)(smem + 16384 + woff + it * 4096) = rq[it];
  }
  __syncthreads();
#pragma unroll 1
  for (int kt = 0; kt < nk; ++kt) {
    const int cur = (kt & 1) * 32768;
    {
      const int kn = (kt + 1 < nk) ? kt + 1 : kt;
      const bf16_t* gp2 = gp + (size_t)kn * 64;
      const bf16_t* gq2 = gq + (size_t)kn * 64;
#pragma unroll
      for (int it = 0; it < 4; ++it) {
        rp[it] = *(const uint4*)(gp2 + (size_t)(32 * it) * ldp);
        rq[it] = *(const uint4*)(gq2 + (size_t)(32 * it) * ldq);
      }
    }
#pragma unroll
    for (int ks = 0; ks < 2; ++ks) {
      const int co = ((ks * 4 + fq) ^ swz) << 4;
      bf16x8 a[4], b[4];
#pragma unroll
      for (int i = 0; i < 4; ++i) a[i] = *(const bf16x8*)(smem + cur + poff + i * 2048 + co);
#pragma unroll
      for (int j = 0; j < 4; ++j) b[j] = *(const bf16x8*)(smem + cur + qoff + j * 2048 + co);
#pragma unroll
      for (int i = 0; i < 4; ++i)
#pragma unroll
        for (int j = 0; j < 4; ++j)
          acc[i][j] = __builtin_amdgcn_mfma_f32_16x16x32_bf16(a[i], b[j], acc[i][j], 0, 0, 0);
    }
    {
      const int nxt = 32768 - cur;
#pragma unroll
      for (int it = 0; it < 4; ++it) {
        *(uint4*)(smem + nxt + woff + it * 4096) = rp[it];
        *(uint4*)(smem + nxt + 16384 + woff + it * 4096) = rq[it];
      }
    }
    __syncthreads();
  }
}

DEVI void gemm_core2(const bf16_t* P, int ldp, const bf16_t* Q, int ldq, int K, f32x4 (&acc)[4][4],
                     unsigned char* smem) {
  const int tid = opaque_tid(), lane = tid & 63, wave = tid >> 6, wp = wave >> 1, wq = wave & 1;
  const int fr = lane & 15, fq = lane >> 4;
  const int lrow = lane >> 2;
  const int lchunk = (lane & 3) ^ ((0x78 >> (2 * ((lrow >> 2) & 3))) & 3);
  const bf16_t* gp = P + (size_t)(wave * 32 + lrow) * ldp + lchunk * 8;
  const bf16_t* gq = Q + (size_t)(wave * 32 + lrow) * ldq + lchunk * 8;
  const size_t p16 = (size_t)16 * ldp, q16 = (size_t)16 * ldq;
  unsigned char* lds_w = smem + wave * 2048;
  const int rslot = (fq ^ ((0x78 >> (2 * ((fr >> 2) & 3))) & 3)) << 4;
  const int poff = (wp * 64 + fr) * 64 + rslot;
  const int qoff = 8192 + (wq * 64 + fr) * 64 + rslot;
  const int nk = K >> 5;
#define GLDS_STAGE(kt_) do { \
    const int st_ = ((kt_) & 3) * 16384; const size_t ko_ = (size_t)(kt_) * 32; \
    __builtin_amdgcn_global_load_lds((const unsigned*)(gp + ko_), (unsigned*)(lds_w + st_), 16, 0, 0); \
    __builtin_amdgcn_global_load_lds((const unsigned*)(gp + ko_ + p16), (unsigned*)(lds_w + st_ + 1024), 16, 0, 0); \
    __builtin_amdgcn_global_load_lds((const unsigned*)(gq + ko_), (unsigned*)(lds_w + st_ + 8192), 16, 0, 0); \
    __builtin_amdgcn_global_load_lds((const unsigned*)(gq + ko_ + q16), (unsigned*)(lds_w + st_ + 8192 + 1024), 16, 0, 0); \
  } while (0)
  GLDS_STAGE(0); GLDS_STAGE(1); GLDS_STAGE(2);
#pragma unroll 1
  for (int kt = 0; kt < nk; ++kt) {
    const int rem = nk - 1 - kt;
    if (rem >= 2) asm volatile("s_waitcnt vmcnt(8)" ::: "memory");
    else if (rem == 1) asm volatile("s_waitcnt vmcnt(4)" ::: "memory");
    else asm volatile("s_waitcnt vmcnt(0)" ::: "memory");
    __builtin_amdgcn_s_barrier();
    if (kt + 3 < nk) GLDS_STAGE(kt + 3);
    const int cur = (kt & 3) * 16384;
    bf16x8 a[4], b[4];
#pragma unroll
    for (int i = 0; i < 4; ++i) a[i] = *(const bf16x8*)(smem + cur + poff + i * 1024);
#pragma unroll
    for (int j = 0; j < 4; ++j) b[j] = *(const bf16x8*)(smem + cur + qoff + j * 1024);
#pragma unroll
    for (int i = 0; i < 4; ++i)
#pragma unroll
      for (int j = 0; j < 4; ++j)
        acc[i][j] = __builtin_amdgcn_mfma_f32_16x16x32_bf16(a[i], b[j], acc[i][j], 0, 0, 0);
  }
#undef GLDS_STAGE
  __syncthreads();
}

DEVI void zero_acc(f32x4 (&acc)[4][4]) {
#pragma unroll
  for (int i = 0; i < 4; ++i)
#pragma unroll
    for (int j = 0; j < 4; ++j) acc[i][j] = f32x4{0.f, 0.f, 0.f, 0.f};
}

DEVI void transpose_tile(const float* W, int K, int N, bf16_t* WT, int kt, int nt, int mode, unsigned char* smem) {
  float* t = (float*)smem;
  const int tid = opaque_tid();
  {
    const int r = tid >> 4, c4 = tid & 15;
#pragma unroll
    for (int it = 0; it < 4; ++it) {
      float4 v = *(const float4*)(W + (size_t)(kt * 64 + r + 16 * it) * N + nt * 64 + c4 * 4);
      float* d = t + (r + 16 * it) * 65 + c4 * 4;
      d[0] = v.x; d[1] = v.y; d[2] = v.z; d[3] = v.w;
    }
  }
  __syncthreads();
  {
    const int n = tid >> 2, kq = tid & 3;
    unsigned w[8];
#pragma unroll
    for (int e = 0; e < 8; ++e) w[e] = pack2(t[(kq * 16 + 2 * e) * 65 + n], t[(kq * 16 + 2 * e + 1) * 65 + n]);
    int c = nt * 64 + n, row = c;
    if (mode == 1) {
      int half = c >= 2816 ? 1 : 0;
      int cc = c - half * 2816;
      row = (cc >> 6) * 128 + half * 64 + (cc & 63);
    }
    uint4* dst = (uint4*)(WT + (size_t)row * K + kt * 64 + kq * 16);
    dst[0] = uint4{w[0], w[1], w[2], w[3]};
    dst[1] = uint4{w[4], w[5], w[6], w[7]};
  }
  __syncthreads();
}

DEVI void weights_item(const Params& p, int idx, unsigned char* smem) {
  const int l = idx / 4032;
  int t = idx - l * 4032;
  bf16_t* wl = (bf16_t*)(p.ws + OFF_W) + (size_t)l * WL_TOT;
  if (t < 1216) { transpose_tile(p.in[9] + (size_t)l * 1024 * 4864, 1024, 4864, wl + WL_IN, t / 76, t % 76, 0, smem); return; }
  t -= 1216;
  if (t < 64) { transpose_tile(p.in[20] + (size_t)l * 512 * 512, 512, 512, wl + WL_GLU, t / 8, t % 8, 0, smem); return; }
  t -= 64;
  if (t < 384) {
    const int br = t / 128; t -= br * 128;
    transpose_tile(p.in[22 + br] + (size_t)l * 512 * 1024, 512, 1024, wl + WL_BR + (size_t)br * 1024 * 512, t / 16, t % 16, 0, smem);
    return;
  }
  t -= 384;
  if (t < 256) { transpose_tile(p.in[25] + (size_t)l * 1024 * 1024, 1024, 1024, wl + WL_OUT, t / 16, t % 16, 0, smem); return; }
  t -= 256;
  if (t < 1408) { transpose_tile(p.in[28] + (size_t)l * 1024 * 5632, 1024, 5632, wl + WL_UP, t / 88, t % 88, 1, smem); return; }
  t -= 1408;
  transpose_tile(p.in[31] + (size_t)l * 2816 * 1024, 2816, 1024, wl + WL_DN, t / 16, t % 16, 0, smem);
}

DEVI void mod_item(const Params& p, int idx, unsigned char* smem) {
  const int l = idx / 96, nt = idx % 96;
  float* sc = (float*)smem;
  float* red = (float*)(smem + 36864);
  const int tid = opaque_tid();
  for (int e = tid; e < 9 * 1024; e += 256) {
    const int r = e >> 10, k = e & 1023;
    const float v = (r == 0) ? p.in[6][k] : p.in[2][(r - 1) * 1024 + k];
    sc[e] = v * sigmoidf_(v);
  }
  __syncthreads();
  const int kq = tid >> 6, col = tid & 63;
  const float* w = p.in[7] + (size_t)l * 1024 * 6144 + (size_t)(kq * 256) * 6144 + nt * 64 + col;
  float acc[9];
#pragma unroll
  for (int r = 0; r < 9; ++r) acc[r] = 0.f;
  for (int k0 = 0; k0 < 256; k0 += 8) {
    float wv[8];
#pragma unroll
    for (int e = 0; e < 8; ++e) wv[e] = w[(size_t)(k0 + e) * 6144];
#pragma unroll
    for (int e = 0; e < 8; ++e)
#pragma unroll
      for (int r = 0; r < 9; ++r) acc[r] += sc[r * 1024 + kq * 256 + k0 + e] * wv[e];
  }
#pragma unroll
  for (int r = 0; r < 9; ++r) red[(kq * 9 + r) * 64 + col] = acc[r];
  __syncthreads();
  float* mod = (float*)(p.ws + OFF_MOD) + (size_t)l * 9 * 6144;
  for (int e = tid; e < 9 * 64; e += 256) {
    const int r = e >> 6, c = e & 63;
    float s = red[(0 * 9 + r) * 64 + c] + red[(1 * 9 + r) * 64 + c] + red[(2 * 9 + r) * 64 + c] + red[(3 * 9 + r) * 64 + c];
    mod[r * 6144 + nt * 64 + c] = s + p.in[8][l * 6144 + nt * 64 + c];
  }
  __syncthreads();
}

DEVI void ssm_pre_item(const Params& p, int idx, unsigned char* smem) {
  const int l = idx >> 5, g = idx & 31;
  const int tid = opaque_tid();
  float2* Lpow = (float2*)smem;
  float2* Bbar = (float2*)(smem + 17408);
  float* Kc = (float*)(smem + 17408 + 16384);
  const float* a_re = p.in[12]; const float* a_im = p.in[13]; const float* log_dt = p.in[14];
  const float* b_re = p.in[15]; const float* b_im = p.in[16]; const float* c_re = p.in[17]; const float* c_im = p.in[18];
  for (int e = tid; e < 2 * 17 * 64; e += 256) {
    const int dir = e / (17 * 64), tau = (e >> 6) % 17, pp = e & 63;
    const int ai = ((l * 2 + dir) * 32 + g) * 64 + pp;
    const float dt = expf(log_dt[(l * 2 + dir) * 32 + g]);
    const float mag = expf(a_re[ai] * dt * (float)tau);
    const float ang = a_im[ai] * dt * (float)tau;
    float s, c; sincosf(ang, &s, &c);
    Lpow[e] = float2{mag * c, mag * s};
    if (tau == 16) ((float2*)(p.ws + OFF_LAM16))[ai] = float2{mag * c, mag * s};
  }
  for (int e = tid; e < 2 * 64 * 16; e += 256) {
    const int dir = e >> 10, pp = (e >> 4) & 63, n = e & 15;
    const int ai = ((l * 2 + dir) * 32 + g) * 64 + pp;
    const float dt = expf(log_dt[(l * 2 + dir) * 32 + g]);
    const float ar = a_re[ai], aim = a_im[ai];
    const float mag = expf(ar * dt);
    float s, c; sincosf(aim * dt, &s, &c);
    const float nr = mag * c - 1.0f, ni = mag * s;
    const float den = ar * ar + aim * aim;
    const float fr_ = (nr * ar + ni * aim) / den, fi_ = (ni * ar - nr * aim) / den;
    const float br = b_re[(size_t)ai * 16 + n], bi = b_im[(size_t)ai * 16 + n];
    Bbar[e] = float2{fr_ * br - fi_ * bi, fr_ * bi + fi_ * br};
  }
  __syncthreads();
  for (int dir = 0; dir < 2; ++dir) {
    const int tau = tid >> 4, n = tid & 15;
    float acc[16];
#pragma unroll
    for (int m = 0; m < 16; ++m) acc[m] = 0.f;
    const size_t cbase = ((size_t)((l * 2 + dir) * 32 + g) * 16 + n) * 64;
    for (int pp = 0; pp < 64; ++pp) {
      const float cr = c_re[cbase + pp], ci = c_im[cbase + pp];
      const float2 lp = Lpow[(dir * 17 + tau) * 64 + pp];
      const float gr = cr * lp.x - ci * lp.y, gi = cr * lp.y + ci * lp.x;
#pragma unroll
      for (int m = 0; m < 16; ++m) {
        const float2 bb = Bbar[(dir * 64 + pp) * 16 + m];
        acc[m] += gr * bb.x - gi * bb.y;
      }
    }
    const int delta = dir == 0 ? 15 - tau : 15 + tau;
#pragma unroll
    for (int m = 0; m < 16; ++m) {
      if (dir == 1 && tau == 0) Kc[(delta * 16 + n) * 16 + m] += acc[m];
      else Kc[(delta * 16 + n) * 16 + m] = acc[m];
    }
    __syncthreads();
  }
  bf16_t* AC = (bf16_t*)(p.ws + OFF_SSM) + (size_t)idx * SSM_EL;
  bf16_t* W1 = AC + 256 * 512;
  for (int v = tid; v < 256 * 64; v += 256) {
    const int row = v >> 6, kc = v & 63;
    const int t = row >> 4, n = row & 15;
    float val[8];
    if (kc < 32) {
      const int s = kc >> 1, m0 = (kc & 1) * 8;
      const int delta = s - t + 15;
#pragma unroll
      for (int e = 0; e < 8; ++e) val[e] = Kc[(delta * 16 + n) * 16 + m0 + e];
    } else {
      const int dir = kc >= 48 ? 1 : 0;
      const int p0 = ((kc - 32) & 15) * 4;
      const int tau = dir == 0 ? t + 1 : 16 - t;
      const size_t cbase = ((size_t)((l * 2 + dir) * 32 + g) * 16 + n) * 64;
#pragma unroll
      for (int e = 0; e < 4; ++e) {
        const float cr = c_re[cbase + p0 + e], ci = c_im[cbase + p0 + e];
        const float2 lp = Lpow[(dir * 17 + tau) * 64 + p0 + e];
        val[2 * e] = cr * lp.x - ci * lp.y;
        val[2 * e + 1] = -(cr * lp.y + ci * lp.x);
      }
    }
    *(uint4*)(AC + (size_t)row * 512 + kc * 8) =
        uint4{pack2(val[0], val[1]), pack2(val[2], val[3]), pack2(val[4], val[5]), pack2(val[6], val[7])};
  }
  for (int v = tid; v < 256 * 32; v += 256) {
    const int row = v >> 5, kc = v & 31;
    const int dir = row >> 7, pp = (row >> 1) & 63, ri = row & 1;
    const int s = kc >> 1, m0 = (kc & 1) * 8;
    const float2 lp = Lpow[(dir * 17 + (dir == 0 ? 15 - s : s)) * 64 + pp];
    float val[8];
#pragma unroll
    for (int e = 0; e < 8; ++e) {
      const float2 bb = Bbar[(dir * 64 + pp) * 16 + m0 + e];
      val[e] = ri == 0 ? (lp.x * bb.x - lp.y * bb.y) : (lp.x * bb.y + lp.y * bb.x);
    }
    *(uint4*)(W1 + (size_t)row * 256 + kc * 8) =
        uint4{pack2(val[0], val[1]), pack2(val[2], val[3]), pack2(val[4], val[5]), pack2(val[6], val[7])};
  }
  __syncthreads();
}

DEVI void table_item(const Params& p, int idx) {
  const int tid = opaque_tid();
  if (idx < 512) {
    bf16_t* T = (bf16_t*)(p.ws + OFF_T1024);
    for (int e = tid; e < 4096; e += 256) {
      const int g = idx * 4096 + e, k = g >> 11, kk = g & 2047;
      const int ph = (k * (kk & 1023)) & 1023;
      float s, c; sincospif((float)ph * (2.0f / 1024.0f), &s, &c);
      T[g] = f2bf(kk < 1024 ? c : -s);
    }
    return;
  }
  idx -= 512;
  if (idx < 32) {
    bf16_t* T = (bf16_t*)(p.ws + OFF_T256);
    for (int e = tid; e < 4096; e += 256) {
      const int g = idx * 4096 + e, k = g >> 9, kk = g & 511;
      const int ph = (k * (kk & 255)) & 255;
      float s, c; sincospif((float)ph * (2.0f / 256.0f), &s, &c);
      T[g] = f2bf(kk < 256 ? c : -s);
    }
    return;
  }
  idx -= 32;
  if (idx < 8) {
    bf16_t* T = (bf16_t*)(p.ws + OFF_DFT128);
    for (int e = tid; e < 4096; e += 256) {
      const int g = idx * 4096 + e, n1 = g >> 7, c_ = g & 127;
      const int ph = (c_ * (n1 & 127)) & 127;
      float s, c; sincospif((float)ph * (2.0f / 128.0f), &s, &c);
      T[g] = f2bf(n1 < 128 ? c : s);
    }
    return;
  }
  idx -= 8;
  {
    float2* T = (float2*)(p.ws + OFF_ROPE);
    for (int e = tid; e < 4096; e += 256) {
      const int g = idx * 4096 + e, t = g >> 5, i = g & 31;
      const float pos = (i < 16) ? (float)(t >> 6) : (float)(t & 63);
      const float fr_ = powf(10000.0f, -(float)(i & 15) / 16.0f);
      float s, c; sincosf(pos * fr_, &s, &c);
      T[g] = float2{c, s};
    }
  }
}

DEVI const float* xin_row(const Params& p, int m) {
  return m < MCTX ? p.in[0] + (size_t)m * 1024 : p.in[1] + (size_t)(m - MCTX) * 1024;
}

DEVI void modulate0_row(const Params& p, int m) {
  const int lane = opaque_tid() & 63;
  const float* x = xin_row(p, m);
  const float* mod = (const float*)(p.ws + OFF_MOD) + (size_t)modrow(m) * 6144;
  bf16_t* u = (bf16_t*)(p.ws + OFF_U) + (size_t)m * 1024;
#pragma unroll
  for (int k = 0; k < 4; ++k) {
    const int c = lane * 4 + 256 * k;
    const float4 v = *(const float4*)(x + c);
    const float4 sh = *(const float4*)(mod + c);
    const float4 sc = *(const float4*)(mod + 1024 + c);
    uint2 o;
    o.x = pack2(v.x * (1.f + sc.x) + sh.x, v.y * (1.f + sc.y) + sh.y);
    o.y = pack2(v.z * (1.f + sc.z) + sh.z, v.w * (1.f + sc.w) + sh.w);
    *(uint2*)(u + c) = o;
  }
}

DEVI void ln_row(const Params& p, int m, const float* g, const float* b, const float* modl, int sh_off, int sc_off, bool write_u) {
  const int lane = opaque_tid() & 63;
  float* x = p.out + (size_t)m * 1024;
  float4 v[4];
  float s = 0.f;
#pragma unroll
  for (int k = 0; k < 4; ++k) {
    v[k] = *(const float4*)(x + lane * 4 + 256 * k);
    s += v[k].x + v[k].y + v[k].z + v[k].w;
  }
#pragma unroll
  for (int o = 32; o >= 1; o >>= 1) s += __shfl_xor(s, o);
  const float mu = s * (1.0f / 1024.0f);
  float q = 0.f;
#pragma unroll
  for (int k = 0; k < 4; ++k) {
    v[k].x -= mu; v[k].y -= mu; v[k].z -= mu; v[k].w -= mu;
    q += v[k].x * v[k].x + v[k].y * v[k].y + v[k].z * v[k].z + v[k].w * v[k].w;
  }
#pragma unroll
  for (int o = 32; o >= 1; o >>= 1) q += __shfl_xor(q, o);
  const float rs = rsqrtf(q * (1.0f / 1024.0f) + LN_EPS);
  const float* mod = modl + (size_t)modrow(m) * 6144;
  bf16_t* u = (bf16_t*)(p.ws + OFF_U) + (size_t)m * 1024;
#pragma unroll
  for (int k = 0; k < 4; ++k) {
    const int c = lane * 4 + 256 * k;
    const float4 gg = *(const float4*)(g + c);
    const float4 bb = *(const float4*)(b + c);
    float4 y;
    y.x = v[k].x * rs * gg.x + bb.x; y.y = v[k].y * rs * gg.y + bb.y;
    y.z = v[k].z * rs * gg.z + bb.z; y.w = v[k].w * rs * gg.w + bb.w;
    *(float4*)(x + c) = y;
    if (write_u) {
      const float4 sh = *(const float4*)(mod + sh_off + c);
      const float4 sc = *(const float4*)(mod + sc_off + c);
      uint2 o;
      o.x = pack2(y.x * (1.f + sc.x) + sh.x, y.y * (1.f + sc.y) + sh.y);
      o.y = pack2(y.z * (1.f + sc.z) + sh.z, y.w * (1.f + sc.w) + sh.w);
      *(uint2*)(u + c) = o;
    }
  }
}

DEVI void prep_token(const Params& p, int l, int tok) {
  const int lane = opaque_tid() & 63;
  bf16_t* Kd = (bf16_t*)(p.ws + OFF_KD); bf16_t* VTd = (bf16_t*)(p.ws + OFF_VTD);
  bf16_t* Kc = (bf16_t*)(p.ws + OFF_KC); bf16_t* VTc = (bf16_t*)(p.ws + OFF_VTC);
  if (tok >= M) {
    const int b = (tok - M) >> 9, j = (tok - M) & 511;
    if (lane < 32) {
      const int li = lane & 15, hk = li >> 3, d0 = (li & 7) * 8;
      const float* src = (lane < 16 ? p.in[3] : p.in[4]) + ((size_t)((b * 2 + l) * 512 + j)) * 128 + li * 8;
      const float4 v0 = *(const float4*)src, v1 = *(const float4*)(src + 4);
      const float vv[8] = {v0.x, v0.y, v0.z, v0.w, v1.x, v1.y, v1.z, v1.w};
      if (lane < 16) {
        *(uint4*)(Kd + ((size_t)(b * 2 + hk) * 1536 + 1024 + j) * 64 + d0) =
            uint4{pack2(vv[0], vv[1]), pack2(vv[2], vv[3]), pack2(vv[4], vv[5]), pack2(vv[6], vv[7])};
      } else {
#pragma unroll
        for (int e = 0; e < 8; ++e) VTd[((size_t)(b * 2 + hk) * 64 + d0 + e) * 1536 + 1024 + j] = f2bf(vv[e]);
      }
    }
    return;
  }
  const int m = tok;
  const bool dec = m >= MCTX;
  const int b = dec ? (m - MCTX) >> 10 : m >> 8;
  const int t = dec ? (m - MCTX) & 1023 : m & 255;
  const bf16_t* z = (const bf16_t*)(p.ws + OFF_Z) + (size_t)m * 1792;
  const float2* rope = (const float2*)(p.ws + OFF_ROPE) + (size_t)t * 32;
  {
    const uint4 raw = *(const uint4*)(z + lane * 8);
    float x[8];
    x[0] = bf2f(raw.x & 0xffff); x[1] = bf2f(raw.x >> 16); x[2] = bf2f(raw.y & 0xffff); x[3] = bf2f(raw.y >> 16);
    x[4] = bf2f(raw.z & 0xffff); x[5] = bf2f(raw.z >> 16); x[6] = bf2f(raw.w & 0xffff); x[7] = bf2f(raw.w >> 16);
    float ss = 0.f;
#pragma unroll
    for (int e = 0; e < 8; ++e) ss += x[e] * x[e];
    ss += __shfl_xor(ss, 1); ss += __shfl_xor(ss, 2); ss += __shfl_xor(ss, 4);
    const float rn = rsqrtf(ss * (1.0f / 64.0f) + LN_EPS);
    const int d0 = (lane & 7) * 8;
    const float* gq = p.in[10] + l * 64 + d0;
#pragma unroll
    for (int e = 0; e < 8; ++e) x[e] = x[e] * rn * gq[e];
    if (dec) {
#pragma unroll
      for (int e = 0; e < 4; ++e) {
        const float2 cs = rope[(d0 >> 1) + e];
        const float x0 = x[2 * e], x1 = x[2 * e + 1];
        x[2 * e] = x0 * cs.x - x1 * cs.y;
        x[2 * e + 1] = x0 * cs.y + x1 * cs.x;
      }
    }
    const float qs = 0.125f * 1.4426950408889634f;
    *(uint4*)((bf16_t*)(p.ws + OFF_QN) + (size_t)m * 512 + lane * 8) =
        uint4{pack2(x[0] * qs, x[1] * qs), pack2(x[2] * qs, x[3] * qs), pack2(x[4] * qs, x[5] * qs), pack2(x[6] * qs, x[7] * qs)};
  }
  {
    const int li = lane & 15, hk = li >> 3, d0 = (li & 7) * 8;
    const uint4 raw = *(const uint4*)(z + 512 + li * 8);
    float x[8];
    x[0] = bf2f(raw.x & 0xffff); x[1] = bf2f(raw.x >> 16); x[2] = bf2f(raw.y & 0xffff); x[3] = bf2f(raw.y >> 16);
    x[4] = bf2f(raw.z & 0xffff); x[5] = bf2f(raw.z >> 16); x[6] = bf2f(raw.w & 0xffff); x[7] = bf2f(raw.w >> 16);
    float ss = 0.f;
#pragma unroll
    for (int e = 0; e < 8; ++e) ss += x[e] * x[e];
    ss += __shfl_xor(ss, 1); ss += __shfl_xor(ss, 2); ss += __shfl_xor(ss, 4);
    const float rn = rsqrtf(ss * (1.0f / 64.0f) + LN_EPS);
    const float* gk = p.in[11] + l * 64 + d0;
#pragma unroll
    for (int e = 0; e < 8; ++e) x[e] = x[e] * rn * gk[e];
    if (lane < 16) {
      if (!dec) {
        float* ck = p.out + OUT_CK + ((size_t)((b * 2 + l) * 256 + t)) * 128 + li * 8;
        *(float4*)ck = float4{x[0], x[1], x[2], x[3]};
        *(float4*)(ck + 4) = float4{x[4], x[5], x[6], x[7]};
        *(uint4*)(Kc + ((size_t)(b * 2 + hk) * 256 + t) * 64 + d0) =
            uint4{pack2(x[0], x[1]), pack2(x[2], x[3]), pack2(x[4], x[5]), pack2(x[6], x[7])};
      } else {
#pragma unroll
        for (int e = 0; e < 4; ++e) {
          const float2 cs = rope[(d0 >> 1) + e];
          const float x0 = x[2 * e], x1 = x[2 * e + 1];
          x[2 * e] = x0 * cs.x - x1 * cs.y;
          x[2 * e + 1] = x0 * cs.y + x1 * cs.x;
        }
        *(uint4*)(Kd + ((size_t)(b * 2 + hk) * 1536 + t) * 64 + d0) =
            uint4{pack2(x[0], x[1]), pack2(x[2], x[3]), pack2(x[4], x[5]), pack2(x[6], x[7])};
      }
    }
  }
  if (lane >= 16 && lane < 32) {
    const int li = lane - 16, hk = li >> 3, d0 = (li & 7) * 8;
    const uint4 raw = *(const uint4*)(z + 640 + li * 8);
    float x[8];
    x[0] = bf2f(raw.x & 0xffff); x[1] = bf2f(raw.x >> 16); x[2] = bf2f(raw.y & 0xffff); x[3] = bf2f(raw.y >> 16);
    x[4] = bf2f(raw.z & 0xffff); x[5] = bf2f(raw.z >> 16); x[6] = bf2f(raw.w & 0xffff); x[7] = bf2f(raw.w >> 16);
    if (!dec) {
      float* cv = p.out + OUT_CV + ((size_t)((b * 2 + l) * 256 + t)) * 128 + li * 8;
      *(float4*)cv = float4{x[0], x[1], x[2], x[3]};
      *(float4*)(cv + 4) = float4{x[4], x[5], x[6], x[7]};
#pragma unroll
      for (int e = 0; e < 8; ++e) VTc[((size_t)(b * 2 + hk) * 64 + d0 + e) * 256 + t] = f2bf(x[e]);
    } else {
#pragma unroll
      for (int e = 0; e < 8; ++e) VTd[((size_t)(b * 2 + hk) * 64 + d0 + e) * 1536 + t] = f2bf(x[e]);
    }
  }
}

DEVI void attn_item(const Params& p, int a, unsigned char* smem) {
  const int tid = opaque_tid(), lane = tid & 63, wave = tid >> 6, fr = lane & 15, fq = lane >> 4;
  int h, Lk, m0;
  const bf16_t *Kb, *Vb;
  if (a < 512) {
    const int b = a >> 6; h = (a >> 3) & 7; const int qb = a & 7; Lk = 1536; m0 = MCTX + b * 1024 + qb * 128;
    const int bh = b * 2 + (h >> 2);
    Kb = (const bf16_t*)(p.ws + OFF_KD) + (size_t)bh * 1536 * 64;
    Vb = (const bf16_t*)(p.ws + OFF_VTD) + (size_t)bh * 64 * 1536;
  } else {
    a -= 512;
    const int b = a >> 4; h = (a >> 1) & 7; const int qb = a & 1; Lk = 256; m0 = b * 256 + qb * 128;
    const int bh = b * 2 + (h >> 2);
    Kb = (const bf16_t*)(p.ws + OFF_KC) + (size_t)bh * 256 * 64;
    Vb = (const bf16_t*)(p.ws + OFF_VTC) + (size_t)bh * 64 * 256;
  }
  const bf16_t* Qn = (const bf16_t*)(p.ws + OFF_QN);
  bf16x8 qf[2][2];
#pragma unroll
  for (int jq = 0; jq < 2; ++jq)
#pragma unroll
    for (int ks = 0; ks < 2; ++ks)
      qf[jq][ks] = *(const bf16x8*)(Qn + (size_t)(m0 + wave * 32 + jq * 16 + fr) * 512 + h * 64 + ks * 32 + fq * 8);
  f32x4 o[4][2];
#pragma unroll
  for (int di = 0; di < 4; ++di)
#pragma unroll
    for (int jq = 0; jq < 2; ++jq) o[di][jq] = f32x4{0.f, 0.f, 0.f, 0.f};
  float mrow[2] = {-1e30f, -1e30f}, lrow[2] = {0.f, 0.f};
  const int nt = Lk >> 6;
  const int srow = tid >> 3, sch = tid & 7;
  const int woff = srow * 128 + ((sch ^ ((srow >> 1) & 7)) << 4);
  const int swz = fr >> 1;
  uint4 rk[2], rv[2];
#pragma unroll
  for (int it = 0; it < 2; ++it) {
    rk[it] = *(const uint4*)(Kb + (size_t)(srow + 32 * it) * 64 + sch * 8);
    rv[it] = *(const uint4*)(Vb + (size_t)(srow + 32 * it) * Lk + sch * 8);
  }
#pragma unroll
  for (int it = 0; it < 2; ++it) {
    *(uint4*)(smem + woff + it * 4096) = rk[it];
    *(uint4*)(smem + 8192 + woff + it * 4096) = rv[it];
  }
  __syncthreads();
#pragma unroll 1
  for (int kt = 0; kt < nt; ++kt) {
    const int cur = (kt & 1) * 16384;
    {
      const int kn = (kt + 1 < nt) ? kt + 1 : kt;
#pragma unroll
      for (int it = 0; it < 2; ++it) {
        rk[it] = *(const uint4*)(Kb + (size_t)(kn * 64 + srow + 32 * it) * 64 + sch * 8);
        rv[it] = *(const uint4*)(Vb + (size_t)(srow + 32 * it) * Lk + kn * 64 + sch * 8);
      }
    }
    f32x4 s[4][2];
#pragma unroll
    for (int i = 0; i < 4; ++i)
#pragma unroll
      for (int jq = 0; jq < 2; ++jq) s[i][jq] = f32x4{0.f, 0.f, 0.f, 0.f};
#pragma unroll
    for (int ks = 0; ks < 2; ++ks) {
      const int co = ((ks * 4 + fq) ^ swz) << 4;
#pragma unroll
      for (int i = 0; i < 4; ++i) {
        const bf16x8 kf = *(const bf16x8*)(smem + cur + (i * 16 + fr) * 128 + co);
#pragma unroll
        for (int jq = 0; jq < 2; ++jq) s[i][jq] = __builtin_amdgcn_mfma_f32_16x16x32_bf16(kf, qf[jq][ks], s[i][jq], 0, 0, 0);
      }
    }
#pragma unroll
    for (int jq = 0; jq < 2; ++jq) {
      float mx = -1e30f;
#pragma unroll
      for (int i = 0; i < 4; ++i)
#pragma unroll
        for (int r = 0; r < 4; ++r) mx = fmaxf(mx, s[i][jq][r]);
      mx = fmaxf(mx, __shfl_xor(mx, 16));
      mx = fmaxf(mx, __shfl_xor(mx, 32));
      const float mnew = fmaxf(mrow[jq], mx);
      const float alpha = exp2f(mrow[jq] - mnew);
      mrow[jq] = mnew;
      float ls = 0.f;
#pragma unroll
      for (int i = 0; i < 4; ++i)
#pragma unroll
        for (int r = 0; r < 4; ++r) { const float e = exp2f(s[i][jq][r] - mnew); s[i][jq][r] = e; ls += e; }
      lrow[jq] = lrow[jq] * alpha + ls;
#pragma unroll
      for (int di = 0; di < 4; ++di)
#pragma unroll
        for (int r = 0; r < 4; ++r) o[di][jq][r] *= alpha;
    }
#pragma unroll
    for (int kk = 0; kk < 2; ++kk) {
      bf16x8 pf[2];
#pragma unroll
      for (int jq = 0; jq < 2; ++jq) {
        union { uint4 u; bf16x8 v; } cv;
        cv.u = uint4{pack2(s[2 * kk][jq][0], s[2 * kk][jq][1]), pack2(s[2 * kk][jq][2], s[2 * kk][jq][3]),
                     pack2(s[2 * kk + 1][jq][0], s[2 * kk + 1][jq][1]), pack2(s[2 * kk + 1][jq][2], s[2 * kk + 1][jq][3])};
        pf[jq] = cv.v;
      }
      const int c0 = ((4 * kk + (fq >> 1)) ^ swz) << 4;
      const int c1 = ((4 * kk + 2 + (fq >> 1)) ^ swz) << 4;
      const int wi = (fq & 1) * 8;
#pragma unroll
      for (int di = 0; di < 4; ++di) {
        const unsigned char* vrow = smem + cur + 8192 + (di * 16 + fr) * 128;
        union { uint2 u[2]; bf16x8 v; } cv;
        cv.u[0] = *(const uint2*)(vrow + c0 + wi);
        cv.u[1] = *(const uint2*)(vrow + c1 + wi);
#pragma unroll
        for (int jq = 0; jq < 2; ++jq) o[di][jq] = __builtin_amdgcn_mfma_f32_16x16x32_bf16(cv.v, pf[jq], o[di][jq], 0, 0, 0);
      }
    }
    {
      const int nxt = 16384 - cur;
#pragma unroll
      for (int it = 0; it < 2; ++it) {
        *(uint4*)(smem + nxt + woff + it * 4096) = rk[it];
        *(uint4*)(smem + nxt + 8192 + woff + it * 4096) = rv[it];
      }
    }
    __syncthreads();
  }
  bf16_t* att = (bf16_t*)(p.ws + OFF_ATT);
#pragma unroll
  for (int jq = 0; jq < 2; ++jq) {
    float lt = lrow[jq];
    lt += __shfl_xor(lt, 16);
    lt += __shfl_xor(lt, 32);
    const float inv = 1.0f / lt;
    bf16_t* dst = att + (size_t)(m0 + wave * 32 + jq * 16 + fr) * 512 + h * 64 + 4 * fq;
#pragma unroll
    for (int di = 0; di < 4; ++di)
      *(uint2*)(dst + di * 16) = uint2{pack2(o[di][jq][0] * inv, o[di][jq][1] * inv), pack2(o[di][jq][2] * inv, o[di][jq][3] * inv)};
  }
}

DEVI int ssm_col_row(int sub, int j) {
  return sub < 8 ? MCTX + sub * 1024 + j * 16 : ((sub - 8) * 4 + (j >> 4)) * 256 + (j & 15) * 16;
}

DEVI void ssm_item(const Params& p, int l, int idx, unsigned char* smem) {
  const int g = idx / 12, sub = idx % 12;
  const int tid = opaque_tid(), lane = tid & 63, wave = tid >> 6, fr = lane & 15, fq = lane >> 4;
  const bf16_t* AC = (const bf16_t*)(p.ws + OFF_SSM) + (size_t)(l * 32 + g) * SSM_EL;
  const bf16_t* W1 = AC + 256 * 512;
  const bf16_t* z = (const bf16_t*)(p.ws + OFF_Z);
  const int ucol = 768 + g * 16;
  size_t ubase[4];
#pragma unroll
  for (int jt = 0; jt < 4; ++jt) ubase[jt] = (size_t)ssm_col_row(sub, jt * 16 + fr) * 1792 + ucol;
  f32x4 acc[4][4];
  zero_acc(acc);
#pragma unroll 1
  for (int ks = 0; ks < 8; ++ks) {
    const int s = 2 * ks + (fq >> 1), m8 = (fq & 1) * 8;
    bf16x8 a[4], b[4];
#pragma unroll
    for (int i = 0; i < 4; ++i) a[i] = *(const bf16x8*)(W1 + (size_t)(wave * 64 + i * 16 + fr) * 256 + ks * 32 + fq * 8);
#pragma unroll
    for (int jt = 0; jt < 4; ++jt) b[jt] = *(const bf16x8*)(z + ubase[jt] + (size_t)s * 1792 + m8);
#pragma unroll
    for (int i = 0; i < 4; ++i)
#pragma unroll
      for (int jt = 0; jt < 4; ++jt) acc[i][jt] = __builtin_amdgcn_mfma_f32_16x16x32_bf16(a[i], b[jt], acc[i][jt], 0, 0, 0);
  }
#pragma unroll
  for (int i = 0; i < 4; ++i)
#pragma unroll
    for (int jt = 0; jt < 4; ++jt) {
      const int j = jt * 16 + fr;
      const int ch = (wave * 64 + i * 16 + 4 * fq) >> 2;
      *(f32x4*)(smem + j * 1024 + ((ch ^ (j & 15)) << 4)) = acc[i][jt];
    }
  __syncthreads();
  if (tid < 128) {
    const int dir = tid >> 6, pp = tid & 63;
    const float2 lam = ((const float2*)(p.ws + OFF_LAM16))[((l * 2 + dir) * 32 + g) * 64 + pp];
    const int nseq = sub < 8 ? 1 : 4, nch = sub < 8 ? 64 : 16;
    const int ch = (dir * 64 + pp) >> 1, wi = (pp & 1) * 8;
    for (int q = 0; q < nseq; ++q) {
      float hr = 0.f, hi = 0.f;
      if (sub < 8) {
        const float* h0 = p.in[5] + ((size_t)(((sub * 2 + l) * 2 + dir) * 32 + g) * 64 + pp) * 2;
        hr = h0[0]; hi = h0[1];
      }
      for (int c = 0; c < nch; ++c) {
        const int j = q * nch + (dir == 0 ? c : nch - 1 - c);
        float2* f = (float2*)(smem + j * 1024 + ((ch ^ (j & 15)) << 4) + wi);
        const float2 F = *f;
        *f = float2{hr, hi};
        const float nr = lam.x * hr - lam.y * hi + F.x;
        const float ni = lam.x * hi + lam.y * hr + F.y;
        hr = nr; hi = ni;
      }
      if (sub >= 8) {
        const int b = (sub - 8) * 4 + q;
        float* st = p.out + OUT_ST + ((size_t)(((b * 2 + l) * 2 + dir) * 32 + g) * 64 + pp) * 2;
        st[0] = hr; st[1] = hi;
      }
    }
  }
  __syncthreads();
  zero_acc(acc);
#pragma unroll 1
  for (int ks = 0; ks < 16; ++ks) {
    bf16x8 a[4], b[4];
#pragma unroll
    for (int i = 0; i < 4; ++i) a[i] = *(const bf16x8*)(AC + (size_t)(wave * 64 + i * 16 + fr) * 512 + ks * 32 + fq * 8);
    if (ks < 8) {
      const int s = 2 * ks + (fq >> 1), m8 = (fq & 1) * 8;
#pragma unroll
      for (int jt = 0; jt < 4; ++jt) b[jt] = *(const bf16x8*)(z + ubase[jt] + (size_t)s * 1792 + m8);
    } else {
      const int c0 = ((ks - 8) * 32 + fq * 8) >> 2;
#pragma unroll
      for (int jt = 0; jt < 4; ++jt) {
        const int j = jt * 16 + fr;
        const f32x4 v0 = *(const f32x4*)(smem + j * 1024 + ((c0 ^ (j & 15)) << 4));
        const f32x4 v1 = *(const f32x4*)(smem + j * 1024 + (((c0 + 1) ^ (j & 15)) << 4));
        union { uint4 u; bf16x8 v; } cv;
        cv.u = uint4{pack2(v0[0], v0[1]), pack2(v0[2], v0[3]), pack2(v1[0], v1[1]), pack2(v1[2], v1[3])};
        b[jt] = cv.v;
      }
    }
#pragma unroll
    for (int i = 0; i < 4; ++i)
#pragma unroll
      for (int jt = 0; jt < 4; ++jt) acc[i][jt] = __builtin_amdgcn_mfma_f32_16x16x32_bf16(a[i], b[jt], acc[i][jt], 0, 0, 0);
  }
  bf16_t* sp = (bf16_t*)(p.ws + OFF_SSMP);
  const float4 dv = *(const float4*)(p.in[19] + l * 512 + g * 16 + 4 * fq);
#pragma unroll
  for (int i = 0; i < 4; ++i) {
    const int t = wave * 4 + i;
#pragma unroll
    for (int jt = 0; jt < 4; ++jt) {
      const size_t row = (size_t)ssm_col_row(sub, jt * 16 + fr) + t;
      const uint2 uu = *(const uint2*)(z + row * 1792 + ucol + 4 * fq);
      const float y0 = gelu_tanh(acc[i][jt][0] + dv.x * bf2f(uu.x & 0xffff));
      const float y1 = gelu_tanh(acc[i][jt][1] + dv.y * bf2f(uu.x >> 16));
      const float y2 = gelu_tanh(acc[i][jt][2] + dv.z * bf2f(uu.y & 0xffff));
      const float y3 = gelu_tanh(acc[i][jt][3] + dv.w * bf2f(uu.y >> 16));
      *(uint2*)(sp + row * 512 + g * 16 + 4 * fq) = uint2{pack2(y0, y1), pack2(y2, y3)};
      asm volatile("" ::: "memory");
    }
  }
  __syncthreads();
}

#define TILE_IDS \
  const int tid = opaque_tid(), lane = tid & 63, wave = tid >> 6, wp = wave >> 1, wq = wave & 1, fr = lane & 15, fq = lane >> 4; \
  (void)tid; (void)wp; (void)wq; (void)fr; (void)fq;

DEVI void z_tile(const Params& p, int l, int t, unsigned char* smem) {
  TILE_IDS
  int mt, nt; grp_tile(t, 14, mt, nt);
  const bf16_t* P = (const bf16_t*)(p.ws + OFF_W) + (size_t)l * WL_TOT + WL_IN + (size_t)nt * 128 * 1024;
  const bf16_t* Q = (const bf16_t*)(p.ws + OFF_U) + (size_t)mt * 128 * 1024;
  f32x4 acc[4][4];
  zero_acc(acc);
  gemm_core2(P, 1024, Q, 1024, 1024, acc, smem);
  bf16_t* z = (bf16_t*)(p.ws + OFF_Z);
#pragma unroll
  for (int i = 0; i < 4; ++i)
#pragma unroll
    for (int j = 0; j < 4; ++j) {
      const int n = nt * 128 + wp * 64 + i * 16 + 4 * fq, m = mt * 128 + wq * 64 + j * 16 + fr;
      *(uint2*)(z + (size_t)m * 1792 + n) = uint2{pack2(acc[i][j][0], acc[i][j][1]), pack2(acc[i][j][2], acc[i][j][3])};
    }
}

DEVI void four1_tile(const Params& p, int t, unsigned char* smem) {
  TILE_IDS
  const int mt = t >> 3, grp = (t >> 1) & 3, half = t & 1;
  const bf16_t* P = (const bf16_t*)(p.ws + OFF_Z) + (size_t)mt * 128 * 1792 + 1280 + grp * 128;
  const bf16_t* Q = (const bf16_t*)(p.ws + OFF_DFT128) + (size_t)half * 128 * 128;
  f32x4 acc[4][4];
  zero_acc(acc);
  gemm_core2(P, 1792, Q, 128, 128, acc, smem);
  bf16_t* GT = (bf16_t*)(p.ws + OFF_GT);
  const int m0 = mt * 128;
  int L; bf16_t* gb; int lpos0;
  if (m0 < MCTX) { L = 256; gb = GT + (size_t)(m0 >> 8) * 512 * 512; lpos0 = m0 & 255; }
  else { L = 1024; gb = GT + (size_t)16 * 512 * 512 + (size_t)((m0 - MCTX) >> 10) * 512 * 2048; lpos0 = (m0 - MCTX) & 1023; }
#pragma unroll
  for (int i = 0; i < 4; ++i)
#pragma unroll
    for (int j = 0; j < 4; ++j) {
      const int lp = lpos0 + wp * 64 + i * 16 + 4 * fq;
      const int cp = wq * 64 + j * 16 + fr;
      *(uint2*)(gb + (size_t)(grp * 128 + cp) * (2 * L) + half * L + lp) =
          uint2{pack2(acc[i][j][0], acc[i][j][1]), pack2(acc[i][j][2], acc[i][j][3])};
    }
}

DEVI void four2_tile(const Params& p, int t, unsigned char* smem) {
  TILE_IDS
  const bf16_t* GT = (const bf16_t*)(p.ws + OFF_GT);
  const bf16_t *P, *Q; int K, mrow0, nt; float scale;
  if (t < 128) {
    const int b = t >> 3, pt = (t >> 2) & 1; nt = t & 3;
    P = GT + (size_t)b * 512 * 512 + (size_t)nt * 128 * 512;
    Q = (const bf16_t*)(p.ws + OFF_T256) + (size_t)pt * 128 * 512;
    K = 512; mrow0 = b * 256 + pt * 128; scale = 0.005524271728019903f;
  } else {
    t -= 128;
    const int b = t >> 5, pt = (t >> 2) & 7; nt = t & 3;
    P = GT + (size_t)16 * 512 * 512 + (size_t)b * 512 * 2048 + (size_t)nt * 128 * 2048;
    Q = (const bf16_t*)(p.ws + OFF_T1024) + (size_t)pt * 128 * 2048;
    K = 2048; mrow0 = MCTX + b * 1024 + pt * 128; scale = 0.0027621358640099515f;
  }
  f32x4 acc[4][4];
  zero_acc(acc);
  gemm_core2(P, K, Q, K, K, acc, smem);
  bf16_t* fo = (bf16_t*)(p.ws + OFF_FOUR);
#pragma unroll
  for (int i = 0; i < 4; ++i)
#pragma unroll
    for (int j = 0; j < 4; ++j) {
      const int n = nt * 128 + wp * 64 + i * 16 + 4 * fq, m = mrow0 + wq * 64 + j * 16 + fr;
      *(uint2*)(fo + (size_t)m * 512 + n) =
          uint2{pack2(acc[i][j][0] * scale, acc[i][j][1] * scale), pack2(acc[i][j][2] * scale, acc[i][j][3] * scale)};
    }
}

DEVI void glu_tile(const Params& p, int l, int t, unsigned char* smem) {
  TILE_IDS
  int mt, nt; grp_tile(t, 4, mt, nt);
  const bf16_t* P = (const bf16_t*)(p.ws + OFF_W) + (size_t)l * WL_TOT + WL_GLU + (size_t)nt * 128 * 512;
  const bf16_t* sp = (const bf16_t*)(p.ws + OFF_SSMP);
  const bf16_t* Q = sp + (size_t)mt * 128 * 512;
  f32x4 acc[4][4];
  zero_acc(acc);
  gemm_core2(P, 512, Q, 512, 512, acc, smem);
  bf16_t* sg = (bf16_t*)(p.ws + OFF_SSMG);
#pragma unroll
  for (int i = 0; i < 4; ++i)
#pragma unroll
    for (int j = 0; j < 4; ++j) {
      const int n = nt * 128 + wp * 64 + i * 16 + 4 * fq, m = mt * 128 + wq * 64 + j * 16 + fr;
      const float4 bg = *(const float4*)(p.in[21] + l * 512 + n);
      const uint2 yy = *(const uint2*)(sp + (size_t)m * 512 + n);
      const float y0 = bf2f(yy.x & 0xffff), y1 = bf2f(yy.x >> 16), y2 = bf2f(yy.y & 0xffff), y3 = bf2f(yy.y >> 16);
      *(uint2*)(sg + (size_t)m * 512 + n) =
          uint2{pack2(y0 * sigmoidf_(acc[i][j][0] + bg.x), y1 * sigmoidf_(acc[i][j][1] + bg.y)),
                pack2(y2 * sigmoidf_(acc[i][j][2] + bg.z), y3 * sigmoidf_(acc[i][j][3] + bg.w))};
      asm volatile("" ::: "memory");
    }
}

DEVI void merged_tile(const Params& p, int l, int t, unsigned char* smem) {
  TILE_IDS
  int mt, nt; grp_tile(t, 8, mt, nt);
  const bf16_t* wl = (const bf16_t*)(p.ws + OFF_W) + (size_t)l * WL_TOT;
  const bf16_t* u = (const bf16_t*)(p.ws + OFF_U) + (size_t)mt * 128 * 1024;
  bf16_t* mo = (bf16_t*)(p.ws + OFF_GT);
#pragma unroll 1
  for (int br = 0; br < 3; ++br) {
    uint2 sg[4][4];
    {
      f32x4 acc[4][4];
      zero_acc(acc);
      gemm_core2(wl + WL_IN + (size_t)(1792 + br * 1024 + nt * 128) * 1024, 1024, u, 1024, 1024, acc, smem);
#pragma unroll
      for (int i = 0; i < 4; ++i)
#pragma unroll
        for (int j = 0; j < 4; ++j)
          sg[i][j] = uint2{pack2(sigmoidf_(acc[i][j][0]), sigmoidf_(acc[i][j][1])), pack2(sigmoidf_(acc[i][j][2]), sigmoidf_(acc[i][j][3]))};
    }
    {
      f32x4 acc[4][4];
      zero_acc(acc);
      const bf16_t* X = (const bf16_t*)(p.ws + OFF_ATT) + (size_t)br * M * 512 + (size_t)mt * 128 * 512;
      gemm_core2(wl + WL_BR + (size_t)br * 1024 * 512 + (size_t)nt * 128 * 512, 512, X, 512, 512, acc, smem);
#pragma unroll
      for (int i = 0; i < 4; ++i)
#pragma unroll
        for (int j = 0; j < 4; ++j) {
          const int n = nt * 128 + wp * 64 + i * 16 + 4 * fq, m = mt * 128 + wq * 64 + j * 16 + fr;
          uint2* dst = (uint2*)(mo + (size_t)m * 1024 + n);
          float v0 = bf2f(sg[i][j].x & 0xffff) * acc[i][j][0];
          float v1 = bf2f(sg[i][j].x >> 16) * acc[i][j][1];
          float v2 = bf2f(sg[i][j].y & 0xffff) * acc[i][j][2];
          float v3 = bf2f(sg[i][j].y >> 16) * acc[i][j][3];
          if (br > 0) {
            const uint2 o = *dst;
            v0 += bf2f(o.x & 0xffff); v1 += bf2f(o.x >> 16); v2 += bf2f(o.y & 0xffff); v3 += bf2f(o.y >> 16);
          }
          *dst = uint2{pack2(v0, v1), pack2(v2, v3)};
          asm volatile("" ::: "memory");
        }
    }
  }
}

DEVI void resid_tile(const Params& p, int l, int t, int which, unsigned char* smem) {
  TILE_IDS
  int mt, nt; grp_tile(t, 8, mt, nt);
  const bf16_t* wl = (const bf16_t*)(p.ws + OFF_W) + (size_t)l * WL_TOT;
  f32x4 acc[4][4];
  zero_acc(acc);
  if (which == 0)
    gemm_core2(wl + WL_OUT + (size_t)nt * 128 * 1024, 1024, (const bf16_t*)(p.ws + OFF_GT) + (size_t)mt * 128 * 1024, 1024, 1024, acc, smem);
  else
    gemm_core2(wl + WL_DN + (size_t)nt * 128 * 2816, 2816, (const bf16_t*)(p.ws + OFF_HG) + (size_t)mt * 128 * 2816, 2816, 2816, acc, smem);
  const float* modl = (const float*)(p.ws + OFF_MOD) + (size_t)l * 9 * 6144 + (which == 0 ? 2048 : 5120);
  const bool from_in = (l == 0 && which == 0);
#pragma unroll
  for (int i = 0; i < 4; ++i)
#pragma unroll
    for (int j = 0; j < 4; ++j) {
      const int n = nt * 128 + wp * 64 + i * 16 + 4 * fq, m = mt * 128 + wq * 64 + j * 16 + fr;
      const float4 gg = *(const float4*)(modl + (size_t)modrow(m) * 6144 + n);
      float* dst = p.out + (size_t)m * 1024 + n;
      const float4 xv = from_in ? *(const float4*)(xin_row(p, m) + n) : *(const float4*)dst;
      *(float4*)dst = float4{ALPHA * xv.x + gg.x * acc[i][j][0], ALPHA * xv.y + gg.y * acc[i][j][1],
                             ALPHA * xv.z + gg.z * acc[i][j][2], ALPHA * xv.w + gg.w * acc[i][j][3]};
    }
}

DEVI void up_tile(const Params& p, int l, int t, unsigned char* smem) {
  TILE_IDS
  int mt, nt; grp_tile(t, 44, mt, nt);
  const bf16_t* P = (const bf16_t*)(p.ws + OFF_W) + (size_t)l * WL_TOT + WL_UP + (size_t)nt * 128 * 1024;
  const bf16_t* Q = (const bf16_t*)(p.ws + OFF_U) + (size_t)mt * 128 * 1024;
  f32x4 acc[4][4];
  zero_acc(acc);
  gemm_core2(P, 1024, Q, 1024, 1024, acc, smem);
  bf16_t* T = (bf16_t*)smem;
#pragma unroll
  for (int i = 0; i < 4; ++i)
#pragma unroll
    for (int j = 0; j < 4; ++j) {
      const int n = wp * 64 + i * 16 + 4 * fq, m = wq * 64 + j * 16 + fr;
      *(uint2*)(T + m * 136 + n) = uint2{pack2(acc[i][j][0], acc[i][j][1]), pack2(acc[i][j][2], acc[i][j][3])};
    }
  __syncthreads();
  {
    const int c = tid & 63, r0 = (tid >> 6) * 32;
    const int ca = nt * 64 + c, cb = 2816 + nt * 64 + c;
    const float* cw = p.in[29] + (size_t)l * 3 * 5632;
    const float* cbias = p.in[30] + (size_t)l * 5632;
    const float wa0 = cw[ca], wa1 = cw[5632 + ca], wa2 = cw[2 * 5632 + ca], ba = cbias[ca];
    const float wb0 = cw[cb], wb1 = cw[5632 + cb], wb2 = cw[2 * 5632 + cb], bb = cbias[cb];
    bf16_t* hg = (bf16_t*)(p.ws + OFF_HG) + (size_t)(mt * 128) * 2816 + nt * 64 + c;
    float pa = r0 > 0 ? bf2f(T[(r0 - 1) * 136 + c]) : 0.f, pb = r0 > 0 ? bf2f(T[(r0 - 1) * 136 + 64 + c]) : 0.f;
    float ca_ = bf2f(T[r0 * 136 + c]), cb_ = bf2f(T[r0 * 136 + 64 + c]);
    for (int r = r0; r < r0 + 32; ++r) {
      const float na = r < 127 ? bf2f(T[(r + 1) * 136 + c]) : 0.f, nb = r < 127 ? bf2f(T[(r + 1) * 136 + 64 + c]) : 0.f;
      if (r > 0 && r < 127) {
        const float ha = wa0 * pa + wa1 * ca_ + wa2 * na + ba;
        const float hb = wb0 * pb + wb1 * cb_ + wb2 * nb + bb;
        hg[(size_t)r * 2816] = f2bf(ha * sigmoidf_(ha) * hb);
      }
      pa = ca_; pb = cb_; ca_ = na; cb_ = nb;
    }
    bf16_t* edge = (bf16_t*)(p.ws + OFF_EDGE) + (size_t)mt * 4 * 5632;
    const int e = tid >> 6;
    const int er = e < 2 ? e : 124 + e;
    edge[(size_t)e * 5632 + ca] = T[er * 136 + c];
    edge[(size_t)e * 5632 + cb] = T[er * 136 + 64 + c];
  }
  __syncthreads();
}

DEVI void edge_item(const Params& p, int l, int idx) {
  const int mt = idx >> 1, bot = idx & 1;
  const int L = mt < 32 ? 256 : 1024;
  const int m = mt * 128 + (bot ? 127 : 0);
  const int mloc = mt < 32 ? m : m - MCTX;
  const int pos = mloc & (L - 1);
  const bf16_t* edge = (const bf16_t*)(p.ws + OFF_EDGE);
  const bf16_t *prev, *cur, *next;
  bool hasp, hasn;
  if (!bot) {
    hasp = pos != 0; hasn = true;
    prev = edge + ((size_t)(mt > 0 ? mt - 1 : 0) * 4 + 3) * 5632;
    cur = edge + ((size_t)mt * 4 + 0) * 5632;
    next = edge + ((size_t)mt * 4 + 1) * 5632;
  } else {
    hasp = true; hasn = pos != L - 1;
    prev = edge + ((size_t)mt * 4 + 2) * 5632;
    cur = edge + ((size_t)mt * 4 + 3) * 5632;
    next = edge + ((size_t)(mt < 95 ? mt + 1 : 95) * 4 + 0) * 5632;
  }
  const float* cw = p.in[29] + (size_t)l * 3 * 5632;
  const float* cbias = p.in[30] + (size_t)l * 5632;
  bf16_t* hg = (bf16_t*)(p.ws + OFF_HG) + (size_t)m * 2816;
  for (int c = opaque_tid(); c < 2816; c += 256) {
    const int cb = 2816 + c;
    const float pa = hasp ? bf2f(prev[c]) : 0.f, pb = hasp ? bf2f(prev[cb]) : 0.f;
    const float na = hasn ? bf2f(next[c]) : 0.f, nb = hasn ? bf2f(next[cb]) : 0.f;
    const float ha = cw[c] * pa + cw[5632 + c] * bf2f(cur[c]) + cw[2 * 5632 + c] * na + cbias[c];
    const float hb = cw[cb] * pb + cw[5632 + cb] * bf2f(cur[cb]) + cw[2 * 5632 + cb] * nb + cbias[cb];
    hg[c] = f2bf(ha * sigmoidf_(ha) * hb);
  }
}


#define XB_TMO      128
#define XB_XCNT(j)  (256  + 64 * (j))
#define XB_XSUB(j)  (1280 + 64 * (j))
#define XB_XGEN(j)  (2304 + 64 * (j))
#define XB_TOP      3328
#define XB_TOPGEN   3392
#define XCD_BAR_WORDS 3456
#define XB_SPIN_CAP (1u << 20)
#define LAS __attribute__((address_space(3)))
DEVI unsigned xb_ld(unsigned* p) { return __hip_atomic_load(p, __ATOMIC_RELAXED, __HIP_MEMORY_SCOPE_AGENT); }
DEVI unsigned xb_add(unsigned* p, unsigned v) { return __hip_atomic_fetch_add(p, v, __ATOMIC_RELAXED, __HIP_MEMORY_SCOPE_AGENT); }
DEVI unsigned xb_xcc_id() { return (unsigned)__builtin_amdgcn_s_getreg((3 << 11) | 20) & 0xFu; }
#define XB_SPIN(cond, bar) do { unsigned _sp = 0; while (cond) { __builtin_amdgcn_s_sleep(1); \
    if ((++_sp & 255u) == 0u) { if (xb_ld(&(bar)[XB_TMO])) break; if (_sp > XB_SPIN_CAP) { atomicAdd(&(bar)[XB_TMO], 1u); break; } } } } while (0)
struct XcdBarrier { unsigned* bar; unsigned x; volatile LAS unsigned* st; };
DEVI XcdBarrier xcd_barrier_post(unsigned* bar, volatile LAS unsigned* st) {
  XcdBarrier b; b.bar = bar; b.x = xb_xcc_id(); b.st = st;
  if (threadIdx.x == 0) (void)xb_add(&bar[XB_XCNT(b.x)], 1u);
  return b;
}
DEVI void xcd_barrier_complete(unsigned* bar, unsigned x, unsigned& nloc, unsigned& nx) {
  const unsigned G = gridDim.x * gridDim.y * gridDim.z;
  unsigned sum, cnt, mine, sp = 0u;
  for (;;) {
    sum = 0u; cnt = 0u; mine = 0u;
#pragma unroll
    for (unsigned j = 0; j < 16; ++j) { const unsigned c = xb_ld(&bar[XB_XCNT(j)]); sum += c; cnt += (c > 0u) ? 1u : 0u; mine = (j == x) ? c : mine; }
    if (sum == G) break;
    __builtin_amdgcn_s_sleep(1);
    if ((++sp & 255u) == 0u) { if (xb_ld(&bar[XB_TMO])) break; if (sp > XB_SPIN_CAP) { atomicAdd(&bar[XB_TMO], 1u); break; } }
  }
  nloc = mine > 0u ? mine : 1u; nx = cnt > 0u ? cnt : 1u;
}
DEVI void xcd_barrier(const XcdBarrier& b) {
  asm volatile("s_waitcnt vmcnt(0)" ::: "memory");
  __syncthreads();
  if (threadIdx.x == 0) {
    unsigned* bar = b.bar;
    __builtin_amdgcn_s_waitcnt(0);
    unsigned nloc = b.st[0], nx = b.st[1];
    if (nloc == 0u) { xcd_barrier_complete(bar, b.x, nloc, nx); b.st[0] = nloc; b.st[1] = nx; }
    const unsigned old = xb_add(&bar[XB_XSUB(b.x)], 1u);
    const unsigned gen = old / nloc;
    if (old + 1u == (gen + 1u) * nloc) {
      __builtin_amdgcn_fence(__ATOMIC_RELEASE, "agent");
      asm volatile("s_waitcnt vmcnt(0)" ::: "memory");
      const unsigned og = xb_add(&bar[XB_TOP], 1u);
      const unsigned tg = og / nx;
      if (og + 1u == (tg + 1u) * nx) xb_add(&bar[XB_TOPGEN], 1u);
      else XB_SPIN(xb_ld(&bar[XB_TOPGEN]) == tg, bar);
      __builtin_amdgcn_fence(__ATOMIC_ACQUIRE, "agent");
      xb_add(&bar[XB_XGEN(b.x)], 1u);
      asm volatile("s_waitcnt vmcnt(0)" ::: "memory");
    } else {
      XB_SPIN(xb_ld(&bar[XB_XGEN(b.x)]) == gen, bar);
      __builtin_amdgcn_fence(__ATOMIC_ACQUIRE, "agent");
      asm volatile("s_waitcnt vmcnt(0)" ::: "memory");
    }
  }
  __syncthreads();
}

#define FOR_ITEMS(idx, T) for (int idx = (bid & 7) * (G >> 3) + (bid >> 3); idx < (T); idx += G)

__global__ void __launch_bounds__(256, 2) trunk_megakernel(Params p) {
  cg::grid_group grid = cg::this_grid();
  __shared__ __attribute__((aligned(16))) unsigned char smem_all[65536 + 16];
  unsigned char* smem = smem_all;
  const int G = gridDim.x, bid = blockIdx.x;
  if (threadIdx.x == 0) *(uint4*)(smem_all + 65536) = uint4{0u, 0u, 0u, 0u};
  __syncthreads();
  const XcdBarrier xb = xcd_barrier_post((unsigned*)(p.ws + OFF_BAR), (volatile LAS unsigned*)(smem_all + 65536));
  grid.sync();

  for (int i = bid; i < 64 + 192 + 8064 + 560; i += G) {
    if (i < 64) ssm_pre_item(p, i, smem);
    else if (i < 256) mod_item(p, i - 64, smem);
    else if (i < 256 + 8064) weights_item(p, i - 256, smem);
    else table_item(p, i - 256 - 8064);
  }
  xcd_barrier(xb);
  for (int r = bid * 4 + (opaque_tid() >> 6); r < M; r += G * 4) modulate0_row(p, r);
  xcd_barrier(xb);

  for (int l = 0; l < 2; ++l) {
    FOR_ITEMS(t, 96 * 14) z_tile(p, l, t, smem);
    xcd_barrier(xb);
    FOR_ITEMS(i, 384 + 768 + 4096) {
      if (i < 384) ssm_item(p, l, i, smem);
      else if (i < 384 + 768) four1_tile(p, i - 384, smem);
      else prep_token(p, l, (i - 1152) * 4 + (opaque_tid() >> 6));
    }
    xcd_barrier(xb);
    FOR_ITEMS(i, 768 + 384 + 384) {
      if (i < 768) attn_item(p, i, smem);
      else if (i < 768 + 384) four2_tile(p, i - 768, smem);
      else glu_tile(p, l, i - 1152, smem);
    }
    xcd_barrier(xb);
    FOR_ITEMS(t, 768) merged_tile(p, l, t, smem);
    xcd_barrier(xb);
    FOR_ITEMS(t, 768) resid_tile(p, l, t, 0, smem);
    xcd_barrier(xb);
    {
      const float* modl = (const float*)(p.ws + OFF_MOD) + (size_t)l * 9 * 6144;
      for (int r = bid * 4 + (opaque_tid() >> 6); r < M; r += G * 4) ln_row(p, r, p.in[26] + l * 1024, p.in[27] + l * 1024, modl, 3072, 4096, true);
    }
    xcd_barrier(xb);
    FOR_ITEMS(t, 96 * 44) up_tile(p, l, t, smem);
    xcd_barrier(xb);
    for (int i = bid; i < 192; i += G) edge_item(p, l, i);
    xcd_barrier(xb);
    FOR_ITEMS(t, 768) resid_tile(p, l, t, 1, smem);
    xcd_barrier(xb);
    {
      const float* modn = (const float*)(p.ws + OFF_MOD) + (size_t)(l + 1 < 2 ? l + 1 : l) * 9 * 6144;
      for (int r = bid * 4 + (opaque_tid() >> 6); r < M; r += G * 4) ln_row(p, r, p.in[32] + l * 1024, p.in[33] + l * 1024, modn, 0, 1024, l == 0);
    }
    if (l == 0) xcd_barrier(xb);
  }
}

extern "C" void kernel_launch(void* const* d_in, const int* in_sizes, int n_in,
                              void* d_out, int out_size, void* d_ws, size_t ws_size,
                              hipStream_t stream) {
  static int grid_blocks = 0;
  if (!grid_blocks) {
    int dev = 0, cus = 0, per_cu = 0;
    (void)hipGetDevice(&dev);
    (void)hipDeviceGetAttribute(&cus, hipDeviceAttributeMultiprocessorCount, dev);
    (void)hipOccupancyMaxActiveBlocksPerMultiprocessor(&per_cu, trunk_megakernel, 256, 0);
    if (per_cu < 1) per_cu = 1;
    grid_blocks = cus * per_cu;
  }
  Params p{};
  for (int i = 0; i < 34; ++i) p.in[i] = (const float*)d_in[i];
  p.out = (float*)d_out;
  p.ws = (unsigned char*)d_ws;
  (void)hipMemsetAsync((unsigned char*)d_ws + OFF_BAR, 0, XCD_BAR_WORDS * 4, stream);
  void* args[] = {&p};
  hipError_t e = hipLaunchCooperativeKernel((void*)trunk_megakernel, dim3(grid_blocks), dim3(256), args, 0, stream);
  if (e != hipSuccess) fprintf(stderr, "cooperative launch failed: %s (grid %d)\n", hipGetErrorString(e), grid_blocks);
}
```

```cpp
#include <hip/hip_runtime.h>
#include <hip/hip_cooperative_groups.h>
#include <cstdio>
#include <cstdint>
namespace cg = cooperative_groups;

typedef unsigned short bf16_t;
using bf16x8 = __attribute__((ext_vector_type(8))) short;
using f32x4 = __attribute__((ext_vector_type(4))) float;

#define DEVI __device__ __forceinline__

#ifndef REP_P0
#define REP_P0 1
#endif
#ifndef REP_L2
#define REP_L2 1
#endif
#ifndef REP_L3
#define REP_L3 1
#endif
#ifndef REP_L7
#define REP_L7 1
#endif
#ifndef REP_SYNC
#define REP_SYNC 0
#endif
constexpr int M = 12288;
constexpr int MCTX = 4096;
constexpr float ALPHA = 1.41421356237f;
constexpr float LN_EPS = 1e-6f;

constexpr size_t WL_IN = 0;
constexpr size_t WL_GLU = WL_IN + (size_t)4864 * 1024;
constexpr size_t WL_BR = WL_GLU + (size_t)512 * 512;
constexpr size_t WL_OUT = WL_BR + (size_t)3 * 1024 * 512;
constexpr size_t WL_UP = WL_OUT + (size_t)1024 * 1024;
constexpr size_t WL_DN = WL_UP + (size_t)5632 * 1024;
constexpr size_t WL_TOT = WL_DN + (size_t)1024 * 2816;
constexpr size_t OFF_W = 0;
constexpr size_t SSM_EL = 196608;
constexpr size_t OFF_SSM = OFF_W + 2 * WL_TOT * 2;
constexpr size_t OFF_LAM16 = OFF_SSM + 64 * SSM_EL * 2;
constexpr size_t OFF_T1024 = OFF_LAM16 + 2 * 2 * 32 * 64 * 8;
constexpr size_t OFF_T256 = OFF_T1024 + (size_t)1024 * 2048 * 2;
constexpr size_t OFF_DFT128 = OFF_T256 + (size_t)256 * 512 * 2;
constexpr size_t OFF_ROPE = OFF_DFT128 + (size_t)256 * 128 * 2;
constexpr size_t OFF_MOD = OFF_ROPE + (size_t)1024 * 32 * 8;
constexpr size_t OFF_U = OFF_MOD + (size_t)2 * 9 * 6144 * 4;
constexpr size_t OFF_R = OFF_U + (size_t)M * 1024 * 2;
constexpr size_t OFF_Z = OFF_R;
constexpr size_t OFF_ATT = OFF_R;
constexpr size_t OFF_SSMG = OFF_R + (size_t)M * 512 * 2;
constexpr size_t OFF_FOUR = OFF_R + (size_t)2 * M * 512 * 2;
constexpr size_t OFF_QN = OFF_Z + (size_t)M * 1792 * 2;
constexpr size_t OFF_KD = OFF_QN + (size_t)M * 512 * 2;
constexpr size_t OFF_VTD = OFF_KD + (size_t)16 * 1536 * 64 * 2;
constexpr size_t OFF_KC = OFF_VTD + (size_t)16 * 1536 * 64 * 2;
constexpr size_t OFF_VTC = OFF_KC + (size_t)32 * 256 * 64 * 2;
constexpr size_t OFF_SSMP = OFF_VTC + (size_t)32 * 256 * 64 * 2;
constexpr size_t OFF_GT = OFF_SSMP + (size_t)M * 512 * 2;
constexpr size_t OFF_HG = OFF_R;
constexpr size_t OFF_EDGE = OFF_HG + (size_t)M * 2816 * 2;
constexpr size_t OFF_BAR = OFF_GT + (size_t)M * 1024 * 2;
constexpr size_t OFF_CTR = OFF_BAR + 16384;
constexpr size_t WS_NEEDED = OFF_BAR + 32768;

constexpr size_t OUT_CK = (size_t)M * 1024;
constexpr size_t OUT_CV = OUT_CK + (size_t)16 * 2 * 256 * 128;
constexpr size_t OUT_ST = OUT_CV + (size_t)16 * 2 * 256 * 128;

struct Params {
  const float* in[34];
  float* out;
  unsigned char* ws;
};

DEVI int opaque_tid() {
  int t = threadIdx.x;
  asm volatile("" : "+v"(t));
  return t;
}
DEVI unsigned short f2bf(float f) {
  unsigned u = __float_as_uint(f);
  u += 0x7fffu + ((u >> 16) & 1u);
  return (unsigned short)(u >> 16);
}
DEVI float bf2f(unsigned short h) { return __uint_as_float(((unsigned)h) << 16); }
DEVI unsigned pack2(float a, float b) { return (unsigned)f2bf(a) | ((unsigned)f2bf(b) << 16); }
DEVI float sigmoidf_(float x) { return 1.0f / (1.0f + __expf(-x)); }
DEVI float gelu_tanh(float x) {
  float y = 0.7978845608028654f * (x + 0.044715f * x * x * x);
  float t = 1.0f - 2.0f / (1.0f + __expf(2.0f * y));
  return 0.5f * x * (1.0f + t);
}
DEVI void grp_tile(int idx, int NT, int& mt, int& nt) {
  const int gsz = 8 * NT, gid = idx / gsz, rem = idx - gid * gsz;
  mt = gid * 8 + (rem & 7); nt = rem >> 3;
}
DEVI int modrow(int m) { return m < MCTX ? 0 : 1 + ((m - MCTX) >> 10); }

DEVI void gemm_core(const bf16_t* P, int ldp, const bf16_t* Q, int ldq, int K, f32x4 (&acc)[4][4],
                    unsigned char* smem) {
  const int tid = opaque_tid(), lane = tid & 63, wave = tid >> 6, wp = wave >> 1, wq = wave & 1;
  const int fr = lane & 15, fq = lane >> 4;
  const int srow = tid >> 3, sch = tid & 7;
  const bf16_t* gp = P + (size_t)srow * ldp + sch * 8;
  const bf16_t* gq = Q + (size_t)srow * ldq + sch * 8;
  const int woff = srow * 128 + ((sch ^ ((srow >> 1) & 7)) << 4);
  const int swz = fr >> 1;
  const int poff = (wp * 64 + fr) * 128;
  const int qoff = 16384 + (wq * 64 + fr) * 128;
  uint4 rp[4], rq[4];
  const int nk = K >> 6;
#pragma unroll
  for (int it = 0; it < 4; ++it) {
    rp[it] = *(const uint4*)(gp + (size_t)(32 * it) * ldp);
    rq[it] = *(const uint4*)(gq + (size_t)(32 * it) * ldq);
  }
#pragma unroll
  for (int it = 0; it < 4; ++it) {
    *(uint4*)(smem + woff + it * 4096) = rp[it];
    *(uint4*)(smem + 16384 + woff + it * 4096) = rq[it];
  }
  __syncthreads();
#pragma unroll 1
  for (int kt = 0; kt < nk; ++kt) {
    const int cur = (kt & 1) * 32768;
    {
      const int kn = (kt + 1 < nk) ? kt + 1 : kt;
      const bf16_t* gp2 = gp + (size_t)kn * 64;
      const bf16_t* gq2 = gq + (size_t)kn * 64;
#pragma unroll
      for (int it = 0; it < 4; ++it) {
        rp[it] = *(const uint4*)(gp2 + (size_t)(32 * it) * ldp);
        rq[it] = *(const uint4*)(gq2 + (size_t)(32 * it) * ldq);
      }
    }
#pragma unroll
    for (int ks = 0; ks < 2; ++ks) {
      const int co = ((ks * 4 + fq) ^ swz) << 4;
      bf16x8 a[4], b[4];
#pragma unroll
      for (int i = 0; i < 4; ++i) a[i] = *(const bf16x8*)(smem + cur + poff + i * 2048 + co);
#pragma unroll
      for (int j = 0; j < 4; ++j) b[j] = *(const bf16x8*)(smem + cur + qoff + j * 2048 + co);
#pragma unroll
      for (int i = 0; i < 4; ++i)
#pragma unroll
        for (int j = 0; j < 4; ++j)
          acc[i][j] = __builtin_amdgcn_mfma_f32_16x16x32_bf16(a[i], b[j], acc[i][j], 0, 0, 0);
    }
    {
      const int nxt = 32768 - cur;
#pragma unroll
      for (int it = 0; it < 4; ++it) {
        *(uint4*)(smem + nxt + woff + it * 4096) = rp[it];
        *(uint4*)(smem + nxt + 16384 + woff + it * 4096) = rq[it];
      }
    }
    __syncthreads();
  }
}

DEVI void gemm_core2(const bf16_t* P, int ldp, const bf16_t* Q, int ldq, int K, f32x4 (&acc)[4][4],
                     unsigned char* smem) {
  const int tid = opaque_tid(), lane = tid & 63, wave = tid >> 6, wp = wave >> 1, wq = wave & 1;
  const int fr = lane & 15, fq = lane >> 4;
  const int lrow = lane >> 2;
  const int lchunk = (lane & 3) ^ ((0x78 >> (2 * ((lrow >> 2) & 3))) & 3);
  const bf16_t* gp = P + (size_t)(wave * 32 + lrow) * ldp + lchunk * 8;
  const bf16_t* gq = Q + (size_t)(wave * 32 + lrow) * ldq + lchunk * 8;
  const size_t p16 = (size_t)16 * ldp, q16 = (size_t)16 * ldq;
  unsigned char* lds_w = smem + wave * 2048;
  const int rslot = (fq ^ ((0x78 >> (2 * ((fr >> 2) & 3))) & 3)) << 4;
  const int poff = (wp * 64 + fr) * 64 + rslot;
  const int qoff = 8192 + (wq * 64 + fr) * 64 + rslot;
  const int nk = K >> 5;
#define GLDS_STAGE(kt_) do { \
    const int st_ = ((kt_) & 3) * 16384; const size_t ko_ = (size_t)(kt_) * 32; \
    __builtin_amdgcn_global_load_lds((const unsigned*)(gp + ko_), (unsigned*)(lds_w + st_), 16, 0, 0); \
    __builtin_amdgcn_global_load_lds((const unsigned*)(gp + ko_ + p16), (unsigned*)(lds_w + st_ + 1024), 16, 0, 0); \
    __builtin_amdgcn_global_load_lds((const unsigned*)(gq + ko_), (unsigned*)(lds_w + st_ + 8192), 16, 0, 0); \
    __builtin_amdgcn_global_load_lds((const unsigned*)(gq + ko_ + q16), (unsigned*)(lds_w + st_ + 8192 + 1024), 16, 0, 0); \
  } while (0)
  GLDS_STAGE(0); GLDS_STAGE(1); GLDS_STAGE(2);
#pragma unroll 1
  for (int kt = 0; kt < nk; ++kt) {
    const int rem = nk - 1 - kt;
    if (rem >= 2) asm volatile("s_waitcnt vmcnt(8)" ::: "memory");
    else if (rem == 1) asm volatile("s_waitcnt vmcnt(4)" ::: "memory");
    else asm volatile("s_waitcnt vmcnt(0)" ::: "memory");
    __builtin_amdgcn_s_barrier();
    if (kt + 3 < nk) GLDS_STAGE(kt + 3);
    const int cur = (kt & 3) * 16384;
    bf16x8 a[4], b[4];
#pragma unroll
    for (int i = 0; i < 4; ++i) a[i] = *(const bf16x8*)(smem + cur + poff + i * 1024);
#pragma unroll
    for (int j = 0; j < 4; ++j) b[j] = *(const bf16x8*)(smem + cur + qoff + j * 1024);
#pragma unroll
    for (int i = 0; i < 4; ++i)
#pragma unroll
      for (int j = 0; j < 4; ++j)
        acc[i][j] = __builtin_amdgcn_mfma_f32_16x16x32_bf16(a[i], b[j], acc[i][j], 0, 0, 0);
  }
#undef GLDS_STAGE
  __syncthreads();
}

DEVI void zero_acc(f32x4 (&acc)[4][4]) {
#pragma unroll
  for (int i = 0; i < 4; ++i)
#pragma unroll
    for (int j = 0; j < 4; ++j) acc[i][j] = f32x4{0.f, 0.f, 0.f, 0.f};
}

DEVI void transpose_tile(const float* W, int K, int N, bf16_t* WT, int kt, int nt, int mode, unsigned char* smem) {
  float* t = (float*)smem;
  const int tid = opaque_tid();
  {
    const int r = tid >> 4, c4 = tid & 15;
#pragma unroll
    for (int it = 0; it < 4; ++it) {
      float4 v = *(const float4*)(W + (size_t)(kt * 64 + r + 16 * it) * N + nt * 64 + c4 * 4);
      float* d = t + (r + 16 * it) * 65 + c4 * 4;
      d[0] = v.x; d[1] = v.y; d[2] = v.z; d[3] = v.w;
    }
  }
  __syncthreads();
  {
    const int n = tid >> 2, kq = tid & 3;
    unsigned w[8];
#pragma unroll
    for (int e = 0; e < 8; ++e) w[e] = pack2(t[(kq * 16 + 2 * e) * 65 + n], t[(kq * 16 + 2 * e + 1) * 65 + n]);
    int c = nt * 64 + n, row = c;
    if (mode == 1) {
      int half = c >= 2816 ? 1 : 0;
      int cc = c - half * 2816;
      row = (cc >> 6) * 128 + half * 64 + (cc & 63);
    }
    uint4* dst = (uint4*)(WT + (size_t)row * K + kt * 64 + kq * 16);
    dst[0] = uint4{w[0], w[1], w[2], w[3]};
    dst[1] = uint4{w[4], w[5], w[6], w[7]};
  }
  __syncthreads();
}

DEVI void weights_item(const Params& p, int idx, unsigned char* smem) {
  const int l = idx / 4032;
  int t = idx - l * 4032;
  bf16_t* wl = (bf16_t*)(p.ws + OFF_W) + (size_t)l * WL_TOT;
  if (t < 1216) { transpose_tile(p.in[9] + (size_t)l * 1024 * 4864, 1024, 4864, wl + WL_IN, t / 76, t % 76, 0, smem); return; }
  t -= 1216;
  if (t < 64) { transpose_tile(p.in[20] + (size_t)l * 512 * 512, 512, 512, wl + WL_GLU, t / 8, t % 8, 0, smem); return; }
  t -= 64;
  if (t < 384) {
    const int br = t / 128; t -= br * 128;
    transpose_tile(p.in[22 + br] + (size_t)l * 512 * 1024, 512, 1024, wl + WL_BR + (size_t)br * 1024 * 512, t / 16, t % 16, 0, smem);
    return;
  }
  t -= 384;
  if (t < 256) { transpose_tile(p.in[25] + (size_t)l * 1024 * 1024, 1024, 1024, wl + WL_OUT, t / 16, t % 16, 0, smem); return; }
  t -= 256;
  if (t < 1408) { transpose_tile(p.in[28] + (size_t)l * 1024 * 5632, 1024, 5632, wl + WL_UP, t / 88, t % 88, 1, smem); return; }
  t -= 1408;
  transpose_tile(p.in[31] + (size_t)l * 2816 * 1024, 2816, 1024, wl + WL_DN, t / 16, t % 16, 0, smem);
}

DEVI void mod_item(const Params& p, int idx, unsigned char* smem) {
  const int l = idx / 96, nt = idx % 96;
  float* sc = (float*)smem;
  float* red = (float*)(smem + 36864);
  const int tid = opaque_tid();
  for (int e = tid; e < 9 * 1024; e += 256) {
    const int r = e >> 10, k = e & 1023;
    const float v = (r == 0) ? p.in[6][k] : p.in[2][(r - 1) * 1024 + k];
    sc[e] = v * sigmoidf_(v);
  }
  __syncthreads();
  const int kq = tid >> 6, col = tid & 63;
  const float* w = p.in[7] + (size_t)l * 1024 * 6144 + (size_t)(kq * 256) * 6144 + nt * 64 + col;
  float acc[9];
#pragma unroll
  for (int r = 0; r < 9; ++r) acc[r] = 0.f;
  for (int k0 = 0; k0 < 256; k0 += 8) {
    float wv[8];
#pragma unroll
    for (int e = 0; e < 8; ++e) wv[e] = w[(size_t)(k0 + e) * 6144];
#pragma unroll
    for (int e = 0; e < 8; ++e)
#pragma unroll
      for (int r = 0; r < 9; ++r) acc[r] += sc[r * 1024 + kq * 256 + k0 + e] * wv[e];
  }
#pragma unroll
  for (int r = 0; r < 9; ++r) red[(kq * 9 + r) * 64 + col] = acc[r];
  __syncthreads();
  float* mod = (float*)(p.ws + OFF_MOD) + (size_t)l * 9 * 6144;
  for (int e = tid; e < 9 * 64; e += 256) {
    const int r = e >> 6, c = e & 63;
    float s = red[(0 * 9 + r) * 64 + c] + red[(1 * 9 + r) * 64 + c] + red[(2 * 9 + r) * 64 + c] + red[(3 * 9 + r) * 64 + c];
    mod[r * 6144 + nt * 64 + c] = s + p.in[8][l * 6144 + nt * 64 + c];
  }
  __syncthreads();
}

DEVI void ssm_pre_item(const Params& p, int idx, unsigned char* smem) {
  const int l = idx >> 5, g = idx & 31;
  const int tid = opaque_tid();
  float2* Lpow = (float2*)smem;
  float2* Bbar = (float2*)(smem + 8704);
  float* Kc = (float*)(smem + 8704 + 8192);
  const float* a_re = p.in[12]; const float* a_im = p.in[13]; const float* log_dt = p.in[14];
  const float* b_re = p.in[15]; const float* b_im = p.in[16]; const float* c_re = p.in[17]; const float* c_im = p.in[18];
  bf16_t* AC = (bf16_t*)(p.ws + OFF_SSM) + (size_t)idx * SSM_EL;
  bf16_t* W1 = AC + 256 * 512;
#pragma unroll 1
  for (int dir = 0; dir < 2; ++dir) {
    const float dt = expf(log_dt[(l * 2 + dir) * 32 + g]);
    for (int e = tid; e < 17 * 64; e += 256) {
      const int tau = e >> 6, pp = e & 63;
      const int ai = ((l * 2 + dir) * 32 + g) * 64 + pp;
      const float mag = expf(a_re[ai] * dt * (float)tau);
      const float ang = a_im[ai] * dt * (float)tau;
      float sn, cs; sincosf(ang, &sn, &cs);
      Lpow[e] = float2{mag * cs, mag * sn};
      if (tau == 16) ((float2*)(p.ws + OFF_LAM16))[ai] = float2{mag * cs, mag * sn};
    }
    for (int e = tid; e < 64 * 16; e += 256) {
      const int pp = e >> 4, n = e & 15;
      const int ai = ((l * 2 + dir) * 32 + g) * 64 + pp;
      const float ar = a_re[ai], aim = a_im[ai];
      const float mag = expf(ar * dt);
      float sn, cs; sincosf(aim * dt, &sn, &cs);
      const float nr = mag * cs - 1.0f, ni = mag * sn;
      const float den = ar * ar + aim * aim;
      const float fr_ = (nr * ar + ni * aim) / den, fi_ = (ni * ar - nr * aim) / den;
      const float br = b_re[(size_t)ai * 16 + n], bi = b_im[(size_t)ai * 16 + n];
      Bbar[e] = float2{fr_ * br - fi_ * bi, fr_ * bi + fi_ * br};
    }
    __syncthreads();
    {
      const int tau = tid >> 4, n = tid & 15;
      float acc[16];
#pragma unroll
      for (int m = 0; m < 16; ++m) acc[m] = 0.f;
      const size_t cbase = ((size_t)((l * 2 + dir) * 32 + g) * 16 + n) * 64;
#pragma unroll 1
      for (int p8 = 0; p8 < 64; p8 += 8) {
        const float4 cr0 = *(const float4*)(c_re + cbase + p8), cr1 = *(const float4*)(c_re + cbase + p8 + 4);
        const float4 ci0 = *(const float4*)(c_im + cbase + p8), ci1 = *(const float4*)(c_im + cbase + p8 + 4);
        const float crv[8] = {cr0.x, cr0.y, cr0.z, cr0.w, cr1.x, cr1.y, cr1.z, cr1.w};
        const float civ[8] = {ci0.x, ci0.y, ci0.z, ci0.w, ci1.x, ci1.y, ci1.z, ci1.w};
#pragma unroll
        for (int e = 0; e < 8; ++e) {
          const int pp = p8 + e;
          const float2 lp = Lpow[tau * 64 + pp];
          const float gr = crv[e] * lp.x - civ[e] * lp.y, gi = crv[e] * lp.y + civ[e] * lp.x;
#pragma unroll
          for (int m = 0; m < 16; ++m) {
            const float2 bb = Bbar[pp * 16 + m];
            acc[m] += gr * bb.x - gi * bb.y;
          }
        }
      }
      const int delta = dir == 0 ? 15 - tau : 15 + tau;
#pragma unroll
      for (int m = 0; m < 16; ++m) {
        if (dir == 1 && tau == 0) Kc[(delta * 16 + n) * 16 + m] += acc[m];
        else Kc[(delta * 16 + n) * 16 + m] = acc[m];
      }
    }
    {
      const int n = tid >> 4, pg = tid & 15, p0 = pg * 4, kc = 32 + dir * 16 + pg;
      const size_t cbase = ((size_t)((l * 2 + dir) * 32 + g) * 16 + n) * 64;
      const float4 cr4 = *(const float4*)(c_re + cbase + p0), ci4 = *(const float4*)(c_im + cbase + p0);
      const float crv[4] = {cr4.x, cr4.y, cr4.z, cr4.w}, civ[4] = {ci4.x, ci4.y, ci4.z, ci4.w};
#pragma unroll 1
      for (int t = 0; t < 16; ++t) {
        const int tau = dir == 0 ? t + 1 : 16 - t;
        float val[8];
#pragma unroll
        for (int e = 0; e < 4; ++e) {
          const float2 lp = Lpow[tau * 64 + p0 + e];
          val[2 * e] = crv[e] * lp.x - civ[e] * lp.y;
          val[2 * e + 1] = -(crv[e] * lp.y + civ[e] * lp.x);
        }
        *(uint4*)(AC + (size_t)(t * 16 + n) * 512 + kc * 8) =
            uint4{pack2(val[0], val[1]), pack2(val[2], val[3]), pack2(val[4], val[5]), pack2(val[6], val[7])};
      }
    }
    for (int v = tid; v < 128 * 32; v += 256) {
      const int rl = v >> 5, kc = v & 31;
      const int pp = rl >> 1, ri = rl & 1;
      const int sidx = kc >> 1, m0 = (kc & 1) * 8;
      const float2 lp = Lpow[(dir == 0 ? 15 - sidx : sidx) * 64 + pp];
      float val[8];
#pragma unroll
      for (int e = 0; e < 8; ++e) {
        const float2 bb = Bbar[pp * 16 + m0 + e];
        val[e] = ri == 0 ? (lp.x * bb.x - lp.y * bb.y) : (lp.x * bb.y + lp.y * bb.x);
      }
      *(uint4*)(W1 + (size_t)(dir * 128 + rl) * 256 + kc * 8) =
          uint4{pack2(val[0], val[1]), pack2(val[2], val[3]), pack2(val[4], val[5]), pack2(val[6], val[7])};
    }
    __syncthreads();
  }
  for (int v = tid; v < 256 * 32; v += 256) {
    const int row = v >> 5, kc = v & 31;
    const int t = row >> 4, n = row & 15;
    const int sidx = kc >> 1, m0 = (kc & 1) * 8;
    const int delta = sidx - t + 15;
    float val[8];
#pragma unroll
    for (int e = 0; e < 8; ++e) val[e] = Kc[(delta * 16 + n) * 16 + m0 + e];
    *(uint4*)(AC + (size_t)row * 512 + kc * 8) =
        uint4{pack2(val[0], val[1]), pack2(val[2], val[3]), pack2(val[4], val[5]), pack2(val[6], val[7])};
  }
  __syncthreads();
}

DEVI void table_item(const Params& p, int idx) {
  const int tid = opaque_tid();
  if (idx < 512) {
    bf16_t* T = (bf16_t*)(p.ws + OFF_T1024);
    for (int e = tid; e < 4096; e += 256) {
      const int g = idx * 4096 + e, k = g >> 11, kk = g & 2047;
      const int ph = (k * (kk & 1023)) & 1023;
      float s, c; sincospif((float)ph * (2.0f / 1024.0f), &s, &c);
      T[g] = f2bf(kk < 1024 ? c : -s);
    }
    return;
  }
  idx -= 512;
  if (idx < 32) {
    bf16_t* T = (bf16_t*)(p.ws + OFF_T256);
    for (int e = tid; e < 4096; e += 256) {
      const int g = idx * 4096 + e, k = g >> 9, kk = g & 511;
      const int ph = (k * (kk & 255)) & 255;
      float s, c; sincospif((float)ph * (2.0f / 256.0f), &s, &c);
      T[g] = f2bf(kk < 256 ? c : -s);
    }
    return;
  }
  idx -= 32;
  if (idx < 8) {
    bf16_t* T = (bf16_t*)(p.ws + OFF_DFT128);
    for (int e = tid; e < 4096; e += 256) {
      const int g = idx * 4096 + e, n1 = g >> 7, c_ = g & 127;
      const int ph = (c_ * (n1 & 127)) & 127;
      float s, c; sincospif((float)ph * (2.0f / 128.0f), &s, &c);
      T[g] = f2bf(n1 < 128 ? c : s);
    }
    return;
  }
  idx -= 8;
  {
    float2* T = (float2*)(p.ws + OFF_ROPE);
    for (int e = tid; e < 4096; e += 256) {
      const int g = idx * 4096 + e, t = g >> 5, i = g & 31;
      const float pos = (i < 16) ? (float)(t >> 6) : (float)(t & 63);
      const float fr_ = powf(10000.0f, -(float)(i & 15) / 16.0f);
      float s, c; sincosf(pos * fr_, &s, &c);
      T[g] = float2{c, s};
    }
  }
}

DEVI const float* xin_row(const Params& p, int m) {
  return m < MCTX ? p.in[0] + (size_t)m * 1024 : p.in[1] + (size_t)(m - MCTX) * 1024;
}

DEVI void modulate0_row(const Params& p, int m) {
  const int lane = opaque_tid() & 63;
  const float* x = xin_row(p, m);
  const float* mod = (const float*)(p.ws + OFF_MOD) + (size_t)modrow(m) * 6144;
  bf16_t* u = (bf16_t*)(p.ws + OFF_U) + (size_t)m * 1024;
#pragma unroll
  for (int k = 0; k < 4; ++k) {
    const int c = lane * 4 + 256 * k;
    const float4 v = *(const float4*)(x + c);
    const float4 sh = *(const float4*)(mod + c);
    const float4 sc = *(const float4*)(mod + 1024 + c);
    uint2 o;
    o.x = pack2(v.x * (1.f + sc.x) + sh.x, v.y * (1.f + sc.y) + sh.y);
    o.y = pack2(v.z * (1.f + sc.z) + sh.z, v.w * (1.f + sc.w) + sh.w);
    *(uint2*)(u + c) = o;
  }
}

DEVI void ln_row(const Params& p, int m, const float* g, const float* b, const float* modl, int sh_off, int sc_off, bool write_u) {
  const int lane = opaque_tid() & 63;
  float* x = p.out + (size_t)m * 1024;
  float4 v[4];
  float s = 0.f;
#pragma unroll
  for (int k = 0; k < 4; ++k) {
    v[k] = *(const float4*)(x + lane * 4 + 256 * k);
    s += v[k].x + v[k].y + v[k].z + v[k].w;
  }
#pragma unroll
  for (int o = 32; o >= 1; o >>= 1) s += __shfl_xor(s, o);
  const float mu = s * (1.0f / 1024.0f);
  float q = 0.f;
#pragma unroll
  for (int k = 0; k < 4; ++k) {
    v[k].x -= mu; v[k].y -= mu; v[k].z -= mu; v[k].w -= mu;
    q += v[k].x * v[k].x + v[k].y * v[k].y + v[k].z * v[k].z + v[k].w * v[k].w;
  }
#pragma unroll
  for (int o = 32; o >= 1; o >>= 1) q += __shfl_xor(q, o);
  const float rs = rsqrtf(q * (1.0f / 1024.0f) + LN_EPS);
  const float* mod = modl + (size_t)modrow(m) * 6144;
  bf16_t* u = (bf16_t*)(p.ws + OFF_U) + (size_t)m * 1024;
#pragma unroll
  for (int k = 0; k < 4; ++k) {
    const int c = lane * 4 + 256 * k;
    const float4 gg = *(const float4*)(g + c);
    const float4 bb = *(const float4*)(b + c);
    float4 y;
    y.x = v[k].x * rs * gg.x + bb.x; y.y = v[k].y * rs * gg.y + bb.y;
    y.z = v[k].z * rs * gg.z + bb.z; y.w = v[k].w * rs * gg.w + bb.w;
    *(float4*)(x + c) = y;
    if (write_u) {
      const float4 sh = *(const float4*)(mod + sh_off + c);
      const float4 sc = *(const float4*)(mod + sc_off + c);
      uint2 o;
      o.x = pack2(y.x * (1.f + sc.x) + sh.x, y.y * (1.f + sc.y) + sh.y);
      o.y = pack2(y.z * (1.f + sc.z) + sh.z, y.w * (1.f + sc.w) + sh.w);
      *(uint2*)(u + c) = o;
    }
  }
}

DEVI void prep_token(const Params& p, int l, int tok) {
  const int lane = opaque_tid() & 63;
  bf16_t* Kd = (bf16_t*)(p.ws + OFF_KD); bf16_t* VTd = (bf16_t*)(p.ws + OFF_VTD);
  bf16_t* Kc = (bf16_t*)(p.ws + OFF_KC); bf16_t* VTc = (bf16_t*)(p.ws + OFF_VTC);
  if (tok >= M) {
    const int b = (tok - M) >> 9, j = (tok - M) & 511;
    if (lane < 32) {
      const int li = lane & 15, hk = li >> 3, d0 = (li & 7) * 8;
      const float* src = (lane < 16 ? p.in[3] : p.in[4]) + ((size_t)((b * 2 + l) * 512 + j)) * 128 + li * 8;
      const float4 v0 = *(const float4*)src, v1 = *(const float4*)(src + 4);
      const float vv[8] = {v0.x, v0.y, v0.z, v0.w, v1.x, v1.y, v1.z, v1.w};
      if (lane < 16) {
        *(uint4*)(Kd + ((size_t)(b * 2 + hk) * 1536 + 1024 + j) * 64 + d0) =
            uint4{pack2(vv[0], vv[1]), pack2(vv[2], vv[3]), pack2(vv[4], vv[5]), pack2(vv[6], vv[7])};
      } else {
#pragma unroll
        for (int e = 0; e < 8; ++e) VTd[((size_t)(b * 2 + hk) * 64 + d0 + e) * 1536 + 1024 + j] = f2bf(vv[e]);
      }
    }
    return;
  }
  const int m = tok;
  const bool dec = m >= MCTX;
  const int b = dec ? (m - MCTX) >> 10 : m >> 8;
  const int t = dec ? (m - MCTX) & 1023 : m & 255;
  const bf16_t* z = (const bf16_t*)(p.ws + OFF_Z) + (size_t)m * 1792;
  const float2* rope = (const float2*)(p.ws + OFF_ROPE) + (size_t)t * 32;
  {
    const uint4 raw = *(const uint4*)(z + lane * 8);
    float x[8];
    x[0] = bf2f(raw.x & 0xffff); x[1] = bf2f(raw.x >> 16); x[2] = bf2f(raw.y & 0xffff); x[3] = bf2f(raw.y >> 16);
    x[4] = bf2f(raw.z & 0xffff); x[5] = bf2f(raw.z >> 16); x[6] = bf2f(raw.w & 0xffff); x[7] = bf2f(raw.w >> 16);
    float ss = 0.f;
#pragma unroll
    for (int e = 0; e < 8; ++e) ss += x[e] * x[e];
    ss += __shfl_xor(ss, 1); ss += __shfl_xor(ss, 2); ss += __shfl_xor(ss, 4);
    const float rn = rsqrtf(ss * (1.0f / 64.0f) + LN_EPS);
    const int d0 = (lane & 7) * 8;
    const float* gq = p.in[10] + l * 64 + d0;
#pragma unroll
    for (int e = 0; e < 8; ++e) x[e] = x[e] * rn * gq[e];
    if (dec) {
#pragma unroll
      for (int e = 0; e < 4; ++e) {
        const float2 cs = rope[(d0 >> 1) + e];
        const float x0 = x[2 * e], x1 = x[2 * e + 1];
        x[2 * e] = x0 * cs.x - x1 * cs.y;
        x[2 * e + 1] = x0 * cs.y + x1 * cs.x;
      }
    }
    const float qs = 0.125f * 1.4426950408889634f;
    *(uint4*)((bf16_t*)(p.ws + OFF_QN) + (size_t)m * 512 + lane * 8) =
        uint4{pack2(x[0] * qs, x[1] * qs), pack2(x[2] * qs, x[3] * qs), pack2(x[4] * qs, x[5] * qs), pack2(x[6] * qs, x[7] * qs)};
  }
  {
    const int li = lane & 15, hk = li >> 3, d0 = (li & 7) * 8;
    const uint4 raw = *(const uint4*)(z + 512 + li * 8);
    float x[8];
    x[0] = bf2f(raw.x & 0xffff); x[1] = bf2f(raw.x >> 16); x[2] = bf2f(raw.y & 0xffff); x[3] = bf2f(raw.y >> 16);
    x[4] = bf2f(raw.z & 0xffff); x[5] = bf2f(raw.z >> 16); x[6] = bf2f(raw.w & 0xffff); x[7] = bf2f(raw.w >> 16);
    float ss = 0.f;
#pragma unroll
    for (int e = 0; e < 8; ++e) ss += x[e] * x[e];
    ss += __shfl_xor(ss, 1); ss += __shfl_xor(ss, 2); ss += __shfl_xor(ss, 4);
    const float rn = rsqrtf(ss * (1.0f / 64.0f) + LN_EPS);
    const float* gk = p.in[11] + l * 64 + d0;
#pragma unroll
    for (int e = 0; e < 8; ++e) x[e] = x[e] * rn * gk[e];
    if (lane < 16) {
      if (!dec) {
        float* ck = p.out + OUT_CK + ((size_t)((b * 2 + l) * 256 + t)) * 128 + li * 8;
        *(float4*)ck = float4{x[0], x[1], x[2], x[3]};
        *(float4*)(ck + 4) = float4{x[4], x[5], x[6], x[7]};
        *(uint4*)(Kc + ((size_t)(b * 2 + hk) * 256 + t) * 64 + d0) =
            uint4{pack2(x[0], x[1]), pack2(x[2], x[3]), pack2(x[4], x[5]), pack2(x[6], x[7])};
      } else {
#pragma unroll
        for (int e = 0; e < 4; ++e) {
          const float2 cs = rope[(d0 >> 1) + e];
          const float x0 = x[2 * e], x1 = x[2 * e + 1];
          x[2 * e] = x0 * cs.x - x1 * cs.y;
          x[2 * e + 1] = x0 * cs.y + x1 * cs.x;
        }
        *(uint4*)(Kd + ((size_t)(b * 2 + hk) * 1536 + t) * 64 + d0) =
            uint4{pack2(x[0], x[1]), pack2(x[2], x[3]), pack2(x[4], x[5]), pack2(x[6], x[7])};
      }
    }
  }
  if (lane >= 16 && lane < 32) {
    const int li = lane - 16, hk = li >> 3, d0 = (li & 7) * 8;
    const uint4 raw = *(const uint4*)(z + 640 + li * 8);
    float x[8];
    x[0] = bf2f(raw.x & 0xffff); x[1] = bf2f(raw.x >> 16); x[2] = bf2f(raw.y & 0xffff); x[3] = bf2f(raw.y >> 16);
    x[4] = bf2f(raw.z & 0xffff); x[5] = bf2f(raw.z >> 16); x[6] = bf2f(raw.w & 0xffff); x[7] = bf2f(raw.w >> 16);
    if (!dec) {
      float* cv = p.out + OUT_CV + ((size_t)((b * 2 + l) * 256 + t)) * 128 + li * 8;
      *(float4*)cv = float4{x[0], x[1], x[2], x[3]};
      *(float4*)(cv + 4) = float4{x[4], x[5], x[6], x[7]};
#pragma unroll
      for (int e = 0; e < 8; ++e) VTc[((size_t)(b * 2 + hk) * 64 + d0 + e) * 256 + t] = f2bf(x[e]);
    } else {
#pragma unroll
      for (int e = 0; e < 8; ++e) VTd[((size_t)(b * 2 + hk) * 64 + d0 + e) * 1536 + t] = f2bf(x[e]);
    }
  }
}

DEVI void attn_item(const Params& p, int a, unsigned char* smem) {
  const int tid = opaque_tid(), lane = tid & 63, wave = tid >> 6, fr = lane & 15, fq = lane >> 4;
  int h, Lk, m0;
  const bf16_t *Kb, *Vb;
  if (a < 512) {
    const int b = a >> 6; h = (a >> 3) & 7; const int qb = a & 7; Lk = 1536; m0 = MCTX + b * 1024 + qb * 128;
    const int bh = b * 2 + (h >> 2);
    Kb = (const bf16_t*)(p.ws + OFF_KD) + (size_t)bh * 1536 * 64;
    Vb = (const bf16_t*)(p.ws + OFF_VTD) + (size_t)bh * 64 * 1536;
  } else {
    a -= 512;
    const int b = a >> 4; h = (a >> 1) & 7; const int qb = a & 1; Lk = 256; m0 = b * 256 + qb * 128;
    const int bh = b * 2 + (h >> 2);
    Kb = (const bf16_t*)(p.ws + OFF_KC) + (size_t)bh * 256 * 64;
    Vb = (const bf16_t*)(p.ws + OFF_VTC) + (size_t)bh * 64 * 256;
  }
  const bf16_t* Qn = (const bf16_t*)(p.ws + OFF_QN);
  bf16x8 qf[2][2];
#pragma unroll
  for (int jq = 0; jq < 2; ++jq)
#pragma unroll
    for (int ks = 0; ks < 2; ++ks)
      qf[jq][ks] = *(const bf16x8*)(Qn + (size_t)(m0 + wave * 32 + jq * 16 + fr) * 512 + h * 64 + ks * 32 + fq * 8);
  f32x4 o[4][2];
#pragma unroll
  for (int di = 0; di < 4; ++di)
#pragma unroll
    for (int jq = 0; jq < 2; ++jq) o[di][jq] = f32x4{0.f, 0.f, 0.f, 0.f};
  float mrow[2] = {-1e30f, -1e30f}, lrow[2] = {0.f, 0.f};
  const int nt = Lk >> 6;
  const int srow = tid >> 3, sch = tid & 7;
  const int woff = srow * 128 + ((sch ^ ((srow >> 1) & 7)) << 4);
  const int swz = fr >> 1;
  uint4 rk[2], rv[2];
#pragma unroll
  for (int it = 0; it < 2; ++it) {
    rk[it] = *(const uint4*)(Kb + (size_t)(srow + 32 * it) * 64 + sch * 8);
    rv[it] = *(const uint4*)(Vb + (size_t)(srow + 32 * it) * Lk + sch * 8);
  }
#pragma unroll
  for (int it = 0; it < 2; ++it) {
    *(uint4*)(smem + woff + it * 4096) = rk[it];
    *(uint4*)(smem + 8192 + woff + it * 4096) = rv[it];
  }
  __syncthreads();
#pragma unroll 1
  for (int kt = 0; kt < nt; ++kt) {
    const int cur = (kt & 1) * 16384;
    {
      const int kn = (kt + 1 < nt) ? kt + 1 : kt;
#pragma unroll
      for (int it = 0; it < 2; ++it) {
        rk[it] = *(const uint4*)(Kb + (size_t)(kn * 64 + srow + 32 * it) * 64 + sch * 8);
        rv[it] = *(const uint4*)(Vb + (size_t)(srow + 32 * it) * Lk + kn * 64 + sch * 8);
      }
    }
    f32x4 s[4][2];
#pragma unroll
    for (int i = 0; i < 4; ++i)
#pragma unroll
      for (int jq = 0; jq < 2; ++jq) s[i][jq] = f32x4{0.f, 0.f, 0.f, 0.f};
#pragma unroll
    for (int ks = 0; ks < 2; ++ks) {
      const int co = ((ks * 4 + fq) ^ swz) << 4;
#pragma unroll
      for (int i = 0; i < 4; ++i) {
        const bf16x8 kf = *(const bf16x8*)(smem + cur + (i * 16 + fr) * 128 + co);
#pragma unroll
        for (int jq = 0; jq < 2; ++jq) s[i][jq] = __builtin_amdgcn_mfma_f32_16x16x32_bf16(kf, qf[jq][ks], s[i][jq], 0, 0, 0);
      }
    }
#pragma unroll
    for (int jq = 0; jq < 2; ++jq) {
      float mx = -1e30f;
#pragma unroll
      for (int i = 0; i < 4; ++i)
#pragma unroll
        for (int r = 0; r < 4; ++r) mx = fmaxf(mx, s[i][jq][r]);
      mx = fmaxf(mx, __shfl_xor(mx, 16));
      mx = fmaxf(mx, __shfl_xor(mx, 32));
      const float mnew = fmaxf(mrow[jq], mx);
      const float alpha = exp2f(mrow[jq] - mnew);
      mrow[jq] = mnew;
      float ls = 0.f;
#pragma unroll
      for (int i = 0; i < 4; ++i)
#pragma unroll
        for (int r = 0; r < 4; ++r) { const float e = exp2f(s[i][jq][r] - mnew); s[i][jq][r] = e; ls += e; }
      lrow[jq] = lrow[jq] * alpha + ls;
#pragma unroll
      for (int di = 0; di < 4; ++di)
#pragma unroll
        for (int r = 0; r < 4; ++r) o[di][jq][r] *= alpha;
    }
#pragma unroll
    for (int kk = 0; kk < 2; ++kk) {
      bf16x8 pf[2];
#pragma unroll
      for (int jq = 0; jq < 2; ++jq) {
        union { uint4 u; bf16x8 v; } cv;
        cv.u = uint4{pack2(s[2 * kk][jq][0], s[2 * kk][jq][1]), pack2(s[2 * kk][jq][2], s[2 * kk][jq][3]),
                     pack2(s[2 * kk + 1][jq][0], s[2 * kk + 1][jq][1]), pack2(s[2 * kk + 1][jq][2], s[2 * kk + 1][jq][3])};
        pf[jq] = cv.v;
      }
      const int c0 = ((4 * kk + (fq >> 1)) ^ swz) << 4;
      const int c1 = ((4 * kk + 2 + (fq >> 1)) ^ swz) << 4;
      const int wi = (fq & 1) * 8;
#pragma unroll
      for (int di = 0; di < 4; ++di) {
        const unsigned char* vrow = smem + cur + 8192 + (di * 16 + fr) * 128;
        union { uint2 u[2]; bf16x8 v; } cv;
        cv.u[0] = *(const uint2*)(vrow + c0 + wi);
        cv.u[1] = *(const uint2*)(vrow + c1 + wi);
#pragma unroll
        for (int jq = 0; jq < 2; ++jq) o[di][jq] = __builtin_amdgcn_mfma_f32_16x16x32_bf16(cv.v, pf[jq], o[di][jq], 0, 0, 0);
      }
    }
    {
      const int nxt = 16384 - cur;
#pragma unroll
      for (int it = 0; it < 2; ++it) {
        *(uint4*)(smem + nxt + woff + it * 4096) = rk[it];
        *(uint4*)(smem + nxt + 8192 + woff + it * 4096) = rv[it];
      }
    }
    __syncthreads();
  }
  bf16_t* att = (bf16_t*)(p.ws + OFF_ATT);
#pragma unroll
  for (int jq = 0; jq < 2; ++jq) {
    float lt = lrow[jq];
    lt += __shfl_xor(lt, 16);
    lt += __shfl_xor(lt, 32);
    const float inv = 1.0f / lt;
    bf16_t* dst = att + (size_t)(m0 + wave * 32 + jq * 16 + fr) * 512 + h * 64 + 4 * fq;
#pragma unroll
    for (int di = 0; di < 4; ++di)
      *(uint2*)(dst + di * 16) = uint2{pack2(o[di][jq][0] * inv, o[di][jq][1] * inv), pack2(o[di][jq][2] * inv, o[di][jq][3] * inv)};
  }
}

DEVI int ssm_col_row(int sub, int j) {
  return sub < 8 ? MCTX + sub * 1024 + j * 16 : ((sub - 8) * 4 + (j >> 4)) * 256 + (j & 15) * 16;
}

DEVI void ssm_item(const Params& p, int l, int idx, unsigned char* smem) {
  const int g = idx / 12, sub = idx % 12;
  const int tid = opaque_tid(), lane = tid & 63, wave = tid >> 6, fr = lane & 15, fq = lane >> 4;
  const bf16_t* AC = (const bf16_t*)(p.ws + OFF_SSM) + (size_t)(l * 32 + g) * SSM_EL;
  const bf16_t* W1 = AC + 256 * 512;
  const bf16_t* z = (const bf16_t*)(p.ws + OFF_Z);
  const int ucol = 768 + g * 16;
  size_t ubase[4];
#pragma unroll
  for (int jt = 0; jt < 4; ++jt) ubase[jt] = (size_t)ssm_col_row(sub, jt * 16 + fr) * 1792 + ucol;
  f32x4 acc[4][4];
  zero_acc(acc);
#pragma unroll 1
  for (int ks = 0; ks < 8; ++ks) {
    const int s = 2 * ks + (fq >> 1), m8 = (fq & 1) * 8;
    bf16x8 a[4], b[4];
#pragma unroll
    for (int i = 0; i < 4; ++i) a[i] = *(const bf16x8*)(W1 + (size_t)(wave * 64 + i * 16 + fr) * 256 + ks * 32 + fq * 8);
#pragma unroll
    for (int jt = 0; jt < 4; ++jt) b[jt] = *(const bf16x8*)(z + ubase[jt] + (size_t)s * 1792 + m8);
#pragma unroll
    for (int i = 0; i < 4; ++i)
#pragma unroll
      for (int jt = 0; jt < 4; ++jt) acc[i][jt] = __builtin_amdgcn_mfma_f32_16x16x32_bf16(a[i], b[jt], acc[i][jt], 0, 0, 0);
  }
#pragma unroll
  for (int i = 0; i < 4; ++i)
#pragma unroll
    for (int jt = 0; jt < 4; ++jt) {
      const int j = jt * 16 + fr;
      const int ch = (wave * 64 + i * 16 + 4 * fq) >> 2;
      *(f32x4*)(smem + j * 1024 + ((ch ^ (j & 15)) << 4)) = acc[i][jt];
    }
  __syncthreads();
  if (tid < 128) {
    const int dir = tid >> 6, pp = tid & 63;
    const float2 lam = ((const float2*)(p.ws + OFF_LAM16))[((l * 2 + dir) * 32 + g) * 64 + pp];
    const int nseq = sub < 8 ? 1 : 4, nch = sub < 8 ? 64 : 16;
    const int ch = (dir * 64 + pp) >> 1, wi = (pp & 1) * 8;
    for (int q = 0; q < nseq; ++q) {
      float hr = 0.f, hi = 0.f;
      if (sub < 8) {
        const float* h0 = p.in[5] + ((size_t)(((sub * 2 + l) * 2 + dir) * 32 + g) * 64 + pp) * 2;
        hr = h0[0]; hi = h0[1];
      }
      for (int c = 0; c < nch; ++c) {
        const int j = q * nch + (dir == 0 ? c : nch - 1 - c);
        float2* f = (float2*)(smem + j * 1024 + ((ch ^ (j & 15)) << 4) + wi);
        const float2 F = *f;
        *f = float2{hr, hi};
        const float nr = lam.x * hr - lam.y * hi + F.x;
        const float ni = lam.x * hi + lam.y * hr + F.y;
        hr = nr; hi = ni;
      }
      if (sub >= 8) {
        const int b = (sub - 8) * 4 + q;
        float* st = p.out + OUT_ST + ((size_t)(((b * 2 + l) * 2 + dir) * 32 + g) * 64 + pp) * 2;
        st[0] = hr; st[1] = hi;
      }
    }
  }
  __syncthreads();
  zero_acc(acc);
#pragma unroll 1
  for (int ks = 0; ks < 16; ++ks) {
    bf16x8 a[4], b[4];
#pragma unroll
    for (int i = 0; i < 4; ++i) a[i] = *(const bf16x8*)(AC + (size_t)(wave * 64 + i * 16 + fr) * 512 + ks * 32 + fq * 8);
    if (ks < 8) {
      const int s = 2 * ks + (fq >> 1), m8 = (fq & 1) * 8;
#pragma unroll
      for (int jt = 0; jt < 4; ++jt) b[jt] = *(const bf16x8*)(z + ubase[jt] + (size_t)s * 1792 + m8);
    } else {
      const int c0 = ((ks - 8) * 32 + fq * 8) >> 2;
#pragma unroll
      for (int jt = 0; jt < 4; ++jt) {
        const int j = jt * 16 + fr;
        const f32x4 v0 = *(const f32x4*)(smem + j * 1024 + ((c0 ^ (j & 15)) << 4));
        const f32x4 v1 = *(const f32x4*)(smem + j * 1024 + (((c0 + 1) ^ (j & 15)) << 4));
        union { uint4 u; bf16x8 v; } cv;
        cv.u = uint4{pack2(v0[0], v0[1]), pack2(v0[2], v0[3]), pack2(v1[0], v1[1]), pack2(v1[2], v1[3])};
        b[jt] = cv.v;
      }
    }
#pragma unroll
    for (int i = 0; i < 4; ++i)
#pragma unroll
      for (int jt = 0; jt < 4; ++jt) acc[i][jt] = __builtin_amdgcn_mfma_f32_16x16x32_bf16(a[i], b[jt], acc[i][jt], 0, 0, 0);
  }
  bf16_t* sp = (bf16_t*)(p.ws + OFF_SSMP);
  const float4 dv = *(const float4*)(p.in[19] + l * 512 + g * 16 + 4 * fq);
#pragma unroll
  for (int i = 0; i < 4; ++i) {
    const int t = wave * 4 + i;
#pragma unroll
    for (int jt = 0; jt < 4; ++jt) {
      const size_t row = (size_t)ssm_col_row(sub, jt * 16 + fr) + t;
      const uint2 uu = *(const uint2*)(z + row * 1792 + ucol + 4 * fq);
      const float y0 = gelu_tanh(acc[i][jt][0] + dv.x * bf2f(uu.x & 0xffff));
      const float y1 = gelu_tanh(acc[i][jt][1] + dv.y * bf2f(uu.x >> 16));
      const float y2 = gelu_tanh(acc[i][jt][2] + dv.z * bf2f(uu.y & 0xffff));
      const float y3 = gelu_tanh(acc[i][jt][3] + dv.w * bf2f(uu.y >> 16));
      *(uint2*)(sp + row * 512 + g * 16 + 4 * fq) = uint2{pack2(y0, y1), pack2(y2, y3)};
      asm volatile("" ::: "memory");
    }
  }
  __syncthreads();
}

#define TILE_IDS \
  const int tid = opaque_tid(), lane = tid & 63, wave = tid >> 6, wp = wave >> 1, wq = wave & 1, fr = lane & 15, fq = lane >> 4; \
  (void)tid; (void)wp; (void)wq; (void)fr; (void)fq;

DEVI void z_tile(const Params& p, int l, int t, unsigned char* smem) {
  TILE_IDS
  int mt, nt; grp_tile(t, 14, mt, nt);
  const bf16_t* P = (const bf16_t*)(p.ws + OFF_W) + (size_t)l * WL_TOT + WL_IN + (size_t)nt * 128 * 1024;
  const bf16_t* Q = (const bf16_t*)(p.ws + OFF_U) + (size_t)mt * 128 * 1024;
  f32x4 acc[4][4];
  zero_acc(acc);
  gemm_core2(P, 1024, Q, 1024, 1024, acc, smem);
  bf16_t* z = (bf16_t*)(p.ws + OFF_Z);
#pragma unroll
  for (int i = 0; i < 4; ++i)
#pragma unroll
    for (int j = 0; j < 4; ++j) {
      const int n = nt * 128 + wp * 64 + i * 16 + 4 * fq, m = mt * 128 + wq * 64 + j * 16 + fr;
      *(uint2*)(z + (size_t)m * 1792 + n) = uint2{pack2(acc[i][j][0], acc[i][j][1]), pack2(acc[i][j][2], acc[i][j][3])};
    }
}

DEVI void four1_tile(const Params& p, int t, unsigned char* smem) {
  TILE_IDS
  const int mt = t >> 3, grp = (t >> 1) & 3, half = t & 1;
  const bf16_t* P = (const bf16_t*)(p.ws + OFF_Z) + (size_t)mt * 128 * 1792 + 1280 + grp * 128;
  const bf16_t* Q = (const bf16_t*)(p.ws + OFF_DFT128) + (size_t)half * 128 * 128;
  f32x4 acc[4][4];
  zero_acc(acc);
  gemm_core2(P, 1792, Q, 128, 128, acc, smem);
  bf16_t* GT = (bf16_t*)(p.ws + OFF_GT);
  const int m0 = mt * 128;
  int L; bf16_t* gb; int lpos0;
  if (m0 < MCTX) { L = 256; gb = GT + (size_t)(m0 >> 8) * 512 * 512; lpos0 = m0 & 255; }
  else { L = 1024; gb = GT + (size_t)16 * 512 * 512 + (size_t)((m0 - MCTX) >> 10) * 512 * 2048; lpos0 = (m0 - MCTX) & 1023; }
#pragma unroll
  for (int i = 0; i < 4; ++i)
#pragma unroll
    for (int j = 0; j < 4; ++j) {
      const int lp = lpos0 + wp * 64 + i * 16 + 4 * fq;
      const int cp = wq * 64 + j * 16 + fr;
      *(uint2*)(gb + (size_t)(grp * 128 + cp) * (2 * L) + half * L + lp) =
          uint2{pack2(acc[i][j][0], acc[i][j][1]), pack2(acc[i][j][2], acc[i][j][3])};
    }
}

DEVI void four2_tile(const Params& p, int t, unsigned char* smem) {
  TILE_IDS
  const bf16_t* GT = (const bf16_t*)(p.ws + OFF_GT);
  const bf16_t *P, *Q; int K, mrow0, nt; float scale;
  if (t < 128) {
    const int b = t >> 3, pt = (t >> 2) & 1; nt = t & 3;
    P = GT + (size_t)b * 512 * 512 + (size_t)nt * 128 * 512;
    Q = (const bf16_t*)(p.ws + OFF_T256) + (size_t)pt * 128 * 512;
    K = 512; mrow0 = b * 256 + pt * 128; scale = 0.005524271728019903f;
  } else {
    t -= 128;
    const int b = t >> 5, pt = (t >> 2) & 7; nt = t & 3;
    P = GT + (size_t)16 * 512 * 512 + (size_t)b * 512 * 2048 + (size_t)nt * 128 * 2048;
    Q = (const bf16_t*)(p.ws + OFF_T1024) + (size_t)pt * 128 * 2048;
    K = 2048; mrow0 = MCTX + b * 1024 + pt * 128; scale = 0.0027621358640099515f;
  }
  f32x4 acc[4][4];
  zero_acc(acc);
  gemm_core2(P, K, Q, K, K, acc, smem);
  bf16_t* fo = (bf16_t*)(p.ws + OFF_FOUR);
#pragma unroll
  for (int i = 0; i < 4; ++i)
#pragma unroll
    for (int j = 0; j < 4; ++j) {
      const int n = nt * 128 + wp * 64 + i * 16 + 4 * fq, m = mrow0 + wq * 64 + j * 16 + fr;
      *(uint2*)(fo + (size_t)m * 512 + n) =
          uint2{pack2(acc[i][j][0] * scale, acc[i][j][1] * scale), pack2(acc[i][j][2] * scale, acc[i][j][3] * scale)};
    }
}

DEVI void glu_tile(const Params& p, int l, int t, unsigned char* smem) {
  TILE_IDS
  int mt, nt; grp_tile(t, 4, mt, nt);
  const bf16_t* P = (const bf16_t*)(p.ws + OFF_W) + (size_t)l * WL_TOT + WL_GLU + (size_t)nt * 128 * 512;
  const bf16_t* sp = (const bf16_t*)(p.ws + OFF_SSMP);
  const bf16_t* Q = sp + (size_t)mt * 128 * 512;
  f32x4 acc[4][4];
  zero_acc(acc);
  gemm_core2(P, 512, Q, 512, 512, acc, smem);
  bf16_t* sg = (bf16_t*)(p.ws + OFF_SSMG);
#pragma unroll
  for (int i = 0; i < 4; ++i)
#pragma unroll
    for (int j = 0; j < 4; ++j) {
      const int n = nt * 128 + wp * 64 + i * 16 + 4 * fq, m = mt * 128 + wq * 64 + j * 16 + fr;
      const float4 bg = *(const float4*)(p.in[21] + l * 512 + n);
      const uint2 yy = *(const uint2*)(sp + (size_t)m * 512 + n);
      const float y0 = bf2f(yy.x & 0xffff), y1 = bf2f(yy.x >> 16), y2 = bf2f(yy.y & 0xffff), y3 = bf2f(yy.y >> 16);
      *(uint2*)(sg + (size_t)m * 512 + n) =
          uint2{pack2(y0 * sigmoidf_(acc[i][j][0] + bg.x), y1 * sigmoidf_(acc[i][j][1] + bg.y)),
                pack2(y2 * sigmoidf_(acc[i][j][2] + bg.z), y3 * sigmoidf_(acc[i][j][3] + bg.w))};
      asm volatile("" ::: "memory");
    }
}

DEVI void merged_tile(const Params& p, int l, int t, unsigned char* smem) {
  TILE_IDS
  int mt, nt; grp_tile(t, 8, mt, nt);
  const bf16_t* wl = (const bf16_t*)(p.ws + OFF_W) + (size_t)l * WL_TOT;
  const bf16_t* u = (const bf16_t*)(p.ws + OFF_U) + (size_t)mt * 128 * 1024;
  bf16_t* mo = (bf16_t*)(p.ws + OFF_GT);
#pragma unroll 1
  for (int br = 0; br < 3; ++br) {
    uint2 sg[4][4];
    {
      f32x4 acc[4][4];
      zero_acc(acc);
      gemm_core2(wl + WL_IN + (size_t)(1792 + br * 1024 + nt * 128) * 1024, 1024, u, 1024, 1024, acc, smem);
#pragma unroll
      for (int i = 0; i < 4; ++i)
#pragma unroll
        for (int j = 0; j < 4; ++j)
          sg[i][j] = uint2{pack2(sigmoidf_(acc[i][j][0]), sigmoidf_(acc[i][j][1])), pack2(sigmoidf_(acc[i][j][2]), sigmoidf_(acc[i][j][3]))};
    }
    {
      f32x4 acc[4][4];
      zero_acc(acc);
      const bf16_t* X = (const bf16_t*)(p.ws + OFF_ATT) + (size_t)br * M * 512 + (size_t)mt * 128 * 512;
      gemm_core2(wl + WL_BR + (size_t)br * 1024 * 512 + (size_t)nt * 128 * 512, 512, X, 512, 512, acc, smem);
#pragma unroll
      for (int i = 0; i < 4; ++i)
#pragma unroll
        for (int j = 0; j < 4; ++j) {
          const int n = nt * 128 + wp * 64 + i * 16 + 4 * fq, m = mt * 128 + wq * 64 + j * 16 + fr;
          uint2* dst = (uint2*)(mo + (size_t)m * 1024 + n);
          float v0 = bf2f(sg[i][j].x & 0xffff) * acc[i][j][0];
          float v1 = bf2f(sg[i][j].x >> 16) * acc[i][j][1];
          float v2 = bf2f(sg[i][j].y & 0xffff) * acc[i][j][2];
          float v3 = bf2f(sg[i][j].y >> 16) * acc[i][j][3];
          if (br > 0) {
            const uint2 o = *dst;
            v0 += bf2f(o.x & 0xffff); v1 += bf2f(o.x >> 16); v2 += bf2f(o.y & 0xffff); v3 += bf2f(o.y >> 16);
          }
          *dst = uint2{pack2(v0, v1), pack2(v2, v3)};
          asm volatile("" ::: "memory");
        }
    }
  }
}

DEVI void resid_tile(const Params& p, int l, int t, int which, unsigned char* smem) {
  TILE_IDS
  int mt, nt; grp_tile(t, 8, mt, nt);
  const bf16_t* wl = (const bf16_t*)(p.ws + OFF_W) + (size_t)l * WL_TOT;
  f32x4 acc[4][4];
  zero_acc(acc);
  if (which == 0)
    gemm_core2(wl + WL_OUT + (size_t)nt * 128 * 1024, 1024, (const bf16_t*)(p.ws + OFF_GT) + (size_t)mt * 128 * 1024, 1024, 1024, acc, smem);
  else
    gemm_core2(wl + WL_DN + (size_t)nt * 128 * 2816, 2816, (const bf16_t*)(p.ws + OFF_HG) + (size_t)mt * 128 * 2816, 2816, 2816, acc, smem);
  const float* modl = (const float*)(p.ws + OFF_MOD) + (size_t)l * 9 * 6144 + (which == 0 ? 2048 : 5120);
  const bool from_in = (l == 0 && which == 0);
#pragma unroll
  for (int i = 0; i < 4; ++i)
#pragma unroll
    for (int j = 0; j < 4; ++j) {
      const int n = nt * 128 + wp * 64 + i * 16 + 4 * fq, m = mt * 128 + wq * 64 + j * 16 + fr;
      const float4 gg = *(const float4*)(modl + (size_t)modrow(m) * 6144 + n);
      float* dst = p.out + (size_t)m * 1024 + n;
      const float4 xv = from_in ? *(const float4*)(xin_row(p, m) + n) : *(const float4*)dst;
      *(float4*)dst = float4{ALPHA * xv.x + gg.x * acc[i][j][0], ALPHA * xv.y + gg.y * acc[i][j][1],
                             ALPHA * xv.z + gg.z * acc[i][j][2], ALPHA * xv.w + gg.w * acc[i][j][3]};
    }
}

DEVI void up_tile(const Params& p, int l, int t, unsigned char* smem) {
  TILE_IDS
  int mt, nt; grp_tile(t, 44, mt, nt);
  const bf16_t* P = (const bf16_t*)(p.ws + OFF_W) + (size_t)l * WL_TOT + WL_UP + (size_t)nt * 128 * 1024;
  const bf16_t* Q = (const bf16_t*)(p.ws + OFF_U) + (size_t)mt * 128 * 1024;
  f32x4 acc[4][4];
  zero_acc(acc);
  gemm_core2(P, 1024, Q, 1024, 1024, acc, smem);
  bf16_t* T = (bf16_t*)smem;
#pragma unroll
  for (int i = 0; i < 4; ++i)
#pragma unroll
    for (int j = 0; j < 4; ++j) {
      const int n = wp * 64 + i * 16 + 4 * fq, m = wq * 64 + j * 16 + fr;
      *(uint2*)(T + m * 136 + n) = uint2{pack2(acc[i][j][0], acc[i][j][1]), pack2(acc[i][j][2], acc[i][j][3])};
    }
  __syncthreads();
  {
    const int c = tid & 63, r0 = (tid >> 6) * 32;
    const int ca = nt * 64 + c, cb = 2816 + nt * 64 + c;
    const float* cw = p.in[29] + (size_t)l * 3 * 5632;
    const float* cbias = p.in[30] + (size_t)l * 5632;
    const float wa0 = cw[ca], wa1 = cw[5632 + ca], wa2 = cw[2 * 5632 + ca], ba = cbias[ca];
    const float wb0 = cw[cb], wb1 = cw[5632 + cb], wb2 = cw[2 * 5632 + cb], bb = cbias[cb];
    bf16_t* hg = (bf16_t*)(p.ws + OFF_HG) + (size_t)(mt * 128) * 2816 + nt * 64 + c;
    float pa = r0 > 0 ? bf2f(T[(r0 - 1) * 136 + c]) : 0.f, pb = r0 > 0 ? bf2f(T[(r0 - 1) * 136 + 64 + c]) : 0.f;
    float ca_ = bf2f(T[r0 * 136 + c]), cb_ = bf2f(T[r0 * 136 + 64 + c]);
    for (int r = r0; r < r0 + 32; ++r) {
      const float na = r < 127 ? bf2f(T[(r + 1) * 136 + c]) : 0.f, nb = r < 127 ? bf2f(T[(r + 1) * 136 + 64 + c]) : 0.f;
      if (r > 0 && r < 127) {
        const float ha = wa0 * pa + wa1 * ca_ + wa2 * na + ba;
        const float hb = wb0 * pb + wb1 * cb_ + wb2 * nb + bb;
        hg[(size_t)r * 2816] = f2bf(ha * sigmoidf_(ha) * hb);
      }
      pa = ca_; pb = cb_; ca_ = na; cb_ = nb;
    }
    bf16_t* edge = (bf16_t*)(p.ws + OFF_EDGE) + (size_t)mt * 4 * 5632;
    const int e = tid >> 6;
    const int er = e < 2 ? e : 124 + e;
    edge[(size_t)e * 5632 + ca] = T[er * 136 + c];
    edge[(size_t)e * 5632 + cb] = T[er * 136 + 64 + c];
  }
  __syncthreads();
}

DEVI void edge_item(const Params& p, int l, int idx) {
  const int mt = idx >> 1, bot = idx & 1;
  const int L = mt < 32 ? 256 : 1024;
  const int m = mt * 128 + (bot ? 127 : 0);
  const int mloc = mt < 32 ? m : m - MCTX;
  const int pos = mloc & (L - 1);
  const bf16_t* edge = (const bf16_t*)(p.ws + OFF_EDGE);
  const bf16_t *prev, *cur, *next;
  bool hasp, hasn;
  if (!bot) {
    hasp = pos != 0; hasn = true;
    prev = edge + ((size_t)(mt > 0 ? mt - 1 : 0) * 4 + 3) * 5632;
    cur = edge + ((size_t)mt * 4 + 0) * 5632;
    next = edge + ((size_t)mt * 4 + 1) * 5632;
  } else {
    hasp = true; hasn = pos != L - 1;
    prev = edge + ((size_t)mt * 4 + 2) * 5632;
    cur = edge + ((size_t)mt * 4 + 3) * 5632;
    next = edge + ((size_t)(mt < 95 ? mt + 1 : 95) * 4 + 0) * 5632;
  }
  const float* cw = p.in[29] + (size_t)l * 3 * 5632;
  const float* cbias = p.in[30] + (size_t)l * 5632;
  bf16_t* hg = (bf16_t*)(p.ws + OFF_HG) + (size_t)m * 2816;
  for (int c = opaque_tid(); c < 2816; c += 256) {
    const int cb = 2816 + c;
    const float pa = hasp ? bf2f(prev[c]) : 0.f, pb = hasp ? bf2f(prev[cb]) : 0.f;
    const float na = hasn ? bf2f(next[c]) : 0.f, nb = hasn ? bf2f(next[cb]) : 0.f;
    const float ha = cw[c] * pa + cw[5632 + c] * bf2f(cur[c]) + cw[2 * 5632 + c] * na + cbias[c];
    const float hb = cw[cb] * pb + cw[5632 + cb] * bf2f(cur[cb]) + cw[2 * 5632 + cb] * nb + cbias[cb];
    hg[c] = f2bf(ha * sigmoidf_(ha) * hb);
  }
}


#define XB_TMO      128
#define XB_XCNT(j)  (256  + 64 * (j))
#define XB_XSUB(j)  (1280 + 64 * (j))
#define XB_XGEN(j)  (2304 + 64 * (j))
#define XB_TOP      3328
#define XB_TOPGEN   3392
#define XCD_BAR_WORDS 3456
#define XB_SPIN_CAP (1u << 20)
#define LAS __attribute__((address_space(3)))
DEVI unsigned xb_ld(unsigned* p) { return __hip_atomic_load(p, __ATOMIC_RELAXED, __HIP_MEMORY_SCOPE_AGENT); }
DEVI unsigned xb_add(unsigned* p, unsigned v) { return __hip_atomic_fetch_add(p, v, __ATOMIC_RELAXED, __HIP_MEMORY_SCOPE_AGENT); }
DEVI unsigned xb_xcc_id() { return (unsigned)__builtin_amdgcn_s_getreg((3 << 11) | 20) & 0xFu; }
#define XB_SPIN(cond, bar) do { unsigned _sp = 0; while (cond) { __builtin_amdgcn_s_sleep(1); \
    if ((++_sp & 255u) == 0u) { if (xb_ld(&(bar)[XB_TMO])) break; if (_sp > XB_SPIN_CAP) { atomicAdd(&(bar)[XB_TMO], 1u); break; } } } } while (0)
struct XcdBarrier { unsigned* bar; unsigned x; volatile LAS unsigned* st; };
DEVI XcdBarrier xcd_barrier_post(unsigned* bar, volatile LAS unsigned* st) {
  XcdBarrier b; b.bar = bar; b.x = xb_xcc_id(); b.st = st;
  if (threadIdx.x == 0) (void)xb_add(&bar[XB_XCNT(b.x)], 1u);
  return b;
}
DEVI void xcd_barrier_complete(unsigned* bar, unsigned x, unsigned& nloc, unsigned& nx) {
  const unsigned G = gridDim.x * gridDim.y * gridDim.z;
  unsigned sum, cnt, mine, sp = 0u;
  for (;;) {
    sum = 0u; cnt = 0u; mine = 0u;
#pragma unroll
    for (unsigned j = 0; j < 16; ++j) { const unsigned c = xb_ld(&bar[XB_XCNT(j)]); sum += c; cnt += (c > 0u) ? 1u : 0u; mine = (j == x) ? c : mine; }
    if (sum == G) break;
    __builtin_amdgcn_s_sleep(1);
    if ((++sp & 255u) == 0u) { if (xb_ld(&bar[XB_TMO])) break; if (sp > XB_SPIN_CAP) { atomicAdd(&bar[XB_TMO], 1u); break; } }
  }
  nloc = mine > 0u ? mine : 1u; nx = cnt > 0u ? cnt : 1u;
}
DEVI void xcd_barrier(const XcdBarrier& b) {
  asm volatile("s_waitcnt vmcnt(0)" ::: "memory");
  __syncthreads();
  if (threadIdx.x == 0) {
    unsigned* bar = b.bar;
    __builtin_amdgcn_s_waitcnt(0);
    unsigned nloc = b.st[0], nx = b.st[1];
    if (nloc == 0u) { xcd_barrier_complete(bar, b.x, nloc, nx); b.st[0] = nloc; b.st[1] = nx; }
    const unsigned old = xb_add(&bar[XB_XSUB(b.x)], 1u);
    const unsigned gen = old / nloc;
    if (old + 1u == (gen + 1u) * nloc) {
      __builtin_amdgcn_fence(__ATOMIC_RELEASE, "agent");
      asm volatile("s_waitcnt vmcnt(0)" ::: "memory");
      const unsigned og = xb_add(&bar[XB_TOP], 1u);
      const unsigned tg = og / nx;
      if (og + 1u == (tg + 1u) * nx) xb_add(&bar[XB_TOPGEN], 1u);
      else XB_SPIN(xb_ld(&bar[XB_TOPGEN]) == tg, bar);
      __builtin_amdgcn_fence(__ATOMIC_ACQUIRE, "agent");
      xb_add(&bar[XB_XGEN(b.x)], 1u);
      asm volatile("s_waitcnt vmcnt(0)" ::: "memory");
    } else {
      XB_SPIN(xb_ld(&bar[XB_XGEN(b.x)]) == gen, bar);
      __builtin_amdgcn_fence(__ATOMIC_ACQUIRE, "agent");
      asm volatile("s_waitcnt vmcnt(0)" ::: "memory");
    }
  }
  __syncthreads();
}

DEVI int next_item(unsigned* ctr, volatile unsigned* slot) {
  __syncthreads();
  if (threadIdx.x == 0) *slot = __hip_atomic_fetch_add(ctr, 1u, __ATOMIC_RELAXED, __HIP_MEMORY_SCOPE_AGENT);
  __syncthreads();
  return (int)*slot;
}
#define FOR_QUEUE(idx, T, q) for (int idx = next_item((unsigned*)(p.ws + OFF_CTR) + 64 * (q), qslot); idx < (T); idx = next_item((unsigned*)(p.ws + OFF_CTR) + 64 * (q), qslot))

#define FOR_ITEMS(idx, T) for (int idx = (bid & 7) * (G >> 3) + (bid >> 3); idx < (T); idx += G)

__global__ void __launch_bounds__(256, 2) trunk_megakernel(Params p) {
  cg::grid_group grid = cg::this_grid();
  __shared__ __attribute__((aligned(16))) unsigned char smem_all[65536 + 16];
  unsigned char* smem = smem_all;
  const int G = gridDim.x, bid = blockIdx.x;
  if (threadIdx.x == 0) *(uint4*)(smem_all + 65536) = uint4{0u, 0u, 0u, 0u};
  __syncthreads();
  volatile unsigned* qslot = (volatile unsigned*)(smem_all + 65536 + 8);
  const XcdBarrier xb = xcd_barrier_post((unsigned*)(p.ws + OFF_BAR), (volatile LAS unsigned*)(smem_all + 65536));
  if (p.ws == nullptr) grid.sync();

  for (int i = bid; i < 64 + 192 + 8064 + 560; i += G) {
    if (i < 64) ssm_pre_item(p, i, smem);
    else if (i < 256) mod_item(p, i - 64, smem);
    else if (i < 256 + 8064) weights_item(p, i - 256, smem);
    else table_item(p, i - 256 - 8064);
  }
  xcd_barrier(xb);
  for (int r = bid * 4 + (opaque_tid() >> 6); r < M; r += G * 4) modulate0_row(p, r);
  xcd_barrier(xb);

  for (int l = 0; l < 2; ++l) {
    FOR_ITEMS(t, 96 * 14) z_tile(p, l, t, smem);
    xcd_barrier(xb);
    FOR_QUEUE(i, 384 + 1024 + 768, 1 + 2 * l) {
      if (i < 384) ssm_item(p, l, i, smem);
      else if (i < 384 + 1024) { for (int k = 0; k < 4; ++k) prep_token(p, l, (i - 384) * 16 + k * 4 + (opaque_tid() >> 6)); }
      else four1_tile(p, i - 1408, smem);
    }
    xcd_barrier(xb);
    FOR_QUEUE(i, 1536, 2 + 2 * l) {
      if (i < 512) attn_item(p, i, smem);
      else if (i < 768) four2_tile(p, 128 + (i - 512), smem);
      else if (i < 1152) glu_tile(p, l, i - 768, smem);
      else if (i < 1280) four2_tile(p, i - 1152, smem);
      else attn_item(p, 512 + (i - 1280), smem);
    }
    xcd_barrier(xb);
    FOR_ITEMS(t, 768) merged_tile(p, l, t, smem);
    xcd_barrier(xb);
    FOR_ITEMS(t, 768) resid_tile(p, l, t, 0, smem);
    xcd_barrier(xb);
    {
      const float* modl = (const float*)(p.ws + OFF_MOD) + (size_t)l * 9 * 6144;
      for (int r = bid * 4 + (opaque_tid() >> 6); r < M; r += G * 4) ln_row(p, r, p.in[26] + l * 1024, p.in[27] + l * 1024, modl, 3072, 4096, true);
    }
    xcd_barrier(xb);
    FOR_ITEMS(t, 96 * 44) up_tile(p, l, t, smem);
    xcd_barrier(xb);
    for (int i = bid; i < 192; i += G) edge_item(p, l, i);
    xcd_barrier(xb);
    FOR_ITEMS(t, 768) resid_tile(p, l, t, 1, smem);
    xcd_barrier(xb);
    {
      const float* modn = (const float*)(p.ws + OFF_MOD) + (size_t)(l + 1 < 2 ? l + 1 : l) * 9 * 6144;
      for (int r = bid * 4 + (opaque_tid() >> 6); r < M; r += G * 4) ln_row(p, r, p.in[32] + l * 1024, p.in[33] + l * 1024, modn, 0, 1024, l == 0);
    }
    if (l == 0) xcd_barrier(xb);
  }
}

extern "C" void kernel_launch(void* const* d_in, const int* in_sizes, int n_in,
                              void* d_out, int out_size, void* d_ws, size_t ws_size,
                              hipStream_t stream) {
  static int grid_blocks = 0;
  if (!grid_blocks) {
    int dev = 0, cus = 0, per_cu = 0;
    (void)hipGetDevice(&dev);
    (void)hipDeviceGetAttribute(&cus, hipDeviceAttributeMultiprocessorCount, dev);
    (void)hipOccupancyMaxActiveBlocksPerMultiprocessor(&per_cu, trunk_megakernel, 256, 0);
    if (per_cu < 1) per_cu = 1;
    grid_blocks = cus * per_cu;
  }
  Params p{};
  for (int i = 0; i < 34; ++i) p.in[i] = (const float*)d_in[i];
  p.out = (float*)d_out;
  p.ws = (unsigned char*)d_ws;
  (void)hipMemsetAsync((unsigned char*)d_ws + OFF_BAR, 0, 16384 + 2048, stream);
  void* args[] = {&p};
  hipError_t e = hipLaunchCooperativeKernel((void*)trunk_megakernel, dim3(grid_blocks), dim3(256), args, 0, stream);
  if (e != hipSuccess) fprintf(stderr, "cooperative launch failed: %s (grid %d)\n", hipGetErrorString(e), grid_blocks);
}
```

```cpp
#include <hip/hip_runtime.h>
#include <hip/hip_cooperative_groups.h>
#include <cstdio>
#include <cstdint>
namespace cg = cooperative_groups;

typedef unsigned short bf16_t;
using bf16x8 = __attribute__((ext_vector_type(8))) short;
using f32x4 = __attribute__((ext_vector_type(4))) float;

#define DEVI __device__ __forceinline__

#ifndef PROBE_PHASE
#define PROBE_PHASE -1
#endif
#define RP(n) for (int rep_ = 0; rep_ < ((n) == PROBE_PHASE ? 2 : 1); ++rep_)
#ifndef REP_P0
#define REP_P0 1
#endif
#ifndef REP_L2
#define REP_L2 1
#endif
#ifndef REP_L3
#define REP_L3 1
#endif
#ifndef REP_L7
#define REP_L7 1
#endif
#ifndef REP_SYNC
#define REP_SYNC 0
#endif
constexpr int M = 12288;
constexpr int MCTX = 4096;
constexpr float ALPHA = 1.41421356237f;
constexpr float LN_EPS = 1e-6f;

constexpr size_t WL_IN = 0;
constexpr size_t WL_GLU = WL_IN + (size_t)4864 * 1024;
constexpr size_t WL_BR = WL_GLU + (size_t)512 * 512;
constexpr size_t WL_OUT = WL_BR + (size_t)3 * 1024 * 512;
constexpr size_t WL_UP = WL_OUT + (size_t)1024 * 1024;
constexpr size_t WL_DN = WL_UP + (size_t)5632 * 1024;
constexpr size_t WL_TOT = WL_DN + (size_t)1024 * 2816;
constexpr size_t OFF_W = 0;
constexpr size_t SSM_EL = 196608;
constexpr size_t OFF_SSM = OFF_W + 2 * WL_TOT * 2;
constexpr size_t OFF_LAM16 = OFF_SSM + 64 * SSM_EL * 2;
constexpr size_t OFF_T1024 = OFF_LAM16 + 2 * 2 * 32 * 64 * 8;
constexpr size_t OFF_T256 = OFF_T1024 + (size_t)1024 * 2048 * 2;
constexpr size_t OFF_DFT128 = OFF_T256 + (size_t)256 * 512 * 2;
constexpr size_t OFF_ROPE = OFF_DFT128 + (size_t)256 * 128 * 2;
constexpr size_t OFF_MOD = OFF_ROPE + (size_t)1024 * 32 * 8;
constexpr size_t OFF_U = OFF_MOD + (size_t)2 * 9 * 6144 * 4;
constexpr size_t OFF_R = OFF_U + (size_t)M * 1024 * 2;
constexpr size_t OFF_Z = OFF_R;
constexpr size_t OFF_ATT = OFF_R;
constexpr size_t OFF_SSMG = OFF_R + (size_t)M * 512 * 2;
constexpr size_t OFF_FOUR = OFF_R + (size_t)2 * M * 512 * 2;
constexpr size_t OFF_QN = OFF_Z + (size_t)M * 1792 * 2;
constexpr size_t OFF_KD = OFF_QN + (size_t)M * 512 * 2;
constexpr size_t OFF_VTD = OFF_KD + (size_t)16 * 1536 * 64 * 2;
constexpr size_t OFF_KC = OFF_VTD + (size_t)16 * 1536 * 64 * 2;
constexpr size_t OFF_VTC = OFF_KC + (size_t)32 * 256 * 64 * 2;
constexpr size_t OFF_SSMP = OFF_VTC + (size_t)32 * 256 * 64 * 2;
constexpr size_t OFF_GT = OFF_SSMP + (size_t)M * 512 * 2;
constexpr size_t OFF_HG = OFF_R;
constexpr size_t OFF_EDGE = OFF_HG + (size_t)M * 2816 * 2;
constexpr size_t OFF_BAR = OFF_GT + (size_t)M * 1024 * 2;
constexpr size_t OFF_CTR = OFF_BAR + 16384;
constexpr size_t WS_NEEDED = OFF_BAR + 16384 + 16384;

constexpr size_t OUT_CK = (size_t)M * 1024;
constexpr size_t OUT_CV = OUT_CK + (size_t)16 * 2 * 256 * 128;
constexpr size_t OUT_ST = OUT_CV + (size_t)16 * 2 * 256 * 128;

struct Params {
  const float* in[34];
  float* out;
  unsigned char* ws;
};

DEVI int opaque_tid() {
  int t = threadIdx.x;
  asm volatile("" : "+v"(t));
  return t;
}
DEVI unsigned short f2bf(float f) {
  unsigned u = __float_as_uint(f);
  u += 0x7fffu + ((u >> 16) & 1u);
  return (unsigned short)(u >> 16);
}
DEVI float bf2f(unsigned short h) { return __uint_as_float(((unsigned)h) << 16); }
DEVI unsigned pack2(float a, float b) { return (unsigned)f2bf(a) | ((unsigned)f2bf(b) << 16); }
DEVI float sigmoidf_(float x) { return 1.0f / (1.0f + __expf(-x)); }
DEVI float gelu_tanh(float x) {
  float y = 0.7978845608028654f * (x + 0.044715f * x * x * x);
  float t = 1.0f - 2.0f / (1.0f + __expf(2.0f * y));
  return 0.5f * x * (1.0f + t);
}
DEVI void grp_tile(int idx, int NT, int& mt, int& nt) {
  const int gsz = 8 * NT, gid = idx / gsz, rem = idx - gid * gsz;
  mt = gid * 8 + (rem & 7); nt = rem >> 3;
}
DEVI int modrow(int m) { return m < MCTX ? 0 : 1 + ((m - MCTX) >> 10); }

DEVI void gemm_core2(const bf16_t* P, int ldp, const bf16_t* Q, int ldq, int K, f32x4 (&acc)[4][4],
                     unsigned char* smem) {
  const int tid = opaque_tid(), lane = tid & 63, wave = tid >> 6, wp = wave >> 1, wq = wave & 1;
  const int fr = lane & 15, fq = lane >> 4;
  const int lrow = lane >> 2;
  const int lchunk = (lane & 3) ^ ((0x78 >> (2 * ((lrow >> 2) & 3))) & 3);
  const bf16_t* gp = P + (size_t)(wave * 32 + lrow) * ldp + lchunk * 8;
  const bf16_t* gq = Q + (size_t)(wave * 32 + lrow) * ldq + lchunk * 8;
  const size_t p16 = (size_t)16 * ldp, q16 = (size_t)16 * ldq;
  unsigned char* lds_w = smem + wave * 2048;
  const int rslot = (fq ^ ((0x78 >> (2 * ((fr >> 2) & 3))) & 3)) << 4;
  const int poff = (wp * 64 + fr) * 64 + rslot;
  const int qoff = 8192 + (wq * 64 + fr) * 64 + rslot;
  const int nk = K >> 5;
#define GLDS_STAGE(kt_, st_) do { \
    const size_t ko_ = (size_t)(kt_) * 32; \
    __builtin_amdgcn_global_load_lds((const unsigned*)(gp + ko_), (unsigned*)(lds_w + (st_)), 16, 0, 0); \
    __builtin_amdgcn_global_load_lds((const unsigned*)(gp + ko_ + p16), (unsigned*)(lds_w + (st_) + 1024), 16, 0, 0); \
    __builtin_amdgcn_global_load_lds((const unsigned*)(gq + ko_), (unsigned*)(lds_w + (st_) + 8192), 16, 0, 0); \
    __builtin_amdgcn_global_load_lds((const unsigned*)(gq + ko_ + q16), (unsigned*)(lds_w + (st_) + 8192 + 1024), 16, 0, 0); \
  } while (0)
  GLDS_STAGE(0, 0); GLDS_STAGE(1, 16384);
  asm volatile("s_waitcnt vmcnt(4)" ::: "memory");
  __builtin_amdgcn_s_barrier();
  int cur = 0, nxt = 32768;
#pragma unroll 1
  for (int kt = 0; kt < nk; ++kt) {
    asm volatile("s_waitcnt vmcnt(0)" ::: "memory");
    __builtin_amdgcn_s_barrier();
    if (kt + 2 < nk) GLDS_STAGE(kt + 2, nxt);
    bf16x8 a[4], b[4];
#pragma unroll
    for (int i = 0; i < 4; ++i) a[i] = *(const bf16x8*)(smem + cur + poff + i * 1024);
#pragma unroll
    for (int j = 0; j < 4; ++j) b[j] = *(const bf16x8*)(smem + cur + qoff + j * 1024);
#pragma unroll
    for (int i = 0; i < 4; ++i)
#pragma unroll
      for (int j = 0; j < 4; ++j)
        acc[i][j] = __builtin_amdgcn_mfma_f32_16x16x32_bf16(a[i], b[j], acc[i][j], 0, 0, 0);
    cur = (cur == 32768) ? 0 : cur + 16384;
    nxt = (nxt == 32768) ? 0 : nxt + 16384;
  }
#undef GLDS_STAGE
  __syncthreads();
}

DEVI void zero_acc(f32x4 (&acc)[4][4]) {
#pragma unroll
  for (int i = 0; i < 4; ++i)
#pragma unroll
    for (int j = 0; j < 4; ++j) acc[i][j] = f32x4{0.f, 0.f, 0.f, 0.f};
}

DEVI void transpose_tile(const float* W, int K, int N, bf16_t* WT, int kt, int nt, int mode, unsigned char* smem) {
  float* t = (float*)smem;
  const int tid = opaque_tid();
  {
    const int r = tid >> 4, c4 = tid & 15;
#pragma unroll
    for (int it = 0; it < 4; ++it) {
      float4 v = *(const float4*)(W + (size_t)(kt * 64 + r + 16 * it) * N + nt * 64 + c4 * 4);
      float* d = t + (r + 16 * it) * 65 + c4 * 4;
      d[0] = v.x; d[1] = v.y; d[2] = v.z; d[3] = v.w;
    }
  }
  __syncthreads();
  {
    const int n = tid >> 2, kq = tid & 3;
    unsigned w[8];
#pragma unroll
    for (int e = 0; e < 8; ++e) w[e] = pack2(t[(kq * 16 + 2 * e) * 65 + n], t[(kq * 16 + 2 * e + 1) * 65 + n]);
    int c = nt * 64 + n, row = c;
    if (mode == 1) {
      int half = c >= 2816 ? 1 : 0;
      int cc = c - half * 2816;
      row = (cc >> 6) * 128 + half * 64 + (cc & 63);
    }
    uint4* dst = (uint4*)(WT + (size_t)row * K + kt * 64 + kq * 16);
    dst[0] = uint4{w[0], w[1], w[2], w[3]};
    dst[1] = uint4{w[4], w[5], w[6], w[7]};
  }
  __syncthreads();
}

DEVI void weights_item(const Params& p, int idx, unsigned char* smem) {
  const int l = idx / 4032;
  int t = idx - l * 4032;
  bf16_t* wl = (bf16_t*)(p.ws + OFF_W) + (size_t)l * WL_TOT;
  if (t < 1216) { transpose_tile(p.in[9] + (size_t)l * 1024 * 4864, 1024, 4864, wl + WL_IN, t / 76, t % 76, 0, smem); return; }
  t -= 1216;
  if (t < 64) { transpose_tile(p.in[20] + (size_t)l * 512 * 512, 512, 512, wl + WL_GLU, t / 8, t % 8, 0, smem); return; }
  t -= 64;
  if (t < 384) {
    const int br = t / 128; t -= br * 128;
    transpose_tile(p.in[22 + br] + (size_t)l * 512 * 1024, 512, 1024, wl + WL_BR + (size_t)br * 1024 * 512, t / 16, t % 16, 0, smem);
    return;
  }
  t -= 384;
  if (t < 256) { transpose_tile(p.in[25] + (size_t)l * 1024 * 1024, 1024, 1024, wl + WL_OUT, t / 16, t % 16, 0, smem); return; }
  t -= 256;
  if (t < 1408) { transpose_tile(p.in[28] + (size_t)l * 1024 * 5632, 1024, 5632, wl + WL_UP, t / 88, t % 88, 1, smem); return; }
  t -= 1408;
  transpose_tile(p.in[31] + (size_t)l * 2816 * 1024, 2816, 1024, wl + WL_DN, t / 16, t % 16, 0, smem);
}

DEVI void mod_item(const Params& p, int idx, unsigned char* smem) {
  const int l = idx / 96, nt = idx % 96;
  float* sc = (float*)smem;
  float* red = (float*)(smem + 36864);
  const int tid = opaque_tid();
  for (int e = tid; e < 9 * 1024; e += 256) {
    const int r = e >> 10, k = e & 1023;
    const float v = (r == 0) ? p.in[6][k] : p.in[2][(r - 1) * 1024 + k];
    sc[e] = v * sigmoidf_(v);
  }
  __syncthreads();
  const int kq = tid >> 6, col = tid & 63;
  const float* w = p.in[7] + (size_t)l * 1024 * 6144 + (size_t)(kq * 256) * 6144 + nt * 64 + col;
  float acc[9];
#pragma unroll
  for (int r = 0; r < 9; ++r) acc[r] = 0.f;
  for (int k0 = 0; k0 < 256; k0 += 8) {
    float wv[8];
#pragma unroll
    for (int e = 0; e < 8; ++e) wv[e] = w[(size_t)(k0 + e) * 6144];
#pragma unroll
    for (int e = 0; e < 8; ++e)
#pragma unroll
      for (int r = 0; r < 9; ++r) acc[r] += sc[r * 1024 + kq * 256 + k0 + e] * wv[e];
  }
#pragma unroll
  for (int r = 0; r < 9; ++r) red[(kq * 9 + r) * 64 + col] = acc[r];
  __syncthreads();
  float* mod = (float*)(p.ws + OFF_MOD) + (size_t)l * 9 * 6144;
  for (int e = tid; e < 9 * 64; e += 256) {
    const int r = e >> 6, c = e & 63;
    float s = red[(0 * 9 + r) * 64 + c] + red[(1 * 9 + r) * 64 + c] + red[(2 * 9 + r) * 64 + c] + red[(3 * 9 + r) * 64 + c];
    mod[r * 6144 + nt * 64 + c] = s + p.in[8][l * 6144 + nt * 64 + c];
  }
  __syncthreads();
}

DEVI void ssm_pre_item(const Params& p, int idx, unsigned char* smem) {
  const int l = idx >> 5, g = idx & 31;
  const int tid = opaque_tid();
  float2* Lpow = (float2*)smem;
  float2* Bbar = (float2*)(smem + 8704);
  float* Kc = (float*)(smem + 8704 + 8192);
  const float* a_re = p.in[12]; const float* a_im = p.in[13]; const float* log_dt = p.in[14];
  const float* b_re = p.in[15]; const float* b_im = p.in[16]; const float* c_re = p.in[17]; const float* c_im = p.in[18];
  bf16_t* AC = (bf16_t*)(p.ws + OFF_SSM) + (size_t)idx * SSM_EL;
  bf16_t* W1 = AC + 256 * 512;
#pragma unroll 1
  for (int dir = 0; dir < 2; ++dir) {
    const float dt = expf(log_dt[(l * 2 + dir) * 32 + g]);
    for (int e = tid; e < 17 * 64; e += 256) {
      const int tau = e >> 6, pp = e & 63;
      const int ai = ((l * 2 + dir) * 32 + g) * 64 + pp;
      const float mag = expf(a_re[ai] * dt * (float)tau);
      const float ang = a_im[ai] * dt * (float)tau;
      float sn, cs; sincosf(ang, &sn, &cs);
      Lpow[e] = float2{mag * cs, mag * sn};
      if (tau == 16) ((float2*)(p.ws + OFF_LAM16))[ai] = float2{mag * cs, mag * sn};
    }
    for (int e = tid; e < 64 * 16; e += 256) {
      const int pp = e >> 4, n = e & 15;
      const int ai = ((l * 2 + dir) * 32 + g) * 64 + pp;
      const float ar = a_re[ai], aim = a_im[ai];
      const float mag = expf(ar * dt);
      float sn, cs; sincosf(aim * dt, &sn, &cs);
      const float nr = mag * cs - 1.0f, ni = mag * sn;
      const float den = ar * ar + aim * aim;
      const float fr_ = (nr * ar + ni * aim) / den, fi_ = (ni * ar - nr * aim) / den;
      const float br = b_re[(size_t)ai * 16 + n], bi = b_im[(size_t)ai * 16 + n];
      Bbar[e] = float2{fr_ * br - fi_ * bi, fr_ * bi + fi_ * br};
    }
    __syncthreads();
    {
      const int tau = tid >> 4, n = tid & 15;
      float acc[16];
#pragma unroll
      for (int m = 0; m < 16; ++m) acc[m] = 0.f;
      const size_t cbase = ((size_t)((l * 2 + dir) * 32 + g) * 16 + n) * 64;
#pragma unroll 1
      for (int p8 = 0; p8 < 64; p8 += 8) {
        const float4 cr0 = *(const float4*)(c_re + cbase + p8), cr1 = *(const float4*)(c_re + cbase + p8 + 4);
        const float4 ci0 = *(const float4*)(c_im + cbase + p8), ci1 = *(const float4*)(c_im + cbase + p8 + 4);
        const float crv[8] = {cr0.x, cr0.y, cr0.z, cr0.w, cr1.x, cr1.y, cr1.z, cr1.w};
        const float civ[8] = {ci0.x, ci0.y, ci0.z, ci0.w, ci1.x, ci1.y, ci1.z, ci1.w};
#pragma unroll
        for (int e = 0; e < 8; ++e) {
          const int pp = p8 + e;
          const float2 lp = Lpow[tau * 64 + pp];
          const float gr = crv[e] * lp.x - civ[e] * lp.y, gi = crv[e] * lp.y + civ[e] * lp.x;
#pragma unroll
          for (int m = 0; m < 16; ++m) {
            const float2 bb = Bbar[pp * 16 + m];
            acc[m] += gr * bb.x - gi * bb.y;
          }
        }
      }
      const int delta = dir == 0 ? 15 - tau : 15 + tau;
#pragma unroll
      for (int m = 0; m < 16; ++m) {
        if (dir == 1 && tau == 0) Kc[(delta * 16 + n) * 16 + m] += acc[m];
        else Kc[(delta * 16 + n) * 16 + m] = acc[m];
      }
    }
    {
      const int n = tid >> 4, pg = tid & 15, p0 = pg * 4, kc = 32 + dir * 16 + pg;
      const size_t cbase = ((size_t)((l * 2 + dir) * 32 + g) * 16 + n) * 64;
      const float4 cr4 = *(const float4*)(c_re + cbase + p0), ci4 = *(const float4*)(c_im + cbase + p0);
      const float crv[4] = {cr4.x, cr4.y, cr4.z, cr4.w}, civ[4] = {ci4.x, ci4.y, ci4.z, ci4.w};
#pragma unroll 1
      for (int t = 0; t < 16; ++t) {
        const int tau = dir == 0 ? t + 1 : 16 - t;
        float val[8];
#pragma unroll
        for (int e = 0; e < 4; ++e) {
          const float2 lp = Lpow[tau * 64 + p0 + e];
          val[2 * e] = crv[e] * lp.x - civ[e] * lp.y;
          val[2 * e + 1] = -(crv[e] * lp.y + civ[e] * lp.x);
        }
        *(uint4*)(AC + (size_t)(t * 16 + n) * 512 + kc * 8) =
            uint4{pack2(val[0], val[1]), pack2(val[2], val[3]), pack2(val[4], val[5]), pack2(val[6], val[7])};
      }
    }
    for (int v = tid; v < 128 * 32; v += 256) {
      const int rl = v >> 5, kc = v & 31;
      const int pp = rl >> 1, ri = rl & 1;
      const int sidx = kc >> 1, m0 = (kc & 1) * 8;
      const float2 lp = Lpow[(dir == 0 ? 15 - sidx : sidx) * 64 + pp];
      float val[8];
#pragma unroll
      for (int e = 0; e < 8; ++e) {
        const float2 bb = Bbar[pp * 16 + m0 + e];
        val[e] = ri == 0 ? (lp.x * bb.x - lp.y * bb.y) : (lp.x * bb.y + lp.y * bb.x);
      }
      *(uint4*)(W1 + (size_t)(dir * 128 + rl) * 256 + kc * 8) =
          uint4{pack2(val[0], val[1]), pack2(val[2], val[3]), pack2(val[4], val[5]), pack2(val[6], val[7])};
    }
    __syncthreads();
  }
  for (int v = tid; v < 256 * 32; v += 256) {
    const int row = v >> 5, kc = v & 31;
    const int t = row >> 4, n = row & 15;
    const int sidx = kc >> 1, m0 = (kc & 1) * 8;
    const int delta = sidx - t + 15;
    float val[8];
#pragma unroll
    for (int e = 0; e < 8; ++e) val[e] = Kc[(delta * 16 + n) * 16 + m0 + e];
    *(uint4*)(AC + (size_t)row * 512 + kc * 8) =
        uint4{pack2(val[0], val[1]), pack2(val[2], val[3]), pack2(val[4], val[5]), pack2(val[6], val[7])};
  }
  __syncthreads();
}

DEVI void table_item(const Params& p, int idx) {
  const int tid = opaque_tid();
  if (idx < 512) {
    bf16_t* T = (bf16_t*)(p.ws + OFF_T1024);
    for (int e = tid; e < 4096; e += 256) {
      const int g = idx * 4096 + e, k = g >> 11, kk = g & 2047;
      const int ph = (k * (kk & 1023)) & 1023;
      float s, c; sincospif((float)ph * (2.0f / 1024.0f), &s, &c);
      T[g] = f2bf(kk < 1024 ? c : -s);
    }
    return;
  }
  idx -= 512;
  if (idx < 32) {
    bf16_t* T = (bf16_t*)(p.ws + OFF_T256);
    for (int e = tid; e < 4096; e += 256) {
      const int g = idx * 4096 + e, k = g >> 9, kk = g & 511;
      const int ph = (k * (kk & 255)) & 255;
      float s, c; sincospif((float)ph * (2.0f / 256.0f), &s, &c);
      T[g] = f2bf(kk < 256 ? c : -s);
    }
    return;
  }
  idx -= 32;
  if (idx < 8) {
    bf16_t* T = (bf16_t*)(p.ws + OFF_DFT128);
    for (int e = tid; e < 4096; e += 256) {
      const int g = idx * 4096 + e, n1 = g >> 7, c_ = g & 127;
      const int ph = (c_ * (n1 & 127)) & 127;
      float s, c; sincospif((float)ph * (2.0f / 128.0f), &s, &c);
      T[g] = f2bf(n1 < 128 ? c : s);
    }
    return;
  }
  idx -= 8;
  {
    float2* T = (float2*)(p.ws + OFF_ROPE);
    for (int e = tid; e < 4096; e += 256) {
      const int g = idx * 4096 + e, t = g >> 5, i = g & 31;
      const float pos = (i < 16) ? (float)(t >> 6) : (float)(t & 63);
      const float fr_ = powf(10000.0f, -(float)(i & 15) / 16.0f);
      float s, c; sincosf(pos * fr_, &s, &c);
      T[g] = float2{c, s};
    }
  }
}

DEVI const float* xin_row(const Params& p, int m) {
  return m < MCTX ? p.in[0] + (size_t)m * 1024 : p.in[1] + (size_t)(m - MCTX) * 1024;
}

DEVI void modulate0_row(const Params& p, int m) {
  const int lane = opaque_tid() & 63;
  const float* x = xin_row(p, m);
  const float* mod = (const float*)(p.ws + OFF_MOD) + (size_t)modrow(m) * 6144;
  bf16_t* u = (bf16_t*)(p.ws + OFF_U) + (size_t)m * 1024;
#pragma unroll
  for (int k = 0; k < 4; ++k) {
    const int c = lane * 4 + 256 * k;
    const float4 v = *(const float4*)(x + c);
    const float4 sh = *(const float4*)(mod + c);
    const float4 sc = *(const float4*)(mod + 1024 + c);
    uint2 o;
    o.x = pack2(v.x * (1.f + sc.x) + sh.x, v.y * (1.f + sc.y) + sh.y);
    o.y = pack2(v.z * (1.f + sc.z) + sh.z, v.w * (1.f + sc.w) + sh.w);
    *(uint2*)(u + c) = o;
  }
}

DEVI void ln_row(const Params& p, int m, const float* g, const float* b, const float* modl, int sh_off, int sc_off, bool write_u) {
  const int lane = opaque_tid() & 63;
  float* x = p.out + (size_t)m * 1024;
  float4 v[4];
  float s = 0.f;
#pragma unroll
  for (int k = 0; k < 4; ++k) {
    v[k] = *(const float4*)(x + lane * 4 + 256 * k);
    s += v[k].x + v[k].y + v[k].z + v[k].w;
  }
#pragma unroll
  for (int o = 32; o >= 1; o >>= 1) s += __shfl_xor(s, o);
  const float mu = s * (1.0f / 1024.0f);
  float q = 0.f;
#pragma unroll
  for (int k = 0; k < 4; ++k) {
    v[k].x -= mu; v[k].y -= mu; v[k].z -= mu; v[k].w -= mu;
    q += v[k].x * v[k].x + v[k].y * v[k].y + v[k].z * v[k].z + v[k].w * v[k].w;
  }
#pragma unroll
  for (int o = 32; o >= 1; o >>= 1) q += __shfl_xor(q, o);
  const float rs = rsqrtf(q * (1.0f / 1024.0f) + LN_EPS);
  const float* mod = modl + (size_t)modrow(m) * 6144;
  bf16_t* u = (bf16_t*)(p.ws + OFF_U) + (size_t)m * 1024;
#pragma unroll
  for (int k = 0; k < 4; ++k) {
    const int c = lane * 4 + 256 * k;
    const float4 gg = *(const float4*)(g + c);
    const float4 bb = *(const float4*)(b + c);
    float4 y;
    y.x = v[k].x * rs * gg.x + bb.x; y.y = v[k].y * rs * gg.y + bb.y;
    y.z = v[k].z * rs * gg.z + bb.z; y.w = v[k].w * rs * gg.w + bb.w;
    *(float4*)(x + c) = y;
    if (write_u) {
      const float4 sh = *(const float4*)(mod + sh_off + c);
      const float4 sc = *(const float4*)(mod + sc_off + c);
      uint2 o;
      o.x = pack2(y.x * (1.f + sc.x) + sh.x, y.y * (1.f + sc.y) + sh.y);
      o.y = pack2(y.z * (1.f + sc.z) + sh.z, y.w * (1.f + sc.w) + sh.w);
      *(uint2*)(u + c) = o;
    }
  }
}

DEVI void prep_token(const Params& p, int l, int tok) {
  const int lane = opaque_tid() & 63;
  bf16_t* Kd = (bf16_t*)(p.ws + OFF_KD); bf16_t* VTd = (bf16_t*)(p.ws + OFF_VTD);
  bf16_t* Kc = (bf16_t*)(p.ws + OFF_KC); bf16_t* VTc = (bf16_t*)(p.ws + OFF_VTC);
  if (tok >= M) {
    const int b = (tok - M) >> 9, j = (tok - M) & 511;
    if (lane < 32) {
      const int li = lane & 15, hk = li >> 3, d0 = (li & 7) * 8;
      const float* src = (lane < 16 ? p.in[3] : p.in[4]) + ((size_t)((b * 2 + l) * 512 + j)) * 128 + li * 8;
      const float4 v0 = *(const float4*)src, v1 = *(const float4*)(src + 4);
      const float vv[8] = {v0.x, v0.y, v0.z, v0.w, v1.x, v1.y, v1.z, v1.w};
      if (lane < 16) {
        *(uint4*)(Kd + ((size_t)(b * 2 + hk) * 1536 + 1024 + j) * 64 + d0) =
            uint4{pack2(vv[0], vv[1]), pack2(vv[2], vv[3]), pack2(vv[4], vv[5]), pack2(vv[6], vv[7])};
      } else {
#pragma unroll
        for (int e = 0; e < 8; ++e) VTd[((size_t)(b * 2 + hk) * 64 + d0 + e) * 1536 + 1024 + j] = f2bf(vv[e]);
      }
    }
    return;
  }
  const int m = tok;
  const bool dec = m >= MCTX;
  const int b = dec ? (m - MCTX) >> 10 : m >> 8;
  const int t = dec ? (m - MCTX) & 1023 : m & 255;
  const bf16_t* z = (const bf16_t*)(p.ws + OFF_Z) + (size_t)m * 1792;
  const float2* rope = (const float2*)(p.ws + OFF_ROPE) + (size_t)t * 32;
  {
    const uint4 raw = *(const uint4*)(z + lane * 8);
    float x[8];
    x[0] = bf2f(raw.x & 0xffff); x[1] = bf2f(raw.x >> 16); x[2] = bf2f(raw.y & 0xffff); x[3] = bf2f(raw.y >> 16);
    x[4] = bf2f(raw.z & 0xffff); x[5] = bf2f(raw.z >> 16); x[6] = bf2f(raw.w & 0xffff); x[7] = bf2f(raw.w >> 16);
    float ss = 0.f;
#pragma unroll
    for (int e = 0; e < 8; ++e) ss += x[e] * x[e];
    ss += __shfl_xor(ss, 1); ss += __shfl_xor(ss, 2); ss += __shfl_xor(ss, 4);
    const float rn = rsqrtf(ss * (1.0f / 64.0f) + LN_EPS);
    const int d0 = (lane & 7) * 8;
    const float* gq = p.in[10] + l * 64 + d0;
#pragma unroll
    for (int e = 0; e < 8; ++e) x[e] = x[e] * rn * gq[e];
    if (dec) {
#pragma unroll
      for (int e = 0; e < 4; ++e) {
        const float2 cs = rope[(d0 >> 1) + e];
        const float x0 = x[2 * e], x1 = x[2 * e + 1];
        x[2 * e] = x0 * cs.x - x1 * cs.y;
        x[2 * e + 1] = x0 * cs.y + x1 * cs.x;
      }
    }
    const float qs = 0.125f * 1.4426950408889634f;
    *(uint4*)((bf16_t*)(p.ws + OFF_QN) + (size_t)m * 512 + lane * 8) =
        uint4{pack2(x[0] * qs, x[1] * qs), pack2(x[2] * qs, x[3] * qs), pack2(x[4] * qs, x[5] * qs), pack2(x[6] * qs, x[7] * qs)};
  }
  {
    const int li = lane & 15, hk = li >> 3, d0 = (li & 7) * 8;
    const uint4 raw = *(const uint4*)(z + 512 + li * 8);
    float x[8];
    x[0] = bf2f(raw.x & 0xffff); x[1] = bf2f(raw.x >> 16); x[2] = bf2f(raw.y & 0xffff); x[3] = bf2f(raw.y >> 16);
    x[4] = bf2f(raw.z & 0xffff); x[5] = bf2f(raw.z >> 16); x[6] = bf2f(raw.w & 0xffff); x[7] = bf2f(raw.w >> 16);
    float ss = 0.f;
#pragma unroll
    for (int e = 0; e < 8; ++e) ss += x[e] * x[e];
    ss += __shfl_xor(ss, 1); ss += __shfl_xor(ss, 2); ss += __shfl_xor(ss, 4);
    const float rn = rsqrtf(ss * (1.0f / 64.0f) + LN_EPS);
    const float* gk = p.in[11] + l * 64 + d0;
#pragma unroll
    for (int e = 0; e < 8; ++e) x[e] = x[e] * rn * gk[e];
    if (lane < 16) {
      if (!dec) {
        float* ck = p.out + OUT_CK + ((size_t)((b * 2 + l) * 256 + t)) * 128 + li * 8;
        *(float4*)ck = float4{x[0], x[1], x[2], x[3]};
        *(float4*)(ck + 4) = float4{x[4], x[5], x[6], x[7]};
        *(uint4*)(Kc + ((size_t)(b * 2 + hk) * 256 + t) * 64 + d0) =
            uint4{pack2(x[0], x[1]), pack2(x[2], x[3]), pack2(x[4], x[5]), pack2(x[6], x[7])};
      } else {
#pragma unroll
        for (int e = 0; e < 4; ++e) {
          const float2 cs = rope[(d0 >> 1) + e];
          const float x0 = x[2 * e], x1 = x[2 * e + 1];
          x[2 * e] = x0 * cs.x - x1 * cs.y;
          x[2 * e + 1] = x0 * cs.y + x1 * cs.x;
        }
        *(uint4*)(Kd + ((size_t)(b * 2 + hk) * 1536 + t) * 64 + d0) =
            uint4{pack2(x[0], x[1]), pack2(x[2], x[3]), pack2(x[4], x[5]), pack2(x[6], x[7])};
      }
    }
  }
  if (lane >= 16 && lane < 32) {
    const int li = lane - 16, hk = li >> 3, d0 = (li & 7) * 8;
    const uint4 raw = *(const uint4*)(z + 640 + li * 8);
    float x[8];
    x[0] = bf2f(raw.x & 0xffff); x[1] = bf2f(raw.x >> 16); x[2] = bf2f(raw.y & 0xffff); x[3] = bf2f(raw.y >> 16);
    x[4] = bf2f(raw.z & 0xffff); x[5] = bf2f(raw.z >> 16); x[6] = bf2f(raw.w & 0xffff); x[7] = bf2f(raw.w >> 16);
    if (!dec) {
      float* cv = p.out + OUT_CV + ((size_t)((b * 2 + l) * 256 + t)) * 128 + li * 8;
      *(float4*)cv = float4{x[0], x[1], x[2], x[3]};
      *(float4*)(cv + 4) = float4{x[4], x[5], x[6], x[7]};
#pragma unroll
      for (int e = 0; e < 8; ++e) VTc[((size_t)(b * 2 + hk) * 64 + d0 + e) * 256 + t] = f2bf(x[e]);
    } else {
#pragma unroll
      for (int e = 0; e < 8; ++e) VTd[((size_t)(b * 2 + hk) * 64 + d0 + e) * 1536 + t] = f2bf(x[e]);
    }
  }
}

DEVI void attn_item(const Params& p, int a, unsigned char* smem) {
  const int tid = opaque_tid(), lane = tid & 63, wave = tid >> 6, fr = lane & 15, fq = lane >> 4;
  int h, Lk, m0;
  const bf16_t *Kb, *Vb;
  if (a < 512) {
    const int b = a >> 6; h = (a >> 3) & 7; const int qb = a & 7; Lk = 1536; m0 = MCTX + b * 1024 + qb * 128;
    const int bh = b * 2 + (h >> 2);
    Kb = (const bf16_t*)(p.ws + OFF_KD) + (size_t)bh * 1536 * 64;
    Vb = (const bf16_t*)(p.ws + OFF_VTD) + (size_t)bh * 64 * 1536;
  } else {
    a -= 512;
    const int b = a >> 4; h = (a >> 1) & 7; const int qb = a & 1; Lk = 256; m0 = b * 256 + qb * 128;
    const int bh = b * 2 + (h >> 2);
    Kb = (const bf16_t*)(p.ws + OFF_KC) + (size_t)bh * 256 * 64;
    Vb = (const bf16_t*)(p.ws + OFF_VTC) + (size_t)bh * 64 * 256;
  }
  const bf16_t* Qn = (const bf16_t*)(p.ws + OFF_QN);
  bf16x8 qf[2][2];
#pragma unroll
  for (int jq = 0; jq < 2; ++jq)
#pragma unroll
    for (int ks = 0; ks < 2; ++ks)
      qf[jq][ks] = *(const bf16x8*)(Qn + (size_t)(m0 + wave * 32 + jq * 16 + fr) * 512 + h * 64 + ks * 32 + fq * 8);
  f32x4 o[4][2];
#pragma unroll
  for (int di = 0; di < 4; ++di)
#pragma unroll
    for (int jq = 0; jq < 2; ++jq) o[di][jq] = f32x4{0.f, 0.f, 0.f, 0.f};
  float mrow[2] = {-1e30f, -1e30f}, lrow[2] = {0.f, 0.f};
  const int nt = Lk >> 6;
  const int srow = tid >> 3, sch = tid & 7;
  const int woff = srow * 128 + ((sch ^ ((srow >> 1) & 7)) << 4);
  const int swz = fr >> 1;
  uint4 rk[2], rv[2];
#pragma unroll
  for (int it = 0; it < 2; ++it) {
    rk[it] = *(const uint4*)(Kb + (size_t)(srow + 32 * it) * 64 + sch * 8);
    rv[it] = *(const uint4*)(Vb + (size_t)(srow + 32 * it) * Lk + sch * 8);
  }
#pragma unroll
  for (int it = 0; it < 2; ++it) {
    *(uint4*)(smem + woff + it * 4096) = rk[it];
    *(uint4*)(smem + 8192 + woff + it * 4096) = rv[it];
  }
  __syncthreads();
#pragma unroll 1
  for (int kt = 0; kt < nt; ++kt) {
    const int cur = (kt & 1) * 16384;
    {
      const int kn = (kt + 1 < nt) ? kt + 1 : kt;
#pragma unroll
      for (int it = 0; it < 2; ++it) {
        rk[it] = *(const uint4*)(Kb + (size_t)(kn * 64 + srow + 32 * it) * 64 + sch * 8);
        rv[it] = *(const uint4*)(Vb + (size_t)(srow + 32 * it) * Lk + kn * 64 + sch * 8);
      }
    }
    f32x4 s[4][2];
#pragma unroll
    for (int i = 0; i < 4; ++i)
#pragma unroll
      for (int jq = 0; jq < 2; ++jq) s[i][jq] = f32x4{0.f, 0.f, 0.f, 0.f};
#pragma unroll
    for (int ks = 0; ks < 2; ++ks) {
      const int co = ((ks * 4 + fq) ^ swz) << 4;
#pragma unroll
      for (int i = 0; i < 4; ++i) {
        const bf16x8 kf = *(const bf16x8*)(smem + cur + (i * 16 + fr) * 128 + co);
#pragma unroll
        for (int jq = 0; jq < 2; ++jq) s[i][jq] = __builtin_amdgcn_mfma_f32_16x16x32_bf16(kf, qf[jq][ks], s[i][jq], 0, 0, 0);
      }
    }
#pragma unroll
    for (int jq = 0; jq < 2; ++jq) {
      float mx = -1e30f;
#pragma unroll
      for (int i = 0; i < 4; ++i)
#pragma unroll
        for (int r = 0; r < 4; ++r) mx = fmaxf(mx, s[i][jq][r]);
      mx = fmaxf(mx, __shfl_xor(mx, 16));
      mx = fmaxf(mx, __shfl_xor(mx, 32));
      const float mnew = fmaxf(mrow[jq], mx);
      const float alpha = exp2f(mrow[jq] - mnew);
      mrow[jq] = mnew;
      float ls = 0.f;
#pragma unroll
      for (int i = 0; i < 4; ++i)
#pragma unroll
        for (int r = 0; r < 4; ++r) { const float e = exp2f(s[i][jq][r] - mnew); s[i][jq][r] = e; ls += e; }
      lrow[jq] = lrow[jq] * alpha + ls;
#pragma unroll
      for (int di = 0; di < 4; ++di)
#pragma unroll
        for (int r = 0; r < 4; ++r) o[di][jq][r] *= alpha;
    }
#pragma unroll
    for (int kk = 0; kk < 2; ++kk) {
      bf16x8 pf[2];
#pragma unroll
      for (int jq = 0; jq < 2; ++jq) {
        union { uint4 u; bf16x8 v; } cv;
        cv.u = uint4{pack2(s[2 * kk][jq][0], s[2 * kk][jq][1]), pack2(s[2 * kk][jq][2], s[2 * kk][jq][3]),
                     pack2(s[2 * kk + 1][jq][0], s[2 * kk + 1][jq][1]), pack2(s[2 * kk + 1][jq][2], s[2 * kk + 1][jq][3])};
        pf[jq] = cv.v;
      }
      const int c0 = ((4 * kk + (fq >> 1)) ^ swz) << 4;
      const int c1 = ((4 * kk + 2 + (fq >> 1)) ^ swz) << 4;
      const int wi = (fq & 1) * 8;
#pragma unroll
      for (int di = 0; di < 4; ++di) {
        const unsigned char* vrow = smem + cur + 8192 + (di * 16 + fr) * 128;
        union { uint2 u[2]; bf16x8 v; } cv;
        cv.u[0] = *(const uint2*)(vrow + c0 + wi);
        cv.u[1] = *(const uint2*)(vrow + c1 + wi);
#pragma unroll
        for (int jq = 0; jq < 2; ++jq) o[di][jq] = __builtin_amdgcn_mfma_f32_16x16x32_bf16(cv.v, pf[jq], o[di][jq], 0, 0, 0);
      }
    }
    {
      const int nxt = 16384 - cur;
#pragma unroll
      for (int it = 0; it < 2; ++it) {
        *(uint4*)(smem + nxt + woff + it * 4096) = rk[it];
        *(uint4*)(smem + nxt + 8192 + woff + it * 4096) = rv[it];
      }
    }
    __syncthreads();
  }
  bf16_t* att = (bf16_t*)(p.ws + OFF_ATT);
#pragma unroll
  for (int jq = 0; jq < 2; ++jq) {
    float lt = lrow[jq];
    lt += __shfl_xor(lt, 16);
    lt += __shfl_xor(lt, 32);
    const float inv = 1.0f / lt;
    bf16_t* dst = att + (size_t)(m0 + wave * 32 + jq * 16 + fr) * 512 + h * 64 + 4 * fq;
#pragma unroll
    for (int di = 0; di < 4; ++di)
      *(uint2*)(dst + di * 16) = uint2{pack2(o[di][jq][0] * inv, o[di][jq][1] * inv), pack2(o[di][jq][2] * inv, o[di][jq][3] * inv)};
  }
}

DEVI int ssm_col_row(int sub, int j) {
  return sub < 8 ? MCTX + sub * 1024 + j * 16 : ((sub - 8) * 4 + (j >> 4)) * 256 + (j & 15) * 16;
}

DEVI void ssm_item(const Params& p, int l, int idx, unsigned char* smem) {
  const int g = idx / 12, sub = idx % 12;
  const int tid = opaque_tid(), lane = tid & 63, wave = tid >> 6, fr = lane & 15, fq = lane >> 4;
  const bf16_t* AC = (const bf16_t*)(p.ws + OFF_SSM) + (size_t)(l * 32 + g) * SSM_EL;
  const bf16_t* W1 = AC + 256 * 512;
  const bf16_t* z = (const bf16_t*)(p.ws + OFF_Z);
  const int ucol = 768 + g * 16;
  size_t ubase[4];
#pragma unroll
  for (int jt = 0; jt < 4; ++jt) ubase[jt] = (size_t)ssm_col_row(sub, jt * 16 + fr) * 1792 + ucol;
  f32x4 acc[4][4];
  zero_acc(acc);
#pragma unroll 1
  for (int ks = 0; ks < 8; ++ks) {
    const int s = 2 * ks + (fq >> 1), m8 = (fq & 1) * 8;
    bf16x8 a[4], b[4];
#pragma unroll
    for (int i = 0; i < 4; ++i) a[i] = *(const bf16x8*)(W1 + (size_t)(wave * 64 + i * 16 + fr) * 256 + ks * 32 + fq * 8);
#pragma unroll
    for (int jt = 0; jt < 4; ++jt) b[jt] = *(const bf16x8*)(z + ubase[jt] + (size_t)s * 1792 + m8);
#pragma unroll
    for (int i = 0; i < 4; ++i)
#pragma unroll
      for (int jt = 0; jt < 4; ++jt) acc[i][jt] = __builtin_amdgcn_mfma_f32_16x16x32_bf16(a[i], b[jt], acc[i][jt], 0, 0, 0);
  }
#pragma unroll
  for (int i = 0; i < 4; ++i)
#pragma unroll
    for (int jt = 0; jt < 4; ++jt) {
      const int j = jt * 16 + fr;
      const int row0 = wave * 64 + i * 16 + 4 * fq;
      *(uint2*)(smem + j * 512 + (((row0 >> 3) ^ (j & 15)) << 4) + (row0 & 4) * 2) =
          uint2{pack2(acc[i][jt][0], acc[i][jt][1]), pack2(acc[i][jt][2], acc[i][jt][3])};
    }
  __syncthreads();
  if (tid < 128) {
    const int dir = tid >> 6, pp = tid & 63;
    const float2 lam = ((const float2*)(p.ws + OFF_LAM16))[((l * 2 + dir) * 32 + g) * 64 + pp];
    const int nseq = sub < 8 ? 1 : 4, nch = sub < 8 ? 64 : 16;
    const int ch = (dir * 64 + pp) >> 2, wi = (pp & 3) * 4;
    for (int q = 0; q < nseq; ++q) {
      float hr = 0.f, hi = 0.f;
      if (sub < 8) {
        const float* h0 = p.in[5] + ((size_t)(((sub * 2 + l) * 2 + dir) * 32 + g) * 64 + pp) * 2;
        hr = h0[0]; hi = h0[1];
      }
      for (int c = 0; c < nch; ++c) {
        const int j = q * nch + (dir == 0 ? c : nch - 1 - c);
        unsigned* f = (unsigned*)(smem + j * 512 + ((ch ^ (j & 15)) << 4) + wi);
        const unsigned Fb = *f;
        *f = pack2(hr, hi);
        const float nr = lam.x * hr - lam.y * hi + bf2f(Fb & 0xffff);
        const float ni = lam.x * hi + lam.y * hr + bf2f(Fb >> 16);
        hr = nr; hi = ni;
      }
      if (sub >= 8) {
        const int b = (sub - 8) * 4 + q;
        float* st = p.out + OUT_ST + ((size_t)(((b * 2 + l) * 2 + dir) * 32 + g) * 64 + pp) * 2;
        st[0] = hr; st[1] = hi;
      }
    }
  }
  __syncthreads();
  zero_acc(acc);
#pragma unroll 1
  for (int ks = 0; ks < 16; ++ks) {
    bf16x8 a[4], b[4];
#pragma unroll
    for (int i = 0; i < 4; ++i) a[i] = *(const bf16x8*)(AC + (size_t)(wave * 64 + i * 16 + fr) * 512 + ks * 32 + fq * 8);
    if (ks < 8) {
      const int s = 2 * ks + (fq >> 1), m8 = (fq & 1) * 8;
#pragma unroll
      for (int jt = 0; jt < 4; ++jt) b[jt] = *(const bf16x8*)(z + ubase[jt] + (size_t)s * 1792 + m8);
    } else {
      const int c0 = (ks - 8) * 4 + fq;
#pragma unroll
      for (int jt = 0; jt < 4; ++jt) {
        const int j = jt * 16 + fr;
        b[jt] = *(const bf16x8*)(smem + j * 512 + ((c0 ^ (j & 15)) << 4));
      }
    }
#pragma unroll
    for (int i = 0; i < 4; ++i)
#pragma unroll
      for (int jt = 0; jt < 4; ++jt) acc[i][jt] = __builtin_amdgcn_mfma_f32_16x16x32_bf16(a[i], b[jt], acc[i][jt], 0, 0, 0);
  }
  bf16_t* sp = (bf16_t*)(p.ws + OFF_SSMP);
  const float4 dv = *(const float4*)(p.in[19] + l * 512 + g * 16 + 4 * fq);
#pragma unroll
  for (int i = 0; i < 4; ++i) {
    const int t = wave * 4 + i;
#pragma unroll
    for (int jt = 0; jt < 4; ++jt) {
      const size_t row = (size_t)ssm_col_row(sub, jt * 16 + fr) + t;
      const uint2 uu = *(const uint2*)(z + row * 1792 + ucol + 4 * fq);
      const float y0 = gelu_tanh(acc[i][jt][0] + dv.x * bf2f(uu.x & 0xffff));
      const float y1 = gelu_tanh(acc[i][jt][1] + dv.y * bf2f(uu.x >> 16));
      const float y2 = gelu_tanh(acc[i][jt][2] + dv.z * bf2f(uu.y & 0xffff));
      const float y3 = gelu_tanh(acc[i][jt][3] + dv.w * bf2f(uu.y >> 16));
      *(uint2*)(sp + row * 512 + g * 16 + 4 * fq) = uint2{pack2(y0, y1), pack2(y2, y3)};
      asm volatile("" ::: "memory");
    }
  }
  __syncthreads();
}

#define TILE_IDS \
  const int tid = opaque_tid(), lane = tid & 63, wave = tid >> 6, wp = wave >> 1, wq = wave & 1, fr = lane & 15, fq = lane >> 4; \
  (void)tid; (void)wp; (void)wq; (void)fr; (void)fq;

DEVI void z_tile(const Params& p, int l, int t, unsigned char* smem) {
  TILE_IDS
  int mt, nt; grp_tile(t, 14, mt, nt);
  const bf16_t* P = (const bf16_t*)(p.ws + OFF_W) + (size_t)l * WL_TOT + WL_IN + (size_t)nt * 128 * 1024;
  const bf16_t* Q = (const bf16_t*)(p.ws + OFF_U) + (size_t)mt * 128 * 1024;
  f32x4 acc[4][4];
  zero_acc(acc);
  gemm_core2(P, 1024, Q, 1024, 1024, acc, smem);
  bf16_t* z = (bf16_t*)(p.ws + OFF_Z);
#pragma unroll
  for (int i = 0; i < 4; ++i)
#pragma unroll
    for (int j = 0; j < 4; ++j) {
      const int n = nt * 128 + wp * 64 + i * 16 + 4 * fq, m = mt * 128 + wq * 64 + j * 16 + fr;
      *(uint2*)(z + (size_t)m * 1792 + n) = uint2{pack2(acc[i][j][0], acc[i][j][1]), pack2(acc[i][j][2], acc[i][j][3])};
    }
}

DEVI void four1_tile(const Params& p, int t, unsigned char* smem) {
  TILE_IDS
  const int mt = t >> 3, grp = (t >> 1) & 3, half = t & 1;
  const bf16_t* P = (const bf16_t*)(p.ws + OFF_Z) + (size_t)mt * 128 * 1792 + 1280 + grp * 128;
  const bf16_t* Q = (const bf16_t*)(p.ws + OFF_DFT128) + (size_t)half * 128 * 128;
  f32x4 acc[4][4];
  zero_acc(acc);
  gemm_core2(P, 1792, Q, 128, 128, acc, smem);
  bf16_t* GT = (bf16_t*)(p.ws + OFF_GT);
  const int m0 = mt * 128;
  int L; bf16_t* gb; int lpos0;
  if (m0 < MCTX) { L = 256; gb = GT + (size_t)(m0 >> 8) * 512 * 512; lpos0 = m0 & 255; }
  else { L = 1024; gb = GT + (size_t)16 * 512 * 512 + (size_t)((m0 - MCTX) >> 10) * 512 * 2048; lpos0 = (m0 - MCTX) & 1023; }
#pragma unroll
  for (int i = 0; i < 4; ++i)
#pragma unroll
    for (int j = 0; j < 4; ++j) {
      const int lp = lpos0 + wp * 64 + i * 16 + 4 * fq;
      const int cp = wq * 64 + j * 16 + fr;
      *(uint2*)(gb + (size_t)(grp * 128 + cp) * (2 * L) + half * L + lp) =
          uint2{pack2(acc[i][j][0], acc[i][j][1]), pack2(acc[i][j][2], acc[i][j][3])};
    }
}

DEVI void four2_tile(const Params& p, int t, unsigned char* smem) {
  TILE_IDS
  const bf16_t* GT = (const bf16_t*)(p.ws + OFF_GT);
  const bf16_t *P, *Q; int K, mrow0, nt; float scale;
  if (t < 128) {
    const int b = t >> 3, pt = (t >> 2) & 1; nt = t & 3;
    P = GT + (size_t)b * 512 * 512 + (size_t)nt * 128 * 512;
    Q = (const bf16_t*)(p.ws + OFF_T256) + (size_t)pt * 128 * 512;
    K = 512; mrow0 = b * 256 + pt * 128; scale = 0.005524271728019903f;
  } else {
    t -= 128;
    const int b = t >> 5, pt = (t >> 2) & 7; nt = t & 3;
    P = GT + (size_t)16 * 512 * 512 + (size_t)b * 512 * 2048 + (size_t)nt * 128 * 2048;
    Q = (const bf16_t*)(p.ws + OFF_T1024) + (size_t)pt * 128 * 2048;
    K = 2048; mrow0 = MCTX + b * 1024 + pt * 128; scale = 0.0027621358640099515f;
  }
  f32x4 acc[4][4];
  zero_acc(acc);
  gemm_core2(P, K, Q, K, K, acc, smem);
  bf16_t* fo = (bf16_t*)(p.ws + OFF_FOUR);
#pragma unroll
  for (int i = 0; i < 4; ++i)
#pragma unroll
    for (int j = 0; j < 4; ++j) {
      const int n = nt * 128 + wp * 64 + i * 16 + 4 * fq, m = mrow0 + wq * 64 + j * 16 + fr;
      *(uint2*)(fo + (size_t)m * 512 + n) =
          uint2{pack2(acc[i][j][0] * scale, acc[i][j][1] * scale), pack2(acc[i][j][2] * scale, acc[i][j][3] * scale)};
    }
}

DEVI void glu_tile(const Params& p, int l, int t, unsigned char* smem) {
  TILE_IDS
  int mt, nt; grp_tile(t, 4, mt, nt);
  const bf16_t* P = (const bf16_t*)(p.ws + OFF_W) + (size_t)l * WL_TOT + WL_GLU + (size_t)nt * 128 * 512;
  const bf16_t* sp = (const bf16_t*)(p.ws + OFF_SSMP);
  const bf16_t* Q = sp + (size_t)mt * 128 * 512;
  f32x4 acc[4][4];
  zero_acc(acc);
  gemm_core2(P, 512, Q, 512, 512, acc, smem);
  bf16_t* sg = (bf16_t*)(p.ws + OFF_SSMG);
#pragma unroll
  for (int i = 0; i < 4; ++i)
#pragma unroll
    for (int j = 0; j < 4; ++j) {
      const int n = nt * 128 + wp * 64 + i * 16 + 4 * fq, m = mt * 128 + wq * 64 + j * 16 + fr;
      const float4 bg = *(const float4*)(p.in[21] + l * 512 + n);
      const uint2 yy = *(const uint2*)(sp + (size_t)m * 512 + n);
      const float y0 = bf2f(yy.x & 0xffff), y1 = bf2f(yy.x >> 16), y2 = bf2f(yy.y & 0xffff), y3 = bf2f(yy.y >> 16);
      *(uint2*)(sg + (size_t)m * 512 + n) =
          uint2{pack2(y0 * sigmoidf_(acc[i][j][0] + bg.x), y1 * sigmoidf_(acc[i][j][1] + bg.y)),
                pack2(y2 * sigmoidf_(acc[i][j][2] + bg.z), y3 * sigmoidf_(acc[i][j][3] + bg.w))};
      asm volatile("" ::: "memory");
    }
}

DEVI void merged_tile(const Params& p, int l, int t, unsigned char* smem) {
  TILE_IDS
  int mt, nt; grp_tile(t, 8, mt, nt);
  const bf16_t* wl = (const bf16_t*)(p.ws + OFF_W) + (size_t)l * WL_TOT;
  const bf16_t* u = (const bf16_t*)(p.ws + OFF_U) + (size_t)mt * 128 * 1024;
  bf16_t* mo = (bf16_t*)(p.ws + OFF_GT);
  bf16_t* sgt = (bf16_t*)(p.ws + OFF_QN);
#pragma unroll 1
  for (int br = 0; br < 3; ++br) {
    {
      f32x4 acc[4][4];
      zero_acc(acc);
      gemm_core2(wl + WL_IN + (size_t)(1792 + br * 1024 + nt * 128) * 1024, 1024, u, 1024, 1024, acc, smem);
#pragma unroll
      for (int i = 0; i < 4; ++i)
#pragma unroll
        for (int j = 0; j < 4; ++j) {
          const int n = nt * 128 + wp * 64 + i * 16 + 4 * fq, m = mt * 128 + wq * 64 + j * 16 + fr;
          *(uint2*)(sgt + (size_t)m * 1024 + n) =
              uint2{pack2(sigmoidf_(acc[i][j][0]), sigmoidf_(acc[i][j][1])), pack2(sigmoidf_(acc[i][j][2]), sigmoidf_(acc[i][j][3]))};
        }
    }
    {
      f32x4 acc[4][4];
      zero_acc(acc);
      const bf16_t* X = (const bf16_t*)(p.ws + OFF_ATT) + (size_t)br * M * 512 + (size_t)mt * 128 * 512;
      gemm_core2(wl + WL_BR + (size_t)br * 1024 * 512 + (size_t)nt * 128 * 512, 512, X, 512, 512, acc, smem);
#pragma unroll
      for (int i = 0; i < 4; ++i)
#pragma unroll
        for (int j = 0; j < 4; ++j) {
          const int n = nt * 128 + wp * 64 + i * 16 + 4 * fq, m = mt * 128 + wq * 64 + j * 16 + fr;
          uint2* dst = (uint2*)(mo + (size_t)m * 1024 + n);
          const uint2 sg = *(const uint2*)(sgt + (size_t)m * 1024 + n);
          float v0 = bf2f(sg.x & 0xffff) * acc[i][j][0];
          float v1 = bf2f(sg.x >> 16) * acc[i][j][1];
          float v2 = bf2f(sg.y & 0xffff) * acc[i][j][2];
          float v3 = bf2f(sg.y >> 16) * acc[i][j][3];
          if (br > 0) {
            const uint2 o = *dst;
            v0 += bf2f(o.x & 0xffff); v1 += bf2f(o.x >> 16); v2 += bf2f(o.y & 0xffff); v3 += bf2f(o.y >> 16);
          }
          *dst = uint2{pack2(v0, v1), pack2(v2, v3)};
          asm volatile("" ::: "memory");
        }
    }
  }
}

DEVI void resid_tile(const Params& p, int l, int t, int which, unsigned char* smem) {
  TILE_IDS
  int mt, nt; grp_tile(t, 8, mt, nt);
  const bf16_t* wl = (const bf16_t*)(p.ws + OFF_W) + (size_t)l * WL_TOT;
  f32x4 acc[4][4];
  zero_acc(acc);
  if (which == 0)
    gemm_core2(wl + WL_OUT + (size_t)nt * 128 * 1024, 1024, (const bf16_t*)(p.ws + OFF_GT) + (size_t)mt * 128 * 1024, 1024, 1024, acc, smem);
  else
    gemm_core2(wl + WL_DN + (size_t)nt * 128 * 2816, 2816, (const bf16_t*)(p.ws + OFF_HG) + (size_t)mt * 128 * 2816, 2816, 2816, acc, smem);
  const float* modl = (const float*)(p.ws + OFF_MOD) + (size_t)l * 9 * 6144 + (which == 0 ? 2048 : 5120);
  const bool from_in = (l == 0 && which == 0);
#pragma unroll
  for (int i = 0; i < 4; ++i)
#pragma unroll
    for (int j = 0; j < 4; ++j) {
      const int n = nt * 128 + wp * 64 + i * 16 + 4 * fq, m = mt * 128 + wq * 64 + j * 16 + fr;
      const float4 gg = *(const float4*)(modl + (size_t)modrow(m) * 6144 + n);
      float* dst = p.out + (size_t)m * 1024 + n;
      const float4 xv = from_in ? *(const float4*)(xin_row(p, m) + n) : *(const float4*)dst;
      *(float4*)dst = float4{ALPHA * xv.x + gg.x * acc[i][j][0], ALPHA * xv.y + gg.y * acc[i][j][1],
                             ALPHA * xv.z + gg.z * acc[i][j][2], ALPHA * xv.w + gg.w * acc[i][j][3]};
    }
}

DEVI void up_tile(const Params& p, int l, int t, unsigned char* smem) {
  TILE_IDS
  int mt, nt; grp_tile(t, 44, mt, nt);
  const bf16_t* P = (const bf16_t*)(p.ws + OFF_W) + (size_t)l * WL_TOT + WL_UP + (size_t)nt * 128 * 1024;
  const bf16_t* Q = (const bf16_t*)(p.ws + OFF_U) + (size_t)mt * 128 * 1024;
  f32x4 acc[4][4];
  zero_acc(acc);
  gemm_core2(P, 1024, Q, 1024, 1024, acc, smem);
  bf16_t* T = (bf16_t*)smem;
#pragma unroll
  for (int i = 0; i < 4; ++i)
#pragma unroll
    for (int j = 0; j < 4; ++j) {
      const int n = wp * 64 + i * 16 + 4 * fq, m = wq * 64 + j * 16 + fr;
      *(uint2*)(T + m * 136 + n) = uint2{pack2(acc[i][j][0], acc[i][j][1]), pack2(acc[i][j][2], acc[i][j][3])};
    }
  __syncthreads();
  {
    const int c = tid & 63, r0 = (tid >> 6) * 32;
    const int ca = nt * 64 + c, cb = 2816 + nt * 64 + c;
    const float* cw = p.in[29] + (size_t)l * 3 * 5632;
    const float* cbias = p.in[30] + (size_t)l * 5632;
    const float wa0 = cw[ca], wa1 = cw[5632 + ca], wa2 = cw[2 * 5632 + ca], ba = cbias[ca];
    const float wb0 = cw[cb], wb1 = cw[5632 + cb], wb2 = cw[2 * 5632 + cb], bb = cbias[cb];
    bf16_t* hg = (bf16_t*)(p.ws + OFF_HG) + (size_t)(mt * 128) * 2816 + nt * 64 + c;
    float pa = r0 > 0 ? bf2f(T[(r0 - 1) * 136 + c]) : 0.f, pb = r0 > 0 ? bf2f(T[(r0 - 1) * 136 + 64 + c]) : 0.f;
    float ca_ = bf2f(T[r0 * 136 + c]), cb_ = bf2f(T[r0 * 136 + 64 + c]);
    for (int r = r0; r < r0 + 32; ++r) {
      const float na = r < 127 ? bf2f(T[(r + 1) * 136 + c]) : 0.f, nb = r < 127 ? bf2f(T[(r + 1) * 136 + 64 + c]) : 0.f;
      if (r > 0 && r < 127) {
        const float ha = wa0 * pa + wa1 * ca_ + wa2 * na + ba;
        const float hb = wb0 * pb + wb1 * cb_ + wb2 * nb + bb;
        hg[(size_t)r * 2816] = f2bf(ha * sigmoidf_(ha) * hb);
      }
      pa = ca_; pb = cb_; ca_ = na; cb_ = nb;
    }
    bf16_t* edge = (bf16_t*)(p.ws + OFF_EDGE) + (size_t)mt * 4 * 5632;
    const int e = tid >> 6;
    const int er = e < 2 ? e : 124 + e;
    edge[(size_t)e * 5632 + ca] = T[er * 136 + c];
    edge[(size_t)e * 5632 + cb] = T[er * 136 + 64 + c];
  }
  __syncthreads();
}

DEVI void edge_item(const Params& p, int l, int idx) {
  const int mt = idx >> 1, bot = idx & 1;
  const int L = mt < 32 ? 256 : 1024;
  const int m = mt * 128 + (bot ? 127 : 0);
  const int mloc = mt < 32 ? m : m - MCTX;
  const int pos = mloc & (L - 1);
  const bf16_t* edge = (const bf16_t*)(p.ws + OFF_EDGE);
  const bf16_t *prev, *cur, *next;
  bool hasp, hasn;
  if (!bot) {
    hasp = pos != 0; hasn = true;
    prev = edge + ((size_t)(mt > 0 ? mt - 1 : 0) * 4 + 3) * 5632;
    cur = edge + ((size_t)mt * 4 + 0) * 5632;
    next = edge + ((size_t)mt * 4 + 1) * 5632;
  } else {
    hasp = true; hasn = pos != L - 1;
    prev = edge + ((size_t)mt * 4 + 2) * 5632;
    cur = edge + ((size_t)mt * 4 + 3) * 5632;
    next = edge + ((size_t)(mt < 95 ? mt + 1 : 95) * 4 + 0) * 5632;
  }
  const float* cw = p.in[29] + (size_t)l * 3 * 5632;
  const float* cbias = p.in[30] + (size_t)l * 5632;
  bf16_t* hg = (bf16_t*)(p.ws + OFF_HG) + (size_t)m * 2816;
  for (int c = opaque_tid(); c < 2816; c += 256) {
    const int cb = 2816 + c;
    const float pa = hasp ? bf2f(prev[c]) : 0.f, pb = hasp ? bf2f(prev[cb]) : 0.f;
    const float na = hasn ? bf2f(next[c]) : 0.f, nb = hasn ? bf2f(next[cb]) : 0.f;
    const float ha = cw[c] * pa + cw[5632 + c] * bf2f(cur[c]) + cw[2 * 5632 + c] * na + cbias[c];
    const float hb = cw[cb] * pb + cw[5632 + cb] * bf2f(cur[cb]) + cw[2 * 5632 + cb] * nb + cbias[cb];
    hg[c] = f2bf(ha * sigmoidf_(ha) * hb);
  }
}


#define XB_TMO      128
#define XB_XCNT(j)  (256  + 64 * (j))
#define XB_XSUB(j)  (1280 + 64 * (j))
#define XB_XGEN(j)  (2304 + 64 * (j))
#define XB_TOP      3328
#define XB_TOPGEN   3392
#define XCD_BAR_WORDS 3456
#define XB_SPIN_CAP (1u << 20)
#define LAS __attribute__((address_space(3)))
DEVI unsigned xb_ld(unsigned* p) { return __hip_atomic_load(p, __ATOMIC_RELAXED, __HIP_MEMORY_SCOPE_AGENT); }
DEVI unsigned xb_add(unsigned* p, unsigned v) { return __hip_atomic_fetch_add(p, v, __ATOMIC_RELAXED, __HIP_MEMORY_SCOPE_AGENT); }
DEVI unsigned xb_xcc_id() { return (unsigned)__builtin_amdgcn_s_getreg((3 << 11) | 20) & 0xFu; }
#define XB_SPIN(cond, bar) do { unsigned _sp = 0; while (cond) { __builtin_amdgcn_s_sleep(1); \
    if ((++_sp & 255u) == 0u) { if (xb_ld(&(bar)[XB_TMO])) break; if (_sp > XB_SPIN_CAP) { atomicAdd(&(bar)[XB_TMO], 1u); break; } } } } while (0)
struct XcdBarrier { unsigned* bar; unsigned x; volatile LAS unsigned* st; };
DEVI XcdBarrier xcd_barrier_post(unsigned* bar, volatile LAS unsigned* st) {
  XcdBarrier b; b.bar = bar; b.x = xb_xcc_id(); b.st = st;
  if (threadIdx.x == 0) (void)xb_add(&bar[XB_XCNT(b.x)], 1u);
  return b;
}
DEVI void xcd_barrier_complete(unsigned* bar, unsigned x, unsigned& nloc, unsigned& nx) {
  const unsigned G = gridDim.x * gridDim.y * gridDim.z;
  unsigned sum, cnt, mine, sp = 0u;
  for (;;) {
    sum = 0u; cnt = 0u; mine = 0u;
#pragma unroll
    for (unsigned j = 0; j < 16; ++j) { const unsigned c = xb_ld(&bar[XB_XCNT(j)]); sum += c; cnt += (c > 0u) ? 1u : 0u; mine = (j == x) ? c : mine; }
    if (sum == G) break;
    __builtin_amdgcn_s_sleep(1);
    if ((++sp & 255u) == 0u) { if (xb_ld(&bar[XB_TMO])) break; if (sp > XB_SPIN_CAP) { atomicAdd(&bar[XB_TMO], 1u); break; } }
  }
  nloc = mine > 0u ? mine : 1u; nx = cnt > 0u ? cnt : 1u;
}
DEVI void xcd_barrier(const XcdBarrier& b_) {
  asm volatile("s_waitcnt vmcnt(0)" ::: "memory");
  __syncthreads();
  if (threadIdx.x == 0) {
    XcdBarrier b = b_; b.x = xb_xcc_id();
    unsigned* bar = b.bar;
    __builtin_amdgcn_s_waitcnt(0);
    unsigned nloc = b.st[0], nx = b.st[1];
    if (nloc == 0u) { xcd_barrier_complete(bar, b.x, nloc, nx); b.st[0] = nloc; b.st[1] = nx; }
    const unsigned old = xb_add(&bar[XB_XSUB(b.x)], 1u);
    const unsigned gen = old / nloc;
    if (old + 1u == (gen + 1u) * nloc) {
      __builtin_amdgcn_fence(__ATOMIC_RELEASE, "agent");
      asm volatile("s_waitcnt vmcnt(0)" ::: "memory");
      const unsigned og = xb_add(&bar[XB_TOP], 1u);
      const unsigned tg = og / nx;
      if (og + 1u == (tg + 1u) * nx) xb_add(&bar[XB_TOPGEN], 1u);
      else XB_SPIN(xb_ld(&bar[XB_TOPGEN]) == tg, bar);
      __builtin_amdgcn_fence(__ATOMIC_ACQUIRE, "agent");
      xb_add(&bar[XB_XGEN(b.x)], 1u);
      asm volatile("s_waitcnt vmcnt(0)" ::: "memory");
    } else {
      XB_SPIN(xb_ld(&bar[XB_XGEN(b.x)]) == gen, bar);
      __builtin_amdgcn_fence(__ATOMIC_ACQUIRE, "agent");
      asm volatile("s_waitcnt vmcnt(0)" ::: "memory");
    }
  }
  __syncthreads();
}


DEVI int next_item(unsigned* ctr, volatile unsigned* slot) {
  __syncthreads();
  if (threadIdx.x == 0) *slot = __hip_atomic_fetch_add(ctr, 1u, __ATOMIC_RELAXED, __HIP_MEMORY_SCOPE_AGENT);
  __syncthreads();
  return (int)*slot;
}
#define FOR_QUEUE(idx, T, q) for (int idx = next_item((unsigned*)(p.ws + OFF_CTR) + 64 * (q), qslot); idx < (T); idx = next_item((unsigned*)(p.ws + OFF_CTR) + 64 * (q), qslot))

#define FOR_ITEMS(idx, T) for (int idx = (bid & 7) * (G >> 3) + (bid >> 3); idx < (T); idx += G)

__global__ void __launch_bounds__(256, 3) trunk_megakernel(Params p) {
  cg::grid_group grid = cg::this_grid();
  __shared__ __attribute__((aligned(16))) unsigned char smem_all[49152 + 16];
  unsigned char* smem = smem_all;
  const int G = gridDim.x, bid = blockIdx.x;
  if (threadIdx.x == 0) *(uint4*)(smem_all + 49152) = uint4{0u, 0u, 0u, 0u};
  __syncthreads();
  volatile unsigned* qslot = (volatile unsigned*)(smem_all + 49152 + 8);
  const XcdBarrier xb = xcd_barrier_post((unsigned*)(p.ws + OFF_BAR), (volatile LAS unsigned*)(smem_all + 49152));
  if (p.ws == nullptr) grid.sync();

  FOR_QUEUE(i, 64 + 192 + 2016 + 560, 0) {
    if (i < 64) ssm_pre_item(p, i, smem);
    else if (i < 256) mod_item(p, i - 64, smem);
    else if (i < 256 + 2016) { for (int k = 0; k < 4; ++k) weights_item(p, (i - 256) * 4 + k, smem); }
    else table_item(p, i - 256 - 2016);
  }
  xcd_barrier(xb);
  for (int r = bid * 4 + (opaque_tid() >> 6); r < M; r += G * 4) modulate0_row(p, r);
  xcd_barrier(xb);

  for (int l = 0; l < 2; ++l) {
    RP(1) FOR_ITEMS(t, 96 * 14) z_tile(p, l, t, smem);
    xcd_barrier(xb);
    FOR_QUEUE(i, 384 + 1024 + 768, 1 + 2 * l) {
      if (i < 384) ssm_item(p, l, i, smem);
      else if (i < 384 + 1024) { for (int k = 0; k < 4; ++k) prep_token(p, l, (i - 384) * 16 + k * 4 + (opaque_tid() >> 6)); }
      else four1_tile(p, i - 1408, smem);
    }
    xcd_barrier(xb);
    FOR_QUEUE(i, 1536, 2 + 2 * l) {
      if (i < 512) attn_item(p, i, smem);
      else if (i < 768) four2_tile(p, 128 + (i - 512), smem);
      else if (i < 1152) glu_tile(p, l, i - 768, smem);
      else if (i < 1280) four2_tile(p, i - 1152, smem);
      else attn_item(p, 512 + (i - 1280), smem);
    }
    xcd_barrier(xb);
    RP(4) FOR_ITEMS(t, 768) merged_tile(p, l, t, smem);
    xcd_barrier(xb);
    FOR_ITEMS(t, 768) resid_tile(p, l, t, 0, smem);
    xcd_barrier(xb);
    {
      const float* modl = (const float*)(p.ws + OFF_MOD) + (size_t)l * 9 * 6144;
      for (int r = bid * 4 + (opaque_tid() >> 6); r < M; r += G * 4) ln_row(p, r, p.in[26] + l * 1024, p.in[27] + l * 1024, modl, 3072, 4096, true);
    }
    xcd_barrier(xb);
    RP(7) FOR_ITEMS(t, 96 * 44) up_tile(p, l, t, smem);
    xcd_barrier(xb);
    RP(8) for (int i = bid; i < 192; i += G) edge_item(p, l, i);
    xcd_barrier(xb);
    FOR_ITEMS(t, 768) resid_tile(p, l, t, 1, smem);
    xcd_barrier(xb);
    {
      const float* modn = (const float*)(p.ws + OFF_MOD) + (size_t)(l + 1 < 2 ? l + 1 : l) * 9 * 6144;
      for (int r = bid * 4 + (opaque_tid() >> 6); r < M; r += G * 4) ln_row(p, r, p.in[32] + l * 1024, p.in[33] + l * 1024, modn, 0, 1024, l == 0);
    }
    if (l == 0) xcd_barrier(xb);
    for (int rep_ = 0; rep_ < (PROBE_PHASE == 20 ? 1 : 0); ++rep_) { xcd_barrier(xb); xcd_barrier(xb); xcd_barrier(xb); xcd_barrier(xb); xcd_barrier(xb); }
  }
}

extern "C" void kernel_launch(void* const* d_in, const int* in_sizes, int n_in,
                              void* d_out, int out_size, void* d_ws, size_t ws_size,
                              hipStream_t stream) {
  static int grid_blocks = 0;
  if (!grid_blocks) {
    int dev = 0, cus = 0, per_cu = 0;
    (void)hipGetDevice(&dev);
    (void)hipDeviceGetAttribute(&cus, hipDeviceAttributeMultiprocessorCount, dev);
    (void)hipOccupancyMaxActiveBlocksPerMultiprocessor(&per_cu, trunk_megakernel, 256, 0);
    if (per_cu < 1) per_cu = 1;
    grid_blocks = cus * per_cu;
  }
  Params p{};
  for (int i = 0; i < 34; ++i) p.in[i] = (const float*)d_in[i];
  p.out = (float*)d_out;
  p.ws = (unsigned char*)d_ws;
  (void)hipMemsetAsync((unsigned char*)d_ws + OFF_BAR, 0, 16384 + 2048, stream);
  void* args[] = {&p};
  hipError_t e = hipLaunchCooperativeKernel((void*)trunk_megakernel, dim3(grid_blocks), dim3(256), args, 0, stream);
  if (e != hipSuccess) fprintf(stderr, "cooperative launch failed: %s (grid %d)\n", hipGetErrorString(e), grid_blocks);
}
```

```cpp
#include <hip/hip_runtime.h>
#include <hip/hip_cooperative_groups.h>
#include <cstdio>
#include <cstdint>
namespace cg = cooperative_groups;

typedef unsigned short bf16_t;
using bf16x8 = __attribute__((ext_vector_type(8))) short;
using f32x4 = __attribute__((ext_vector_type(4))) float;

#define DEVI __device__ __forceinline__

#ifndef PROBE_PHASE
#define PROBE_PHASE -1
#endif
#define RP(n) for (int rep_ = 0; rep_ < ((n) == PROBE_PHASE ? 2 : 1); ++rep_)
#ifndef REP_P0
#define REP_P0 1
#endif
#ifndef REP_L2
#define REP_L2 1
#endif
#ifndef REP_L3
#define REP_L3 1
#endif
#ifndef REP_L7
#define REP_L7 1
#endif
#ifndef REP_SYNC
#define REP_SYNC 0
#endif
constexpr int M = 12288;
constexpr int MCTX = 4096;
constexpr float ALPHA = 1.41421356237f;
constexpr float LN_EPS = 1e-6f;

constexpr size_t WL_IN = 0;
constexpr size_t WL_GLU = WL_IN + (size_t)4864 * 1024;
constexpr size_t WL_BR = WL_GLU + (size_t)512 * 512;
constexpr size_t WL_OUT = WL_BR + (size_t)3 * 1024 * 512;
constexpr size_t WL_UP = WL_OUT + (size_t)1024 * 1024;
constexpr size_t WL_DN = WL_UP + (size_t)5632 * 1024;
constexpr size_t WL_TOT = WL_DN + (size_t)1024 * 2816;
constexpr size_t OFF_W = 0;
constexpr size_t SSM_EL = 196608;
constexpr size_t OFF_SSM = OFF_W + 2 * WL_TOT * 2;
constexpr size_t OFF_LAM16 = OFF_SSM + 64 * SSM_EL * 2;
constexpr size_t OFF_T1024 = OFF_LAM16 + 2 * 2 * 32 * 64 * 8;
constexpr size_t OFF_T256 = OFF_T1024 + (size_t)1024 * 2048 * 2;
constexpr size_t OFF_DFT128 = OFF_T256 + (size_t)256 * 512 * 2;
constexpr size_t OFF_ROPE = OFF_DFT128 + (size_t)256 * 128 * 2;
constexpr size_t OFF_MOD = OFF_ROPE + (size_t)1024 * 32 * 8;
constexpr size_t OFF_U = OFF_MOD + (size_t)2 * 9 * 6144 * 4;
constexpr size_t OFF_R = OFF_U + (size_t)M * 1024 * 2;
constexpr size_t OFF_Z = OFF_R;
constexpr size_t OFF_ATT = OFF_R;
constexpr size_t OFF_SSMG = OFF_R + (size_t)M * 512 * 2;
constexpr size_t OFF_FOUR = OFF_R + (size_t)2 * M * 512 * 2;
constexpr size_t OFF_QN = OFF_Z + (size_t)M * 1792 * 2;
constexpr size_t OFF_KD = OFF_QN + (size_t)M * 512 * 2;
constexpr size_t OFF_VTD = OFF_KD + (size_t)16 * 1536 * 64 * 2;
constexpr size_t OFF_KC = OFF_VTD + (size_t)16 * 1536 * 64 * 2;
constexpr size_t OFF_VTC = OFF_KC + (size_t)32 * 256 * 64 * 2;
constexpr size_t OFF_SSMP = OFF_VTC + (size_t)32 * 256 * 64 * 2;
constexpr size_t OFF_GT = OFF_SSMP + (size_t)M * 512 * 2;
constexpr size_t OFF_HG = OFF_R;
constexpr size_t OFF_EDGE = OFF_HG + (size_t)M * 2816 * 2;
constexpr size_t OFF_BAR = OFF_GT + (size_t)M * 1024 * 2;
constexpr size_t OFF_CTR = OFF_BAR + 16384;
constexpr size_t WS_NEEDED = OFF_BAR + 16384 + 16384;

constexpr size_t OUT_CK = (size_t)M * 1024;
constexpr size_t OUT_CV = OUT_CK + (size_t)16 * 2 * 256 * 128;
constexpr size_t OUT_ST = OUT_CV + (size_t)16 * 2 * 256 * 128;

struct Params {
  const float* in[34];
  float* out;
  unsigned char* ws;
};

DEVI int opaque_tid() {
  int t = threadIdx.x;
  asm volatile("" : "+v"(t));
  return t;
}
DEVI unsigned short f2bf(float f) {
  unsigned u = __float_as_uint(f);
  u += 0x7fffu + ((u >> 16) & 1u);
  return (unsigned short)(u >> 16);
}
DEVI float bf2f(unsigned short h) { return __uint_as_float(((unsigned)h) << 16); }
DEVI unsigned pack2(float a, float b) {
  typedef float f2_t __attribute__((ext_vector_type(2)));
  typedef __bf16 b2_t __attribute__((ext_vector_type(2)));
  const f2_t v = {a, b};
  const b2_t r = __builtin_convertvector(v, b2_t);
  return __builtin_bit_cast(unsigned, r);
}
DEVI float sigmoidf_(float x) { return 1.0f / (1.0f + __expf(-x)); }
DEVI float gelu_tanh(float x) {
  float y = 0.7978845608028654f * (x + 0.044715f * x * x * x);
  float t = 1.0f - 2.0f / (1.0f + __expf(2.0f * y));
  return 0.5f * x * (1.0f + t);
}
DEVI void grp_tile(int idx, int NT, int& mt, int& nt) {
  const int gsz = 8 * NT, gid = idx / gsz, rem = idx - gid * gsz;
  mt = gid * 8 + (rem & 7); nt = rem >> 3;
}
DEVI int modrow(int m) { return m < MCTX ? 0 : 1 + ((m - MCTX) >> 10); }

DEVI void gemm_core2(const bf16_t* P, int ldp, const bf16_t* Q, int ldq, int K, f32x4 (&acc)[4][4],
                     unsigned char* smem) {
  const int tid = opaque_tid(), lane = tid & 63, wave = tid >> 6, wp = wave >> 1, wq = wave & 1;
  const int fr = lane & 15, fq = lane >> 4;
  const int lrow = lane >> 2;
  const int lchunk = (lane & 3) ^ ((0x78 >> (2 * ((lrow >> 2) & 3))) & 3);
  const bf16_t* gp = P + (size_t)(wave * 32 + lrow) * ldp + lchunk * 8;
  const bf16_t* gq = Q + (size_t)(wave * 32 + lrow) * ldq + lchunk * 8;
  const size_t p16 = (size_t)16 * ldp, q16 = (size_t)16 * ldq;
  unsigned char* lds_w = smem + wave * 2048;
  const int rslot = (fq ^ ((0x78 >> (2 * ((fr >> 2) & 3))) & 3)) << 4;
  const int poff = (wp * 64 + fr) * 64 + rslot;
  const int qoff = 8192 + (wq * 64 + fr) * 64 + rslot;
  const int nk = K >> 5;
#define GLDS_STAGE(kt_, st_) do { \
    const size_t ko_ = (size_t)(kt_) * 32; \
    __builtin_amdgcn_global_load_lds((const unsigned*)(gp + ko_), (unsigned*)(lds_w + (st_)), 16, 0, 0); \
    __builtin_amdgcn_global_load_lds((const unsigned*)(gp + ko_ + p16), (unsigned*)(lds_w + (st_) + 1024), 16, 0, 0); \
    __builtin_amdgcn_global_load_lds((const unsigned*)(gq + ko_), (unsigned*)(lds_w + (st_) + 8192), 16, 0, 0); \
    __builtin_amdgcn_global_load_lds((const unsigned*)(gq + ko_ + q16), (unsigned*)(lds_w + (st_) + 8192 + 1024), 16, 0, 0); \
  } while (0)
  GLDS_STAGE(0, 0); GLDS_STAGE(1, 16384);
  asm volatile("s_waitcnt vmcnt(4)" ::: "memory");
  __builtin_amdgcn_s_barrier();
  int cur = 0, nxt = 32768;
#pragma unroll 1
  for (int kt = 0; kt < nk; ++kt) {
    asm volatile("s_waitcnt vmcnt(0)" ::: "memory");
    __builtin_amdgcn_s_barrier();
    if (kt + 2 < nk) GLDS_STAGE(kt + 2, nxt);
    bf16x8 a[4], b[4];
#pragma unroll
    for (int i = 0; i < 4; ++i) a[i] = *(const bf16x8*)(smem + cur + poff + i * 1024);
#pragma unroll
    for (int j = 0; j < 4; ++j) b[j] = *(const bf16x8*)(smem + cur + qoff + j * 1024);
#pragma unroll
    for (int i = 0; i < 4; ++i)
#pragma unroll
      for (int j = 0; j < 4; ++j)
        acc[i][j] = __builtin_amdgcn_mfma_f32_16x16x32_bf16(a[i], b[j], acc[i][j], 0, 0, 0);
    cur = (cur == 32768) ? 0 : cur + 16384;
    nxt = (nxt == 32768) ? 0 : nxt + 16384;
  }
#undef GLDS_STAGE
  __syncthreads();
}

DEVI void zero_acc(f32x4 (&acc)[4][4]) {
#pragma unroll
  for (int i = 0; i < 4; ++i)
#pragma unroll
    for (int j = 0; j < 4; ++j) acc[i][j] = f32x4{0.f, 0.f, 0.f, 0.f};
}

DEVI void transpose_tile(const float* W, int K, int N, bf16_t* WT, int kt, int nt, int mode, unsigned char* smem) {
  float* t = (float*)smem;
  const int tid = opaque_tid();
  {
    const int r = tid >> 4, c4 = tid & 15;
#pragma unroll
    for (int it = 0; it < 4; ++it) {
      const f32x4 v = __builtin_nontemporal_load((const f32x4*)(W + (size_t)(kt * 64 + r + 16 * it) * N + nt * 64 + c4 * 4));
      float* d = t + (r + 16 * it) * 65 + c4 * 4;
      d[0] = v[0]; d[1] = v[1]; d[2] = v[2]; d[3] = v[3];
    }
  }
  __syncthreads();
  {
    const int n = tid >> 2, kq = tid & 3;
    unsigned w[8];
#pragma unroll
    for (int e = 0; e < 8; ++e) w[e] = pack2(t[(kq * 16 + 2 * e) * 65 + n], t[(kq * 16 + 2 * e + 1) * 65 + n]);
    int c = nt * 64 + n, row = c;
    if (mode == 1) {
      int half = c >= 2816 ? 1 : 0;
      int cc = c - half * 2816;
      row = (cc >> 6) * 128 + half * 64 + (cc & 63);
    }
    uint4* dst = (uint4*)(WT + (size_t)row * K + kt * 64 + kq * 16);
    dst[0] = uint4{w[0], w[1], w[2], w[3]};
    dst[1] = uint4{w[4], w[5], w[6], w[7]};
  }
  __syncthreads();
}

DEVI void weights_item(const Params& p, int idx, unsigned char* smem) {
  const int l = idx / 4032;
  int t = idx - l * 4032;
  bf16_t* wl = (bf16_t*)(p.ws + OFF_W) + (size_t)l * WL_TOT;
  if (t < 1216) { transpose_tile(p.in[9] + (size_t)l * 1024 * 4864, 1024, 4864, wl + WL_IN, t / 76, t % 76, 0, smem); return; }
  t -= 1216;
  if (t < 64) { transpose_tile(p.in[20] + (size_t)l * 512 * 512, 512, 512, wl + WL_GLU, t / 8, t % 8, 0, smem); return; }
  t -= 64;
  if (t < 384) {
    const int br = t / 128; t -= br * 128;
    transpose_tile(p.in[22 + br] + (size_t)l * 512 * 1024, 512, 1024, wl + WL_BR + (size_t)br * 1024 * 512, t / 16, t % 16, 0, smem);
    return;
  }
  t -= 384;
  if (t < 256) { transpose_tile(p.in[25] + (size_t)l * 1024 * 1024, 1024, 1024, wl + WL_OUT, t / 16, t % 16, 0, smem); return; }
  t -= 256;
  if (t < 1408) { transpose_tile(p.in[28] + (size_t)l * 1024 * 5632, 1024, 5632, wl + WL_UP, t / 88, t % 88, 1, smem); return; }
  t -= 1408;
  transpose_tile(p.in[31] + (size_t)l * 2816 * 1024, 2816, 1024, wl + WL_DN, t / 16, t % 16, 0, smem);
}

DEVI void mod_item(const Params& p, int idx, unsigned char* smem) {
  const int l = idx / 96, nt = idx % 96;
  float* sc = (float*)smem;
  float* red = (float*)(smem + 36864);
  const int tid = opaque_tid();
  for (int e = tid; e < 9 * 1024; e += 256) {
    const int r = e >> 10, k = e & 1023;
    const float v = (r == 0) ? p.in[6][k] : p.in[2][(r - 1) * 1024 + k];
    sc[e] = v * sigmoidf_(v);
  }
  __syncthreads();
  const int kq = tid >> 6, col = tid & 63;
  const float* w = p.in[7] + (size_t)l * 1024 * 6144 + (size_t)(kq * 256) * 6144 + nt * 64 + col;
  float acc[9];
#pragma unroll
  for (int r = 0; r < 9; ++r) acc[r] = 0.f;
  for (int k0 = 0; k0 < 256; k0 += 8) {
    float wv[8];
#pragma unroll
    for (int e = 0; e < 8; ++e) wv[e] = __builtin_nontemporal_load(w + (size_t)(k0 + e) * 6144);
#pragma unroll
    for (int e = 0; e < 8; ++e)
#pragma unroll
      for (int r = 0; r < 9; ++r) acc[r] += sc[r * 1024 + kq * 256 + k0 + e] * wv[e];
  }
#pragma unroll
  for (int r = 0; r < 9; ++r) red[(kq * 9 + r) * 64 + col] = acc[r];
  __syncthreads();
  float* mod = (float*)(p.ws + OFF_MOD) + (size_t)l * 9 * 6144;
  for (int e = tid; e < 9 * 64; e += 256) {
    const int r = e >> 6, c = e & 63;
    float s = red[(0 * 9 + r) * 64 + c] + red[(1 * 9 + r) * 64 + c] + red[(2 * 9 + r) * 64 + c] + red[(3 * 9 + r) * 64 + c];
    mod[r * 6144 + nt * 64 + c] = s + p.in[8][l * 6144 + nt * 64 + c];
  }
  __syncthreads();
}

DEVI void ssm_pre_item(const Params& p, int idx, unsigned char* smem) {
  const int l = idx >> 5, g = idx & 31;
  const int tid = opaque_tid();
  float2* Lpow = (float2*)smem;
  float2* Bbar = (float2*)(smem + 8704);
  float* Kc = (float*)(smem + 8704 + 8192);
  const float* a_re = p.in[12]; const float* a_im = p.in[13]; const float* log_dt = p.in[14];
  const float* b_re = p.in[15]; const float* b_im = p.in[16]; const float* c_re = p.in[17]; const float* c_im = p.in[18];
  bf16_t* AC = (bf16_t*)(p.ws + OFF_SSM) + (size_t)idx * SSM_EL;
  bf16_t* W1 = AC + 256 * 512;
#pragma unroll 1
  for (int dir = 0; dir < 2; ++dir) {
    const float dt = expf(log_dt[(l * 2 + dir) * 32 + g]);
    for (int e = tid; e < 17 * 64; e += 256) {
      const int tau = e >> 6, pp = e & 63;
      const int ai = ((l * 2 + dir) * 32 + g) * 64 + pp;
      const float mag = expf(a_re[ai] * dt * (float)tau);
      const float ang = a_im[ai] * dt * (float)tau;
      float sn, cs; sincosf(ang, &sn, &cs);
      Lpow[e] = float2{mag * cs, mag * sn};
      if (tau == 16) ((float2*)(p.ws + OFF_LAM16))[ai] = float2{mag * cs, mag * sn};
    }
    for (int e = tid; e < 64 * 16; e += 256) {
      const int pp = e >> 4, n = e & 15;
      const int ai = ((l * 2 + dir) * 32 + g) * 64 + pp;
      const float ar = a_re[ai], aim = a_im[ai];
      const float mag = expf(ar * dt);
      float sn, cs; sincosf(aim * dt, &sn, &cs);
      const float nr = mag * cs - 1.0f, ni = mag * sn;
      const float den = ar * ar + aim * aim;
      const float fr_ = (nr * ar + ni * aim) / den, fi_ = (ni * ar - nr * aim) / den;
      const float br = b_re[(size_t)ai * 16 + n], bi = b_im[(size_t)ai * 16 + n];
      Bbar[e] = float2{fr_ * br - fi_ * bi, fr_ * bi + fi_ * br};
    }
    __syncthreads();
    {
      const int tau = tid >> 4, n = tid & 15;
      float acc[16];
#pragma unroll
      for (int m = 0; m < 16; ++m) acc[m] = 0.f;
      const size_t cbase = ((size_t)((l * 2 + dir) * 32 + g) * 16 + n) * 64;
#pragma unroll 1
      for (int p8 = 0; p8 < 64; p8 += 8) {
        const float4 cr0 = *(const float4*)(c_re + cbase + p8), cr1 = *(const float4*)(c_re + cbase + p8 + 4);
        const float4 ci0 = *(const float4*)(c_im + cbase + p8), ci1 = *(const float4*)(c_im + cbase + p8 + 4);
        const float crv[8] = {cr0.x, cr0.y, cr0.z, cr0.w, cr1.x, cr1.y, cr1.z, cr1.w};
        const float civ[8] = {ci0.x, ci0.y, ci0.z, ci0.w, ci1.x, ci1.y, ci1.z, ci1.w};
#pragma unroll
        for (int e = 0; e < 8; ++e) {
          const int pp = p8 + e;
          const float2 lp = Lpow[tau * 64 + pp];
          const float gr = crv[e] * lp.x - civ[e] * lp.y, gi = crv[e] * lp.y + civ[e] * lp.x;
#pragma unroll
          for (int m = 0; m < 16; ++m) {
            const float2 bb = Bbar[pp * 16 + m];
            acc[m] += gr * bb.x - gi * bb.y;
          }
        }
      }
      const int delta = dir == 0 ? 15 - tau : 15 + tau;
#pragma unroll
      for (int m = 0; m < 16; ++m) {
        if (dir == 1 && tau == 0) Kc[(delta * 16 + n) * 16 + m] += acc[m];
        else Kc[(delta * 16 + n) * 16 + m] = acc[m];
      }
    }
    {
      const int n = tid >> 4, pg = tid & 15, p0 = pg * 4, kc = 32 + dir * 16 + pg;
      const size_t cbase = ((size_t)((l * 2 + dir) * 32 + g) * 16 + n) * 64;
      const float4 cr4 = *(const float4*)(c_re + cbase + p0), ci4 = *(const float4*)(c_im + cbase + p0);
      const float crv[4] = {cr4.x, cr4.y, cr4.z, cr4.w}, civ[4] = {ci4.x, ci4.y, ci4.z, ci4.w};
#pragma unroll 1
      for (int t = 0; t < 16; ++t) {
        const int tau = dir == 0 ? t + 1 : 16 - t;
        float val[8];
#pragma unroll
        for (int e = 0; e < 4; ++e) {
          const float2 lp = Lpow[tau * 64 + p0 + e];
          val[2 * e] = crv[e] * lp.x - civ[e] * lp.y;
          val[2 * e + 1] = -(crv[e] * lp.y + civ[e] * lp.x);
        }
        *(uint4*)(AC + (size_t)(t * 16 + n) * 512 + kc * 8) =
            uint4{pack2(val[0], val[1]), pack2(val[2], val[3]), pack2(val[4], val[5]), pack2(val[6], val[7])};
      }
    }
    for (int v = tid; v < 128 * 32; v += 256) {
      const int rl = v >> 5, kc = v & 31;
      const int pp = rl >> 1, ri = rl & 1;
      const int sidx = kc >> 1, m0 = (kc & 1) * 8;
      const float2 lp = Lpow[(dir == 0 ? 15 - sidx : sidx) * 64 + pp];
      float val[8];
#pragma unroll
      for (int e = 0; e < 8; ++e) {
        const float2 bb = Bbar[pp * 16 + m0 + e];
        val[e] = ri == 0 ? (lp.x * bb.x - lp.y * bb.y) : (lp.x * bb.y + lp.y * bb.x);
      }
      *(uint4*)(W1 + (size_t)(dir * 128 + rl) * 256 + kc * 8) =
          uint4{pack2(val[0], val[1]), pack2(val[2], val[3]), pack2(val[4], val[5]), pack2(val[6], val[7])};
    }
    __syncthreads();
  }
  for (int v = tid; v < 256 * 32; v += 256) {
    const int row = v >> 5, kc = v & 31;
    const int t = row >> 4, n = row & 15;
    const int sidx = kc >> 1, m0 = (kc & 1) * 8;
    const int delta = sidx - t + 15;
    float val[8];
#pragma unroll
    for (int e = 0; e < 8; ++e) val[e] = Kc[(delta * 16 + n) * 16 + m0 + e];
    *(uint4*)(AC + (size_t)row * 512 + kc * 8) =
        uint4{pack2(val[0], val[1]), pack2(val[2], val[3]), pack2(val[4], val[5]), pack2(val[6], val[7])};
  }
  __syncthreads();
}

DEVI void table_item(const Params& p, int idx) {
  const int tid = opaque_tid();
  if (idx < 512) {
    bf16_t* T = (bf16_t*)(p.ws + OFF_T1024);
    for (int e = tid; e < 4096; e += 256) {
      const int g = idx * 4096 + e, k = g >> 11, kk = g & 2047;
      const int ph = (k * (kk & 1023)) & 1023;
      float s, c; sincospif((float)ph * (2.0f / 1024.0f), &s, &c);
      T[g] = f2bf(kk < 1024 ? c : -s);
    }
    return;
  }
  idx -= 512;
  if (idx < 32) {
    bf16_t* T = (bf16_t*)(p.ws + OFF_T256);
    for (int e = tid; e < 4096; e += 256) {
      const int g = idx * 4096 + e, k = g >> 9, kk = g & 511;
      const int ph = (k * (kk & 255)) & 255;
      float s, c; sincospif((float)ph * (2.0f / 256.0f), &s, &c);
      T[g] = f2bf(kk < 256 ? c : -s);
    }
    return;
  }
  idx -= 32;
  if (idx < 8) {
    bf16_t* T = (bf16_t*)(p.ws + OFF_DFT128);
    for (int e = tid; e < 4096; e += 256) {
      const int g = idx * 4096 + e, n1 = g >> 7, c_ = g & 127;
      const int ph = (c_ * (n1 & 127)) & 127;
      float s, c; sincospif((float)ph * (2.0f / 128.0f), &s, &c);
      T[g] = f2bf(n1 < 128 ? c : s);
    }
    return;
  }
  idx -= 8;
  {
    float2* T = (float2*)(p.ws + OFF_ROPE);
    for (int e = tid; e < 4096; e += 256) {
      const int g = idx * 4096 + e, t = g >> 5, i = g & 31;
      const float pos = (i < 16) ? (float)(t >> 6) : (float)(t & 63);
      const float fr_ = powf(10000.0f, -(float)(i & 15) / 16.0f);
      float s, c; sincosf(pos * fr_, &s, &c);
      T[g] = float2{c, s};
    }
  }
}

DEVI const float* xin_row(const Params& p, int m) {
  return m < MCTX ? p.in[0] + (size_t)m * 1024 : p.in[1] + (size_t)(m - MCTX) * 1024;
}

DEVI void modulate0_row(const Params& p, int m) {
  const int lane = opaque_tid() & 63;
  const float* x = xin_row(p, m);
  const float* mod = (const float*)(p.ws + OFF_MOD) + (size_t)modrow(m) * 6144;
  bf16_t* u = (bf16_t*)(p.ws + OFF_U) + (size_t)m * 1024;
#pragma unroll
  for (int k = 0; k < 4; ++k) {
    const int c = lane * 4 + 256 * k;
    const f32x4 vn = __builtin_nontemporal_load((const f32x4*)(x + c));
    const float4 v = float4{vn[0], vn[1], vn[2], vn[3]};
    const float4 sh = *(const float4*)(mod + c);
    const float4 sc = *(const float4*)(mod + 1024 + c);
    uint2 o;
    o.x = pack2(v.x * (1.f + sc.x) + sh.x, v.y * (1.f + sc.y) + sh.y);
    o.y = pack2(v.z * (1.f + sc.z) + sh.z, v.w * (1.f + sc.w) + sh.w);
    *(uint2*)(u + c) = o;
  }
}

DEVI void ln_row(const Params& p, int m, const float* g, const float* b, const float* modl, int sh_off, int sc_off, bool write_u) {
  const int lane = opaque_tid() & 63;
  float* x = p.out + (size_t)m * 1024;
  float4 v[4];
  float s = 0.f;
#pragma unroll
  for (int k = 0; k < 4; ++k) {
    v[k] = *(const float4*)(x + lane * 4 + 256 * k);
    s += v[k].x + v[k].y + v[k].z + v[k].w;
  }
#pragma unroll
  for (int o = 32; o >= 1; o >>= 1) s += __shfl_xor(s, o);
  const float mu = s * (1.0f / 1024.0f);
  float q = 0.f;
#pragma unroll
  for (int k = 0; k < 4; ++k) {
    v[k].x -= mu; v[k].y -= mu; v[k].z -= mu; v[k].w -= mu;
    q += v[k].x * v[k].x + v[k].y * v[k].y + v[k].z * v[k].z + v[k].w * v[k].w;
  }
#pragma unroll
  for (int o = 32; o >= 1; o >>= 1) q += __shfl_xor(q, o);
  const float rs = rsqrtf(q * (1.0f / 1024.0f) + LN_EPS);
  const float* mod = modl + (size_t)modrow(m) * 6144;
  bf16_t* u = (bf16_t*)(p.ws + OFF_U) + (size_t)m * 1024;
#pragma unroll
  for (int k = 0; k < 4; ++k) {
    const int c = lane * 4 + 256 * k;
    const float4 gg = *(const float4*)(g + c);
    const float4 bb = *(const float4*)(b + c);
    float4 y;
    y.x = v[k].x * rs * gg.x + bb.x; y.y = v[k].y * rs * gg.y + bb.y;
    y.z = v[k].z * rs * gg.z + bb.z; y.w = v[k].w * rs * gg.w + bb.w;
    *(float4*)(x + c) = y;
    if (write_u) {
      const float4 sh = *(const float4*)(mod + sh_off + c);
      const float4 sc = *(const float4*)(mod + sc_off + c);
      uint2 o;
      o.x = pack2(y.x * (1.f + sc.x) + sh.x, y.y * (1.f + sc.y) + sh.y);
      o.y = pack2(y.z * (1.f + sc.z) + sh.z, y.w * (1.f + sc.w) + sh.w);
      *(uint2*)(u + c) = o;
    }
  }
}

DEVI void prep_token(const Params& p, int l, int tok) {
  const int lane = opaque_tid() & 63;
  bf16_t* Kd = (bf16_t*)(p.ws + OFF_KD); bf16_t* VTd = (bf16_t*)(p.ws + OFF_VTD);
  bf16_t* Kc = (bf16_t*)(p.ws + OFF_KC); bf16_t* VTc = (bf16_t*)(p.ws + OFF_VTC);
  if (tok >= M) {
    const int b = (tok - M) >> 9, j = (tok - M) & 511;
    if (lane < 32) {
      const int li = lane & 15, hk = li >> 3, d0 = (li & 7) * 8;
      const float* src = (lane < 16 ? p.in[3] : p.in[4]) + ((size_t)((b * 2 + l) * 512 + j)) * 128 + li * 8;
      const f32x4 v0 = __builtin_nontemporal_load((const f32x4*)src), v1 = __builtin_nontemporal_load((const f32x4*)(src + 4));
      const float vv[8] = {v0[0], v0[1], v0[2], v0[3], v1[0], v1[1], v1[2], v1[3]};
      if (lane < 16) {
        *(uint4*)(Kd + ((size_t)(b * 2 + hk) * 1536 + 1024 + j) * 64 + d0) =
            uint4{pack2(vv[0], vv[1]), pack2(vv[2], vv[3]), pack2(vv[4], vv[5]), pack2(vv[6], vv[7])};
      } else {
#pragma unroll
        for (int e = 0; e < 8; ++e) VTd[((size_t)(b * 2 + hk) * 64 + d0 + e) * 1536 + 1024 + j] = f2bf(vv[e]);
      }
    }
    return;
  }
  const int m = tok;
  const bool dec = m >= MCTX;
  const int b = dec ? (m - MCTX) >> 10 : m >> 8;
  const int t = dec ? (m - MCTX) & 1023 : m & 255;
  const bf16_t* z = (const bf16_t*)(p.ws + OFF_Z) + (size_t)m * 1792;
  const float2* rope = (const float2*)(p.ws + OFF_ROPE) + (size_t)t * 32;
  {
    const uint4 raw = *(const uint4*)(z + lane * 8);
    float x[8];
    x[0] = bf2f(raw.x & 0xffff); x[1] = bf2f(raw.x >> 16); x[2] = bf2f(raw.y & 0xffff); x[3] = bf2f(raw.y >> 16);
    x[4] = bf2f(raw.z & 0xffff); x[5] = bf2f(raw.z >> 16); x[6] = bf2f(raw.w & 0xffff); x[7] = bf2f(raw.w >> 16);
    float ss = 0.f;
#pragma unroll
    for (int e = 0; e < 8; ++e) ss += x[e] * x[e];
    ss += __shfl_xor(ss, 1); ss += __shfl_xor(ss, 2); ss += __shfl_xor(ss, 4);
    const float rn = rsqrtf(ss * (1.0f / 64.0f) + LN_EPS);
    const int d0 = (lane & 7) * 8;
    const float* gq = p.in[10] + l * 64 + d0;
#pragma unroll
    for (int e = 0; e < 8; ++e) x[e] = x[e] * rn * gq[e];
    if (dec) {
#pragma unroll
      for (int e = 0; e < 4; ++e) {
        const float2 cs = rope[(d0 >> 1) + e];
        const float x0 = x[2 * e], x1 = x[2 * e + 1];
        x[2 * e] = x0 * cs.x - x1 * cs.y;
        x[2 * e + 1] = x0 * cs.y + x1 * cs.x;
      }
    }
    const float qs = 0.125f * 1.4426950408889634f;
    *(uint4*)((bf16_t*)(p.ws + OFF_QN) + (size_t)m * 512 + lane * 8) =
        uint4{pack2(x[0] * qs, x[1] * qs), pack2(x[2] * qs, x[3] * qs), pack2(x[4] * qs, x[5] * qs), pack2(x[6] * qs, x[7] * qs)};
  }
  {
    const int li = lane & 15, hk = li >> 3, d0 = (li & 7) * 8;
    const uint4 raw = *(const uint4*)(z + 512 + li * 8);
    float x[8];
    x[0] = bf2f(raw.x & 0xffff); x[1] = bf2f(raw.x >> 16); x[2] = bf2f(raw.y & 0xffff); x[3] = bf2f(raw.y >> 16);
    x[4] = bf2f(raw.z & 0xffff); x[5] = bf2f(raw.z >> 16); x[6] = bf2f(raw.w & 0xffff); x[7] = bf2f(raw.w >> 16);
    float ss = 0.f;
#pragma unroll
    for (int e = 0; e < 8; ++e) ss += x[e] * x[e];
    ss += __shfl_xor(ss, 1); ss += __shfl_xor(ss, 2); ss += __shfl_xor(ss, 4);
    const float rn = rsqrtf(ss * (1.0f / 64.0f) + LN_EPS);
    const float* gk = p.in[11] + l * 64 + d0;
#pragma unroll
    for (int e = 0; e < 8; ++e) x[e] = x[e] * rn * gk[e];
    if (lane < 16) {
      if (!dec) {
        float* ck = p.out + OUT_CK + ((size_t)((b * 2 + l) * 256 + t)) * 128 + li * 8;
        *(float4*)ck = float4{x[0], x[1], x[2], x[3]};
        *(float4*)(ck + 4) = float4{x[4], x[5], x[6], x[7]};
        *(uint4*)(Kc + ((size_t)(b * 2 + hk) * 256 + t) * 64 + d0) =
            uint4{pack2(x[0], x[1]), pack2(x[2], x[3]), pack2(x[4], x[5]), pack2(x[6], x[7])};
      } else {
#pragma unroll
        for (int e = 0; e < 4; ++e) {
          const float2 cs = rope[(d0 >> 1) + e];
          const float x0 = x[2 * e], x1 = x[2 * e + 1];
          x[2 * e] = x0 * cs.x - x1 * cs.y;
          x[2 * e + 1] = x0 * cs.y + x1 * cs.x;
        }
        *(uint4*)(Kd + ((size_t)(b * 2 + hk) * 1536 + t) * 64 + d0) =
            uint4{pack2(x[0], x[1]), pack2(x[2], x[3]), pack2(x[4], x[5]), pack2(x[6], x[7])};
      }
    }
  }
  if (lane >= 16 && lane < 32) {
    const int li = lane - 16, hk = li >> 3, d0 = (li & 7) * 8;
    const uint4 raw = *(const uint4*)(z + 640 + li * 8);
    float x[8];
    x[0] = bf2f(raw.x & 0xffff); x[1] = bf2f(raw.x >> 16); x[2] = bf2f(raw.y & 0xffff); x[3] = bf2f(raw.y >> 16);
    x[4] = bf2f(raw.z & 0xffff); x[5] = bf2f(raw.z >> 16); x[6] = bf2f(raw.w & 0xffff); x[7] = bf2f(raw.w >> 16);
    if (!dec) {
      float* cv = p.out + OUT_CV + ((size_t)((b * 2 + l) * 256 + t)) * 128 + li * 8;
      *(float4*)cv = float4{x[0], x[1], x[2], x[3]};
      *(float4*)(cv + 4) = float4{x[4], x[5], x[6], x[7]};
#pragma unroll
      for (int e = 0; e < 8; ++e) VTc[((size_t)(b * 2 + hk) * 64 + d0 + e) * 256 + t] = f2bf(x[e]);
    } else {
#pragma unroll
      for (int e = 0; e < 8; ++e) VTd[((size_t)(b * 2 + hk) * 64 + d0 + e) * 1536 + t] = f2bf(x[e]);
    }
  }
}

DEVI void attn_item(const Params& p, int a, unsigned char* smem) {
  const int tid = opaque_tid(), lane = tid & 63, wave = tid >> 6, fr = lane & 15, fq = lane >> 4;
  int h, Lk, m0;
  const bf16_t *Kb, *Vb;
  if (a < 512) {
    const int b = a >> 6; h = (a >> 3) & 7; const int qb = a & 7; Lk = 1536; m0 = MCTX + b * 1024 + qb * 128;
    const int bh = b * 2 + (h >> 2);
    Kb = (const bf16_t*)(p.ws + OFF_KD) + (size_t)bh * 1536 * 64;
    Vb = (const bf16_t*)(p.ws + OFF_VTD) + (size_t)bh * 64 * 1536;
  } else {
    a -= 512;
    const int b = a >> 4; h = (a >> 1) & 7; const int qb = a & 1; Lk = 256; m0 = b * 256 + qb * 128;
    const int bh = b * 2 + (h >> 2);
    Kb = (const bf16_t*)(p.ws + OFF_KC) + (size_t)bh * 256 * 64;
    Vb = (const bf16_t*)(p.ws + OFF_VTC) + (size_t)bh * 64 * 256;
  }
  const bf16_t* Qn = (const bf16_t*)(p.ws + OFF_QN);
  bf16x8 qf[2][2];
#pragma unroll
  for (int jq = 0; jq < 2; ++jq)
#pragma unroll
    for (int ks = 0; ks < 2; ++ks)
      qf[jq][ks] = *(const bf16x8*)(Qn + (size_t)(m0 + wave * 32 + jq * 16 + fr) * 512 + h * 64 + ks * 32 + fq * 8);
  f32x4 o[4][2];
#pragma unroll
  for (int di = 0; di < 4; ++di)
#pragma unroll
    for (int jq = 0; jq < 2; ++jq) o[di][jq] = f32x4{0.f, 0.f, 0.f, 0.f};
  float mrow[2] = {-1e30f, -1e30f}, lrow[2] = {0.f, 0.f};
  const int nt = Lk >> 6;
  const int srow = tid >> 3, sch = tid & 7;
  const int woff = srow * 128 + ((sch ^ ((srow >> 1) & 7)) << 4);
  const int swz = fr >> 1;
  uint4 rk[2], rv[2];
#pragma unroll
  for (int it = 0; it < 2; ++it) {
    rk[it] = *(const uint4*)(Kb + (size_t)(srow + 32 * it) * 64 + sch * 8);
    rv[it] = *(const uint4*)(Vb + (size_t)(srow + 32 * it) * Lk + sch * 8);
  }
#pragma unroll
  for (int it = 0; it < 2; ++it) {
    *(uint4*)(smem + woff + it * 4096) = rk[it];
    *(uint4*)(smem + 8192 + woff + it * 4096) = rv[it];
  }
  __syncthreads();
#pragma unroll 1
  for (int kt = 0; kt < nt; ++kt) {
    const int cur = (kt & 1) * 16384;
    {
      const int kn = (kt + 1 < nt) ? kt + 1 : kt;
#pragma unroll
      for (int it = 0; it < 2; ++it) {
        rk[it] = *(const uint4*)(Kb + (size_t)(kn * 64 + srow + 32 * it) * 64 + sch * 8);
        rv[it] = *(const uint4*)(Vb + (size_t)(srow + 32 * it) * Lk + kn * 64 + sch * 8);
      }
    }
    f32x4 s[4][2];
#pragma unroll
    for (int i = 0; i < 4; ++i)
#pragma unroll
      for (int jq = 0; jq < 2; ++jq) s[i][jq] = f32x4{0.f, 0.f, 0.f, 0.f};
#pragma unroll
    for (int ks = 0; ks < 2; ++ks) {
      const int co = ((ks * 4 + fq) ^ swz) << 4;
#pragma unroll
      for (int i = 0; i < 4; ++i) {
        const bf16x8 kf = *(const bf16x8*)(smem + cur + (i * 16 + fr) * 128 + co);
#pragma unroll
        for (int jq = 0; jq < 2; ++jq) s[i][jq] = __builtin_amdgcn_mfma_f32_16x16x32_bf16(kf, qf[jq][ks], s[i][jq], 0, 0, 0);
      }
    }
#pragma unroll
    for (int jq = 0; jq < 2; ++jq) {
      float mx = -1e30f;
#pragma unroll
      for (int i = 0; i < 4; ++i)
#pragma unroll
        for (int r = 0; r < 4; ++r) mx = fmaxf(mx, s[i][jq][r]);
      mx = fmaxf(mx, __shfl_xor(mx, 16));
      mx = fmaxf(mx, __shfl_xor(mx, 32));
      const float mnew = fmaxf(mrow[jq], mx);
      const float alpha = exp2f(mrow[jq] - mnew);
      mrow[jq] = mnew;
      float ls = 0.f;
#pragma unroll
      for (int i = 0; i < 4; ++i)
#pragma unroll
        for (int r = 0; r < 4; ++r) { const float e = exp2f(s[i][jq][r] - mnew); s[i][jq][r] = e; ls += e; }
      lrow[jq] = lrow[jq] * alpha + ls;
#pragma unroll
      for (int di = 0; di < 4; ++di)
#pragma unroll
        for (int r = 0; r < 4; ++r) o[di][jq][r] *= alpha;
    }
#pragma unroll
    for (int kk = 0; kk < 2; ++kk) {
      bf16x8 pf[2];
#pragma unroll
      for (int jq = 0; jq < 2; ++jq) {
        union { uint4 u; bf16x8 v; } cv;
        cv.u = uint4{pack2(s[2 * kk][jq][0], s[2 * kk][jq][1]), pack2(s[2 * kk][jq][2], s[2 * kk][jq][3]),
                     pack2(s[2 * kk + 1][jq][0], s[2 * kk + 1][jq][1]), pack2(s[2 * kk + 1][jq][2], s[2 * kk + 1][jq][3])};
        pf[jq] = cv.v;
      }
      const int c0 = ((4 * kk + (fq >> 1)) ^ swz) << 4;
      const int c1 = ((4 * kk + 2 + (fq >> 1)) ^ swz) << 4;
      const int wi = (fq & 1) * 8;
#pragma unroll
      for (int di = 0; di < 4; ++di) {
        const unsigned char* vrow = smem + cur + 8192 + (di * 16 + fr) * 128;
        union { uint2 u[2]; bf16x8 v; } cv;
        cv.u[0] = *(const uint2*)(vrow + c0 + wi);
        cv.u[1] = *(const uint2*)(vrow + c1 + wi);
#pragma unroll
        for (int jq = 0; jq < 2; ++jq) o[di][jq] = __builtin_amdgcn_mfma_f32_16x16x32_bf16(cv.v, pf[jq], o[di][jq], 0, 0, 0);
      }
    }
    {
      const int nxt = 16384 - cur;
#pragma unroll
      for (int it = 0; it < 2; ++it) {
        *(uint4*)(smem + nxt + woff + it * 4096) = rk[it];
        *(uint4*)(smem + nxt + 8192 + woff + it * 4096) = rv[it];
      }
    }
    __syncthreads();
  }
  bf16_t* att = (bf16_t*)(p.ws + OFF_ATT);
#pragma unroll
  for (int jq = 0; jq < 2; ++jq) {
    float lt = lrow[jq];
    lt += __shfl_xor(lt, 16);
    lt += __shfl_xor(lt, 32);
    const float inv = 1.0f / lt;
    bf16_t* dst = att + (size_t)(m0 + wave * 32 + jq * 16 + fr) * 512 + h * 64 + 4 * fq;
#pragma unroll
    for (int di = 0; di < 4; ++di)
      *(uint2*)(dst + di * 16) = uint2{pack2(o[di][jq][0] * inv, o[di][jq][1] * inv), pack2(o[di][jq][2] * inv, o[di][jq][3] * inv)};
  }
}

DEVI int ssm_col_row(int sub, int j) {
  return sub < 8 ? MCTX + sub * 1024 + j * 16 : ((sub - 8) * 4 + (j >> 4)) * 256 + (j & 15) * 16;
}

DEVI void ssm_item(const Params& p, int l, int idx, unsigned char* smem) {
  const int g = idx / 12, sub = idx % 12;
  const int tid = opaque_tid(), lane = tid & 63, wave = tid >> 6, fr = lane & 15, fq = lane >> 4;
  const bf16_t* AC = (const bf16_t*)(p.ws + OFF_SSM) + (size_t)(l * 32 + g) * SSM_EL;
  const bf16_t* W1 = AC + 256 * 512;
  const bf16_t* z = (const bf16_t*)(p.ws + OFF_Z);
  const int ucol = 768 + g * 16;
  size_t ubase[4];
#pragma unroll
  for (int jt = 0; jt < 4; ++jt) ubase[jt] = (size_t)ssm_col_row(sub, jt * 16 + fr) * 1792 + ucol;
  f32x4 acc[4][4];
  zero_acc(acc);
#pragma unroll 1
  for (int ks = 0; ks < 8; ++ks) {
    const int s = 2 * ks + (fq >> 1), m8 = (fq & 1) * 8;
    bf16x8 a[4], b[4];
#pragma unroll
    for (int i = 0; i < 4; ++i) a[i] = *(const bf16x8*)(W1 + (size_t)(wave * 64 + i * 16 + fr) * 256 + ks * 32 + fq * 8);
#pragma unroll
    for (int jt = 0; jt < 4; ++jt) b[jt] = *(const bf16x8*)(z + ubase[jt] + (size_t)s * 1792 + m8);
#pragma unroll
    for (int i = 0; i < 4; ++i)
#pragma unroll
      for (int jt = 0; jt < 4; ++jt) acc[i][jt] = __builtin_amdgcn_mfma_f32_16x16x32_bf16(a[i], b[jt], acc[i][jt], 0, 0, 0);
  }
#pragma unroll
  for (int i = 0; i < 4; ++i)
#pragma unroll
    for (int jt = 0; jt < 4; ++jt) {
      const int j = jt * 16 + fr;
      const int row0 = wave * 64 + i * 16 + 4 * fq;
      *(uint2*)(smem + j * 512 + (((row0 >> 3) ^ (j & 15)) << 4) + (row0 & 4) * 2) =
          uint2{pack2(acc[i][jt][0], acc[i][jt][1]), pack2(acc[i][jt][2], acc[i][jt][3])};
    }
  __syncthreads();
  if (tid < 128) {
    const int dir = tid >> 6, pp = tid & 63;
    const float2 lam = ((const float2*)(p.ws + OFF_LAM16))[((l * 2 + dir) * 32 + g) * 64 + pp];
    const int nseq = sub < 8 ? 1 : 4, nch = sub < 8 ? 64 : 16;
    const int ch = (dir * 64 + pp) >> 2, wi = (pp & 3) * 4;
    for (int q = 0; q < nseq; ++q) {
      float hr = 0.f, hi = 0.f;
      if (sub < 8) {
        const float* h0 = p.in[5] + ((size_t)(((sub * 2 + l) * 2 + dir) * 32 + g) * 64 + pp) * 2;
        hr = h0[0]; hi = h0[1];
      }
      for (int c = 0; c < nch; ++c) {
        const int j = q * nch + (dir == 0 ? c : nch - 1 - c);
        unsigned* f = (unsigned*)(smem + j * 512 + ((ch ^ (j & 15)) << 4) + wi);
        const unsigned Fb = *f;
        *f = pack2(hr, hi);
        const float nr = lam.x * hr - lam.y * hi + bf2f(Fb & 0xffff);
        const float ni = lam.x * hi + lam.y * hr + bf2f(Fb >> 16);
        hr = nr; hi = ni;
      }
      if (sub >= 8) {
        const int b = (sub - 8) * 4 + q;
        float* st = p.out + OUT_ST + ((size_t)(((b * 2 + l) * 2 + dir) * 32 + g) * 64 + pp) * 2;
        st[0] = hr; st[1] = hi;
      }
    }
  }
  __syncthreads();
  zero_acc(acc);
#pragma unroll 1
  for (int ks = 0; ks < 16; ++ks) {
    bf16x8 a[4], b[4];
#pragma unroll
    for (int i = 0; i < 4; ++i) a[i] = *(const bf16x8*)(AC + (size_t)(wave * 64 + i * 16 + fr) * 512 + ks * 32 + fq * 8);
    if (ks < 8) {
      const int s = 2 * ks + (fq >> 1), m8 = (fq & 1) * 8;
#pragma unroll
      for (int jt = 0; jt < 4; ++jt) b[jt] = *(const bf16x8*)(z + ubase[jt] + (size_t)s * 1792 + m8);
    } else {
      const int c0 = (ks - 8) * 4 + fq;
#pragma unroll
      for (int jt = 0; jt < 4; ++jt) {
        const int j = jt * 16 + fr;
        b[jt] = *(const bf16x8*)(smem + j * 512 + ((c0 ^ (j & 15)) << 4));
      }
    }
#pragma unroll
    for (int i = 0; i < 4; ++i)
#pragma unroll
      for (int jt = 0; jt < 4; ++jt) acc[i][jt] = __builtin_amdgcn_mfma_f32_16x16x32_bf16(a[i], b[jt], acc[i][jt], 0, 0, 0);
  }
  bf16_t* sp = (bf16_t*)(p.ws + OFF_SSMP);
  const float4 dv = *(const float4*)(p.in[19] + l * 512 + g * 16 + 4 * fq);
#pragma unroll
  for (int i = 0; i < 4; ++i) {
    const int t = wave * 4 + i;
#pragma unroll
    for (int jt = 0; jt < 4; ++jt) {
      const size_t row = (size_t)ssm_col_row(sub, jt * 16 + fr) + t;
      const uint2 uu = *(const uint2*)(z + row * 1792 + ucol + 4 * fq);
      const float y0 = gelu_tanh(acc[i][jt][0] + dv.x * bf2f(uu.x & 0xffff));
      const float y1 = gelu_tanh(acc[i][jt][1] + dv.y * bf2f(uu.x >> 16));
      const float y2 = gelu_tanh(acc[i][jt][2] + dv.z * bf2f(uu.y & 0xffff));
      const float y3 = gelu_tanh(acc[i][jt][3] + dv.w * bf2f(uu.y >> 16));
      *(uint2*)(sp + row * 512 + g * 16 + 4 * fq) = uint2{pack2(y0, y1), pack2(y2, y3)};
      asm volatile("" ::: "memory");
    }
  }
  __syncthreads();
}

#define TILE_IDS \
  const int tid = opaque_tid(), lane = tid & 63, wave = tid >> 6, wp = wave >> 1, wq = wave & 1, fr = lane & 15, fq = lane >> 4; \
  (void)tid; (void)wp; (void)wq; (void)fr; (void)fq;

DEVI void z_tile(const Params& p, int l, int t, unsigned char* smem) {
  TILE_IDS
  int mt, nt; grp_tile(t, 14, mt, nt);
  const bf16_t* P = (const bf16_t*)(p.ws + OFF_W) + (size_t)l * WL_TOT + WL_IN + (size_t)nt * 128 * 1024;
  const bf16_t* Q = (const bf16_t*)(p.ws + OFF_U) + (size_t)mt * 128 * 1024;
  f32x4 acc[4][4];
  zero_acc(acc);
  gemm_core2(P, 1024, Q, 1024, 1024, acc, smem);
  bf16_t* z = (bf16_t*)(p.ws + OFF_Z);
#pragma unroll
  for (int i = 0; i < 4; ++i)
#pragma unroll
    for (int j = 0; j < 4; ++j) {
      const int n = nt * 128 + wp * 64 + i * 16 + 4 * fq, m = mt * 128 + wq * 64 + j * 16 + fr;
      *(uint2*)(z + (size_t)m * 1792 + n) = uint2{pack2(acc[i][j][0], acc[i][j][1]), pack2(acc[i][j][2], acc[i][j][3])};
    }
}

DEVI void four1_tile(const Params& p, int t, unsigned char* smem) {
  TILE_IDS
  const int mt = t >> 3, grp = (t >> 1) & 3, half = t & 1;
  const bf16_t* P = (const bf16_t*)(p.ws + OFF_Z) + (size_t)mt * 128 * 1792 + 1280 + grp * 128;
  const bf16_t* Q = (const bf16_t*)(p.ws + OFF_DFT128) + (size_t)half * 128 * 128;
  f32x4 acc[4][4];
  zero_acc(acc);
  gemm_core2(P, 1792, Q, 128, 128, acc, smem);
  bf16_t* GT = (bf16_t*)(p.ws + OFF_GT);
  const int m0 = mt * 128;
  int L; bf16_t* gb; int lpos0;
  if (m0 < MCTX) { L = 256; gb = GT + (size_t)(m0 >> 8) * 512 * 512; lpos0 = m0 & 255; }
  else { L = 1024; gb = GT + (size_t)16 * 512 * 512 + (size_t)((m0 - MCTX) >> 10) * 512 * 2048; lpos0 = (m0 - MCTX) & 1023; }
#pragma unroll
  for (int i = 0; i < 4; ++i)
#pragma unroll
    for (int j = 0; j < 4; ++j) {
      const int lp = lpos0 + wp * 64 + i * 16 + 4 * fq;
      const int cp = wq * 64 + j * 16 + fr;
      *(uint2*)(gb + (size_t)(grp * 128 + cp) * (2 * L) + half * L + lp) =
          uint2{pack2(acc[i][j][0], acc[i][j][1]), pack2(acc[i][j][2], acc[i][j][3])};
    }
}

DEVI void four2_tile(const Params& p, int t, unsigned char* smem) {
  TILE_IDS
  const bf16_t* GT = (const bf16_t*)(p.ws + OFF_GT);
  const bf16_t *P, *Q; int K, mrow0, nt; float scale;
  if (t < 128) {
    const int b = t >> 3, pt = (t >> 2) & 1; nt = t & 3;
    P = GT + (size_t)b * 512 * 512 + (size_t)nt * 128 * 512;
    Q = (const bf16_t*)(p.ws + OFF_T256) + (size_t)pt * 128 * 512;
    K = 512; mrow0 = b * 256 + pt * 128; scale = 0.005524271728019903f;
  } else {
    t -= 128;
    const int b = t >> 5, pt = (t >> 2) & 7; nt = t & 3;
    P = GT + (size_t)16 * 512 * 512 + (size_t)b * 512 * 2048 + (size_t)nt * 128 * 2048;
    Q = (const bf16_t*)(p.ws + OFF_T1024) + (size_t)pt * 128 * 2048;
    K = 2048; mrow0 = MCTX + b * 1024 + pt * 128; scale = 0.0027621358640099515f;
  }
  f32x4 acc[4][4];
  zero_acc(acc);
  gemm_core2(P, K, Q, K, K, acc, smem);
  bf16_t* fo = (bf16_t*)(p.ws + OFF_FOUR);
#pragma unroll
  for (int i = 0; i < 4; ++i)
#pragma unroll
    for (int j = 0; j < 4; ++j) {
      const int n = nt * 128 + wp * 64 + i * 16 + 4 * fq, m = mrow0 + wq * 64 + j * 16 + fr;
      *(uint2*)(fo + (size_t)m * 512 + n) =
          uint2{pack2(acc[i][j][0] * scale, acc[i][j][1] * scale), pack2(acc[i][j][2] * scale, acc[i][j][3] * scale)};
    }
}

DEVI void glu_tile(const Params& p, int l, int t, unsigned char* smem) {
  TILE_IDS
  int mt, nt; grp_tile(t, 4, mt, nt);
  const bf16_t* P = (const bf16_t*)(p.ws + OFF_W) + (size_t)l * WL_TOT + WL_GLU + (size_t)nt * 128 * 512;
  const bf16_t* sp = (const bf16_t*)(p.ws + OFF_SSMP);
  const bf16_t* Q = sp + (size_t)mt * 128 * 512;
  f32x4 acc[4][4];
  zero_acc(acc);
  gemm_core2(P, 512, Q, 512, 512, acc, smem);
  bf16_t* sg = (bf16_t*)(p.ws + OFF_SSMG);
#pragma unroll
  for (int i = 0; i < 4; ++i)
#pragma unroll
    for (int j = 0; j < 4; ++j) {
      const int n = nt * 128 + wp * 64 + i * 16 + 4 * fq, m = mt * 128 + wq * 64 + j * 16 + fr;
      const float4 bg = *(const float4*)(p.in[21] + l * 512 + n);
      const uint2 yy = *(const uint2*)(sp + (size_t)m * 512 + n);
      const float y0 = bf2f(yy.x & 0xffff), y1 = bf2f(yy.x >> 16), y2 = bf2f(yy.y & 0xffff), y3 = bf2f(yy.y >> 16);
      *(uint2*)(sg + (size_t)m * 512 + n) =
          uint2{pack2(y0 * sigmoidf_(acc[i][j][0] + bg.x), y1 * sigmoidf_(acc[i][j][1] + bg.y)),
                pack2(y2 * sigmoidf_(acc[i][j][2] + bg.z), y3 * sigmoidf_(acc[i][j][3] + bg.w))};
      asm volatile("" ::: "memory");
    }
}

DEVI void merged_tile(const Params& p, int l, int t, unsigned char* smem) {
  TILE_IDS
  int mt, nt; grp_tile(t, 8, mt, nt);
  const bf16_t* wl = (const bf16_t*)(p.ws + OFF_W) + (size_t)l * WL_TOT;
  const bf16_t* u = (const bf16_t*)(p.ws + OFF_U) + (size_t)mt * 128 * 1024;
  bf16_t* mo = (bf16_t*)(p.ws + OFF_GT);
  bf16_t* sgt = (bf16_t*)(p.ws + OFF_QN);
#pragma unroll 1
  for (int br = 0; br < 3; ++br) {
    {
      f32x4 acc[4][4];
      zero_acc(acc);
      gemm_core2(wl + WL_IN + (size_t)(1792 + br * 1024 + nt * 128) * 1024, 1024, u, 1024, 1024, acc, smem);
#pragma unroll
      for (int i = 0; i < 4; ++i)
#pragma unroll
        for (int j = 0; j < 4; ++j) {
          const int n = nt * 128 + wp * 64 + i * 16 + 4 * fq, m = mt * 128 + wq * 64 + j * 16 + fr;
          *(uint2*)(sgt + (size_t)m * 1024 + n) =
              uint2{pack2(sigmoidf_(acc[i][j][0]), sigmoidf_(acc[i][j][1])), pack2(sigmoidf_(acc[i][j][2]), sigmoidf_(acc[i][j][3]))};
        }
    }
    {
      f32x4 acc[4][4];
      zero_acc(acc);
      const bf16_t* X = (const bf16_t*)(p.ws + OFF_ATT) + (size_t)br * M * 512 + (size_t)mt * 128 * 512;
      gemm_core2(wl + WL_BR + (size_t)br * 1024 * 512 + (size_t)nt * 128 * 512, 512, X, 512, 512, acc, smem);
#pragma unroll
      for (int i = 0; i < 4; ++i)
#pragma unroll
        for (int j = 0; j < 4; ++j) {
          const int n = nt * 128 + wp * 64 + i * 16 + 4 * fq, m = mt * 128 + wq * 64 + j * 16 + fr;
          uint2* dst = (uint2*)(mo + (size_t)m * 1024 + n);
          const uint2 sg = *(const uint2*)(sgt + (size_t)m * 1024 + n);
          float v0 = bf2f(sg.x & 0xffff) * acc[i][j][0];
          float v1 = bf2f(sg.x >> 16) * acc[i][j][1];
          float v2 = bf2f(sg.y & 0xffff) * acc[i][j][2];
          float v3 = bf2f(sg.y >> 16) * acc[i][j][3];
          if (br > 0) {
            const uint2 o = *dst;
            v0 += bf2f(o.x & 0xffff); v1 += bf2f(o.x >> 16); v2 += bf2f(o.y & 0xffff); v3 += bf2f(o.y >> 16);
          }
          *dst = uint2{pack2(v0, v1), pack2(v2, v3)};
          asm volatile("" ::: "memory");
        }
    }
  }
}

DEVI void resid_tile(const Params& p, int l, int t, int which, unsigned char* smem) {
  TILE_IDS
  int mt, nt; grp_tile(t, 8, mt, nt);
  const bf16_t* wl = (const bf16_t*)(p.ws + OFF_W) + (size_t)l * WL_TOT;
  f32x4 acc[4][4];
  zero_acc(acc);
  if (which == 0)
    gemm_core2(wl + WL_OUT + (size_t)nt * 128 * 1024, 1024, (const bf16_t*)(p.ws + OFF_GT) + (size_t)mt * 128 * 1024, 1024, 1024, acc, smem);
  else
    gemm_core2(wl + WL_DN + (size_t)nt * 128 * 2816, 2816, (const bf16_t*)(p.ws + OFF_HG) + (size_t)mt * 128 * 2816, 2816, 2816, acc, smem);
  const float* modl = (const float*)(p.ws + OFF_MOD) + (size_t)l * 9 * 6144 + (which == 0 ? 2048 : 5120);
  const bool from_in = (l == 0 && which == 0);
#pragma unroll
  for (int i = 0; i < 4; ++i)
#pragma unroll
    for (int j = 0; j < 4; ++j) {
      const int n = nt * 128 + wp * 64 + i * 16 + 4 * fq, m = mt * 128 + wq * 64 + j * 16 + fr;
      const float4 gg = *(const float4*)(modl + (size_t)modrow(m) * 6144 + n);
      float* dst = p.out + (size_t)m * 1024 + n;
      const float4 xv = from_in ? *(const float4*)(xin_row(p, m) + n) : *(const float4*)dst;
      *(float4*)dst = float4{ALPHA * xv.x + gg.x * acc[i][j][0], ALPHA * xv.y + gg.y * acc[i][j][1],
                             ALPHA * xv.z + gg.z * acc[i][j][2], ALPHA * xv.w + gg.w * acc[i][j][3]};
    }
}

DEVI void up_tile(const Params& p, int l, int t, unsigned char* smem) {
  TILE_IDS
  int mt, nt; grp_tile(t, 44, mt, nt);
  const bf16_t* P = (const bf16_t*)(p.ws + OFF_W) + (size_t)l * WL_TOT + WL_UP + (size_t)nt * 128 * 1024;
  const bf16_t* Q = (const bf16_t*)(p.ws + OFF_U) + (size_t)mt * 128 * 1024;
  f32x4 acc[4][4];
  zero_acc(acc);
  gemm_core2(P, 1024, Q, 1024, 1024, acc, smem);
  bf16_t* T = (bf16_t*)smem;
#pragma unroll
  for (int i = 0; i < 4; ++i)
#pragma unroll
    for (int j = 0; j < 4; ++j) {
      const int n = wp * 64 + i * 16 + 4 * fq, m = wq * 64 + j * 16 + fr;
      *(uint2*)(T + m * 136 + n) = uint2{pack2(acc[i][j][0], acc[i][j][1]), pack2(acc[i][j][2], acc[i][j][3])};
    }
  __syncthreads();
  {
    const int c = tid & 63, r0 = (tid >> 6) * 32;
    const int ca = nt * 64 + c, cb = 2816 + nt * 64 + c;
    const float* cw = p.in[29] + (size_t)l * 3 * 5632;
    const float* cbias = p.in[30] + (size_t)l * 5632;
    const float wa0 = cw[ca], wa1 = cw[5632 + ca], wa2 = cw[2 * 5632 + ca], ba = cbias[ca];
    const float wb0 = cw[cb], wb1 = cw[5632 + cb], wb2 = cw[2 * 5632 + cb], bb = cbias[cb];
    bf16_t* hg = (bf16_t*)(p.ws + OFF_HG) + (size_t)(mt * 128) * 2816 + nt * 64 + c;
    float pa = r0 > 0 ? bf2f(T[(r0 - 1) * 136 + c]) : 0.f, pb = r0 > 0 ? bf2f(T[(r0 - 1) * 136 + 64 + c]) : 0.f;
    float ca_ = bf2f(T[r0 * 136 + c]), cb_ = bf2f(T[r0 * 136 + 64 + c]);
    for (int r = r0; r < r0 + 32; ++r) {
      const float na = r < 127 ? bf2f(T[(r + 1) * 136 + c]) : 0.f, nb = r < 127 ? bf2f(T[(r + 1) * 136 + 64 + c]) : 0.f;
      if (r > 0 && r < 127) {
        const float ha = wa0 * pa + wa1 * ca_ + wa2 * na + ba;
        const float hb = wb0 * pb + wb1 * cb_ + wb2 * nb + bb;
        hg[(size_t)r * 2816] = f2bf(ha * sigmoidf_(ha) * hb);
      }
      pa = ca_; pb = cb_; ca_ = na; cb_ = nb;
    }
    bf16_t* edge = (bf16_t*)(p.ws + OFF_EDGE) + (size_t)mt * 4 * 5632;
    const int e = tid >> 6;
    const int er = e < 2 ? e : 124 + e;
    edge[(size_t)e * 5632 + ca] = T[er * 136 + c];
    edge[(size_t)e * 5632 + cb] = T[er * 136 + 64 + c];
  }
  __syncthreads();
}

DEVI void edge_item(const Params& p, int l, int idx) {
  const int mt = idx >> 1, bot = idx & 1;
  const int L = mt < 32 ? 256 : 1024;
  const int m = mt * 128 + (bot ? 127 : 0);
  const int mloc = mt < 32 ? m : m - MCTX;
  const int pos = mloc & (L - 1);
  const bf16_t* edge = (const bf16_t*)(p.ws + OFF_EDGE);
  const bf16_t *prev, *cur, *next;
  bool hasp, hasn;
  if (!bot) {
    hasp = pos != 0; hasn = true;
    prev = edge + ((size_t)(mt > 0 ? mt - 1 : 0) * 4 + 3) * 5632;
    cur = edge + ((size_t)mt * 4 + 0) * 5632;
    next = edge + ((size_t)mt * 4 + 1) * 5632;
  } else {
    hasp = true; hasn = pos != L - 1;
    prev = edge + ((size_t)mt * 4 + 2) * 5632;
    cur = edge + ((size_t)mt * 4 + 3) * 5632;
    next = edge + ((size_t)(mt < 95 ? mt + 1 : 95) * 4 + 0) * 5632;
  }
  const float* cw = p.in[29] + (size_t)l * 3 * 5632;
  const float* cbias = p.in[30] + (size_t)l * 5632;
  bf16_t* hg = (bf16_t*)(p.ws + OFF_HG) + (size_t)m * 2816;
  for (int c = opaque_tid(); c < 2816; c += 256) {
    const int cb = 2816 + c;
    const float pa = hasp ? bf2f(prev[c]) : 0.f, pb = hasp ? bf2f(prev[cb]) : 0.f;
    const float na = hasn ? bf2f(next[c]) : 0.f, nb = hasn ? bf2f(next[cb]) : 0.f;
    const float ha = cw[c] * pa + cw[5632 + c] * bf2f(cur[c]) + cw[2 * 5632 + c] * na + cbias[c];
    const float hb = cw[cb] * pb + cw[5632 + cb] * bf2f(cur[cb]) + cw[2 * 5632 + cb] * nb + cbias[cb];
    hg[c] = f2bf(ha * sigmoidf_(ha) * hb);
  }
}


#define XB_TMO      128
#define XB_XCNT(j)  (256  + 64 * (j))
#define XB_XSUB(j)  (1280 + 64 * (j))
#define XB_XGEN(j)  (2304 + 64 * (j))
#define XB_TOP      3328
#define XB_TOPGEN   3392
#define XCD_BAR_WORDS 3456
#define XB_SPIN_CAP (1u << 20)
#define LAS __attribute__((address_space(3)))
DEVI unsigned xb_ld(unsigned* p) { return __hip_atomic_load(p, __ATOMIC_RELAXED, __HIP_MEMORY_SCOPE_AGENT); }
DEVI unsigned xb_add(unsigned* p, unsigned v) { return __hip_atomic_fetch_add(p, v, __ATOMIC_RELAXED, __HIP_MEMORY_SCOPE_AGENT); }
DEVI unsigned xb_xcc_id() { return (unsigned)__builtin_amdgcn_s_getreg((3 << 11) | 20) & 0xFu; }
#define XB_SPIN(cond, bar) do { unsigned _sp = 0; while (cond) { __builtin_amdgcn_s_sleep(1); \
    if ((++_sp & 255u) == 0u) { if (xb_ld(&(bar)[XB_TMO])) break; if (_sp > XB_SPIN_CAP) { atomicAdd(&(bar)[XB_TMO], 1u); break; } } } } while (0)
struct XcdBarrier { unsigned* bar; unsigned x; volatile LAS unsigned* st; };
DEVI XcdBarrier xcd_barrier_post(unsigned* bar, volatile LAS unsigned* st) {
  XcdBarrier b; b.bar = bar; b.x = xb_xcc_id(); b.st = st;
  if (threadIdx.x == 0) (void)xb_add(&bar[XB_XCNT(b.x)], 1u);
  return b;
}
DEVI void xcd_barrier_complete(unsigned* bar, unsigned x, unsigned& nloc, unsigned& nx) {
  const unsigned G = gridDim.x * gridDim.y * gridDim.z;
  unsigned sum, cnt, mine, sp = 0u;
  for (;;) {
    sum = 0u; cnt = 0u; mine = 0u;
#pragma unroll
    for (unsigned j = 0; j < 16; ++j) { const unsigned c = xb_ld(&bar[XB_XCNT(j)]); sum += c; cnt += (c > 0u) ? 1u : 0u; mine = (j == x) ? c : mine; }
    if (sum == G) break;
    __builtin_amdgcn_s_sleep(1);
    if ((++sp & 255u) == 0u) { if (xb_ld(&bar[XB_TMO])) break; if (sp > XB_SPIN_CAP) { atomicAdd(&bar[XB_TMO], 1u); break; } }
  }
  nloc = mine > 0u ? mine : 1u; nx = cnt > 0u ? cnt : 1u;
}
DEVI void xcd_barrier(const XcdBarrier& b_) {
  asm volatile("s_waitcnt vmcnt(0)" ::: "memory");
  __syncthreads();
  if (threadIdx.x == 0) {
    XcdBarrier b = b_; b.x = xb_xcc_id();
    unsigned* bar = b.bar;
    __builtin_amdgcn_s_waitcnt(0);
    unsigned nloc = b.st[0], nx = b.st[1];
    if (nloc == 0u) { xcd_barrier_complete(bar, b.x, nloc, nx); b.st[0] = nloc; b.st[1] = nx; }
    const unsigned old = xb_add(&bar[XB_XSUB(b.x)], 1u);
    const unsigned gen = old / nloc;
    if (old + 1u == (gen + 1u) * nloc) {
      __builtin_amdgcn_fence(__ATOMIC_RELEASE, "agent");
      asm volatile("s_waitcnt vmcnt(0)" ::: "memory");
      const unsigned og = xb_add(&bar[XB_TOP], 1u);
      const unsigned tg = og / nx;
      if (og + 1u == (tg + 1u) * nx) xb_add(&bar[XB_TOPGEN], 1u);
      else XB_SPIN(xb_ld(&bar[XB_TOPGEN]) == tg, bar);
      __builtin_amdgcn_fence(__ATOMIC_ACQUIRE, "agent");
      xb_add(&bar[XB_XGEN(b.x)], 1u);
      asm volatile("s_waitcnt vmcnt(0)" ::: "memory");
    } else {
      XB_SPIN(xb_ld(&bar[XB_XGEN(b.x)]) == gen, bar);
      __builtin_amdgcn_fence(__ATOMIC_ACQUIRE, "agent");
      asm volatile("s_waitcnt vmcnt(0)" ::: "memory");
    }
  }
  __syncthreads();
}


DEVI int next_item(unsigned* ctr, volatile unsigned* slot) {
  __syncthreads();
  if (threadIdx.x == 0) *slot = __hip_atomic_fetch_add(ctr, 1u, __ATOMIC_RELAXED, __HIP_MEMORY_SCOPE_AGENT);
  __syncthreads();
  return (int)*slot;
}
#define FOR_QUEUE(idx, T, q) for (int idx = next_item((unsigned*)(p.ws + OFF_CTR) + 64 * (q), qslot); idx < (T); idx = next_item((unsigned*)(p.ws + OFF_CTR) + 64 * (q), qslot))

#define FOR_ITEMS(idx, T) for (int idx = (bid & 7) * (G >> 3) + (bid >> 3); idx < (T); idx += G)

__global__ void __launch_bounds__(256, 3) trunk_megakernel(Params p) {
  cg::grid_group grid = cg::this_grid();
  __shared__ __attribute__((aligned(16))) unsigned char smem_all[49152 + 16];
  unsigned char* smem = smem_all;
  const int G = gridDim.x, bid = blockIdx.x;
  if (threadIdx.x == 0) *(uint4*)(smem_all + 49152) = uint4{0u, 0u, 0u, 0u};
  __syncthreads();
  volatile unsigned* qslot = (volatile unsigned*)(smem_all + 49152 + 8);
  const XcdBarrier xb = xcd_barrier_post((unsigned*)(p.ws + OFF_BAR), (volatile LAS unsigned*)(smem_all + 49152));
  if (p.ws == nullptr) grid.sync();

  FOR_QUEUE(i, 64 + 192 + 2016 + 560, 0) {
    if (i < 64) ssm_pre_item(p, i, smem);
    else if (i < 256) mod_item(p, i - 64, smem);
    else if (i < 256 + 2016) { for (int k = 0; k < 4; ++k) weights_item(p, (i - 256) * 4 + k, smem); }
    else table_item(p, i - 256 - 2016);
  }
  xcd_barrier(xb);
  for (int r = bid * 4 + (opaque_tid() >> 6); r < M; r += G * 4) modulate0_row(p, r);
  xcd_barrier(xb);

  for (int l = 0; l < 2; ++l) {
    RP(1) FOR_ITEMS(t, 96 * 14) z_tile(p, l, t, smem);
    xcd_barrier(xb);
    FOR_QUEUE(i, 384 + 1024 + 768, 1 + 2 * l) {
      if (i < 384) ssm_item(p, l, i, smem);
      else if (i < 384 + 1024) { for (int k = 0; k < 4; ++k) prep_token(p, l, (i - 384) * 16 + k * 4 + (opaque_tid() >> 6)); }
      else four1_tile(p, i - 1408, smem);
    }
    xcd_barrier(xb);
    FOR_QUEUE(i, 1536, 2 + 2 * l) {
      if (i < 512) attn_item(p, i, smem);
      else if (i < 768) four2_tile(p, 128 + (i - 512), smem);
      else if (i < 1152) glu_tile(p, l, i - 768, smem);
      else if (i < 1280) four2_tile(p, i - 1152, smem);
      else attn_item(p, 512 + (i - 1280), smem);
    }
    xcd_barrier(xb);
    RP(4) FOR_ITEMS(t, 768) merged_tile(p, l, t, smem);
    xcd_barrier(xb);
    FOR_ITEMS(t, 768) resid_tile(p, l, t, 0, smem);
    xcd_barrier(xb);
    {
      const float* modl = (const float*)(p.ws + OFF_MOD) + (size_t)l * 9 * 6144;
      for (int r = bid * 4 + (opaque_tid() >> 6); r < M; r += G * 4) ln_row(p, r, p.in[26] + l * 1024, p.in[27] + l * 1024, modl, 3072, 4096, true);
    }
    xcd_barrier(xb);
    RP(7) FOR_ITEMS(t, 96 * 44) up_tile(p, l, t, smem);
    xcd_barrier(xb);
    RP(8) for (int i = bid; i < 192; i += G) edge_item(p, l, i);
    xcd_barrier(xb);
    FOR_ITEMS(t, 768) resid_tile(p, l, t, 1, smem);
    xcd_barrier(xb);
    {
      const float* modn = (const float*)(p.ws + OFF_MOD) + (size_t)(l + 1 < 2 ? l + 1 : l) * 9 * 6144;
      for (int r = bid * 4 + (opaque_tid() >> 6); r < M; r += G * 4) ln_row(p, r, p.in[32] + l * 1024, p.in[33] + l * 1024, modn, 0, 1024, l == 0);
    }
    if (l == 0) xcd_barrier(xb);
    for (int rep_ = 0; rep_ < (PROBE_PHASE == 20 ? 1 : 0); ++rep_) { xcd_barrier(xb); xcd_barrier(xb); xcd_barrier(xb); xcd_barrier(xb); xcd_barrier(xb); }
  }
}

extern "C" void kernel_launch(void* const* d_in, const int* in_sizes, int n_in,
                              void* d_out, int out_size, void* d_ws, size_t ws_size,
                              hipStream_t stream) {
  static int grid_blocks = 0;
  if (!grid_blocks) {
    int dev = 0, cus = 0, per_cu = 0;
    (void)hipGetDevice(&dev);
    (void)hipDeviceGetAttribute(&cus, hipDeviceAttributeMultiprocessorCount, dev);
    (void)hipOccupancyMaxActiveBlocksPerMultiprocessor(&per_cu, trunk_megakernel, 256, 0);
    if (per_cu < 1) per_cu = 1;
    grid_blocks = cus * per_cu;
  }
  Params p{};
  for (int i = 0; i < 34; ++i) p.in[i] = (const float*)d_in[i];
  p.out = (float*)d_out;
  p.ws = (unsigned char*)d_ws;
  (void)hipMemsetAsync((unsigned char*)d_ws + OFF_BAR, 0, 16384 + 2048, stream);
  void* args[] = {&p};
  hipError_t e = hipLaunchCooperativeKernel((void*)trunk_megakernel, dim3(grid_blocks), dim3(256), args, 0, stream);
  if (e != hipSuccess) fprintf(stderr, "cooperative launch failed: %s (grid %d)\n", hipGetErrorString(e), grid_blocks);
}
```
